# Optimizing an MI355X kernel written in HIP

```python
import math
import jax, jax.numpy as jnp
from jax import lax
import numpy as np

D_MODEL = 2048
BATCH = 1
SEQ = 8192
DEPTH = 2

HEAD_DIM = 64
BLOCK = 128
GROUP_WIDTH = D_MODEL // 4
MIX_WIDTH = 4 * GROUP_WIDTH
ROPE_THETA = 10000.0
NEG_INF = -1e30
LN_EPS = 1e-5
RMS_EPS = 1e-5

A_HEADS = GROUP_WIDTH // HEAD_DIM
A_KV_HEADS = 2
SWA_WINDOW = 128
B_HEADS = GROUP_WIDTH // (2 * HEAD_DIM)
B_VDIM = 2 * HEAD_DIM
C_HEADS = GROUP_WIDTH // HEAD_DIM
DILATION_PAIRS = ((128, 1), (512, 4), (2048, 16))
D_HEADS = GROUP_WIDTH // HEAD_DIM
IDX_HEADS = 8
IDX_DIM = 64
DSA_TOPK_MAX = 256
PEER_HEADS = 8
PEER_TOPK = 16
N_KEYS = 128
N_EXPERTS = N_KEYS * N_KEYS
PEER_QDIM = 256
PEER_HALF = PEER_QDIM // 2
PEER_BLOCK = 128
ALPHA = (2 * DEPTH) ** 0.25
BETA = (8 * DEPTH) ** -0.25

IN_SPLITS = (
    A_HEADS * HEAD_DIM, A_KV_HEADS * HEAD_DIM, A_KV_HEADS * HEAD_DIM,
    B_HEADS * 2 * HEAD_DIM, B_HEADS * 2 * HEAD_DIM, B_HEADS * B_VDIM,
    C_HEADS * HEAD_DIM, C_HEADS * HEAD_DIM, C_HEADS * HEAD_DIM,
    D_HEADS * HEAD_DIM, HEAD_DIM, HEAD_DIM,
    IDX_HEADS * IDX_DIM, IDX_DIM, IDX_HEADS,
)
VALUE_SLOTS = (2, 5, 8, 11)
IN_WIDTH = sum(IN_SPLITS)

kernel_name = 'hybrid_headgroup_swa_diff_dilated_dsa_peer_deepnorm'


def layer_norm(x, g, b):
    xf = x.astype(jnp.float32)
    mu = jnp.mean(xf, -1, keepdims=True)
    var = jnp.mean(jnp.square(xf - mu), -1, keepdims=True)
    y = (xf - mu) * lax.rsqrt(var + LN_EPS)
    return (y * g.astype(jnp.float32) + b.astype(jnp.float32)).astype(x.dtype)


def rope_tables(seq_len):
    half = HEAD_DIM // 2
    inv_freq = ROPE_THETA ** (-jnp.arange(half, dtype=jnp.float32) / half)
    ang = jnp.arange(seq_len, dtype=jnp.float32)[:, None] * inv_freq[None, :]
    return jnp.cos(ang), jnp.sin(ang)


def apply_rope(t, cos, sin):
    half = t.shape[-1] // 2
    tf = t.astype(jnp.float32)
    t1, t2 = tf[..., :half], tf[..., half:]
    return jnp.concatenate([t1 * cos - t2 * sin, t1 * sin + t2 * cos], -1).astype(t.dtype)


def banded_attention(q, k, v, max_dist):
    b, hk, g, L, hd = q.shape
    nb = -(-L // BLOCK)
    pad = nb * BLOCK - L
    qp = jnp.pad(q, ((0, 0), (0, 0), (0, 0), (0, pad), (0, 0))).reshape(b, hk, g, nb, BLOCK, hd)

    def key_blocks(t):
        tp = jnp.pad(t, ((0, 0), (0, 0), (BLOCK, pad), (0, 0))).reshape(b, hk, nb + 1, BLOCK, t.shape[-1])
        return jnp.concatenate([tp[:, :, :-1], tp[:, :, 1:]], axis=3)

    kb, vb = key_blocks(k), key_blocks(v)
    s = jnp.einsum('bhgnqd,bhnkd->bhgnqk', qp.astype(jnp.float32), kb.astype(jnp.float32)) * HEAD_DIM ** -0.5
    qi = jnp.arange(BLOCK)[:, None] + BLOCK
    ki = jnp.arange(2 * BLOCK)[None, :]
    dist = qi - ki
    kabs = jnp.arange(nb)[:, None, None] * BLOCK - BLOCK + ki[None]
    mask = ((dist >= 0) & (dist <= max_dist))[None] & (kabs >= 0)
    s = jnp.where(mask, s, NEG_INF)
    m = jnp.max(s, -1)
    p = jnp.exp(s - m[..., None])
    l = jnp.sum(p, -1)
    acc = jnp.einsum('bhgnqk,bhnkd->bhgnqd', p, vb.astype(jnp.float32))
    acc = acc.reshape(b, hk, g, nb * BLOCK, -1)[..., :L, :]
    m = m.reshape(b, hk, g, nb * BLOCK)[..., :L]
    l = l.reshape(b, hk, g, nb * BLOCK)[..., :L]
    return acc, m, l


def fold_residues(t, dil):
    bsz, h, L = t.shape[:3]
    rest = t.shape[3:]
    t = t.reshape(bsz, h, L // dil, dil, *rest)
    t = jnp.moveaxis(t, 3, 1)
    return t.reshape(bsz * dil, h, L // dil, *rest)


def unfold_residues(t, batch, dil):
    bd, h, ld = t.shape[:3]
    rest = t.shape[3:]
    t = t.reshape(batch, dil, h, ld, *rest)
    t = jnp.moveaxis(t, 1, 3)
    return t.reshape(batch, h, ld * dil, *rest)


def dilated_mixture(q, k, v):
    bsz = q.shape[0]
    accs, ms, ls = [], [], []
    for window, dil in DILATION_PAIRS:
        acc, m, l = banded_attention(fold_residues(q, dil)[:, :, None], fold_residues(k, dil),
                                     fold_residues(v, dil), window // dil)
        accs.append(unfold_residues(acc[:, :, 0], bsz, dil))
        ms.append(unfold_residues(m[:, :, 0], bsz, dil))
        ls.append(unfold_residues(l[:, :, 0], bsz, dil))
    m_all = jnp.stack(ms)
    w = jnp.exp(m_all - jnp.max(m_all, 0))
    num = jnp.sum(w[..., None] * jnp.stack(accs), 0)
    den = jnp.sum(w * jnp.stack(ls), 0)
    return num / den[..., None]


def diff_attention(q1, q2, k1, k2, v, lam):
    bsz, h, L, hd = q1.shape
    nb = L // BLOCK
    kpos = jnp.arange(L)
    k1f, k2f, vf = k1.astype(jnp.float32), k2.astype(jnp.float32), v.astype(jnp.float32)
    scale = HEAD_DIM ** -0.5

    def blk(inp):
        qb1, qb2, n = inp
        qpos = n * BLOCK + jnp.arange(BLOCK)
        causal = kpos[None, :] <= qpos[:, None]
        s1 = jnp.where(causal, jnp.einsum('bhqd,bhkd->bhqk', qb1.astype(jnp.float32), k1f) * scale, NEG_INF)
        s2 = jnp.where(causal, jnp.einsum('bhqd,bhkd->bhqk', qb2.astype(jnp.float32), k2f) * scale, NEG_INF)
        a = jax.nn.softmax(s1, -1) - lam * jax.nn.softmax(s2, -1)
        return jnp.einsum('bhqk,bhkd->bhqd', a, vf)

    def to_blocks(t):
        return t.reshape(bsz, h, nb, BLOCK, t.shape[-1]).transpose(2, 0, 1, 3, 4)

    out = lax.map(blk, (to_blocks(q1), to_blocks(q2), jnp.arange(nb)))
    return out.transpose(1, 2, 0, 3, 4).reshape(bsz, h, L, -1)


def dsa_attention(q, k, v, iq, ik, iw, topk):
    bsz, h, L, hd = q.shape
    nb = L // BLOCK
    kpos = jnp.arange(L)
    ikf = ik.astype(jnp.float32)

    def blk(inp):
        qb, iqb, iwb, n = inp
        qpos = n * BLOCK + jnp.arange(BLOCK)
        sc = jax.nn.relu(jnp.einsum('bhqd,bsd->bqhs', iqb.astype(jnp.float32), ikf) * IDX_DIM ** -0.5)
        score = jnp.einsum('bqh,bqhs->bqs', iwb.astype(jnp.float32) * IDX_HEADS ** -0.5, sc)
        causal = kpos[None, :] <= qpos[:, None]
        score = jnp.where(causal[None], score, NEG_INF)
        _, idx = lax.top_k(score, topk)
        ksel = jax.vmap(lambda kk, ii: kk[ii])(k, idx).astype(jnp.float32)
        vsel = jax.vmap(lambda vv, ii: vv[ii])(v, idx).astype(jnp.float32)
        valid = idx <= qpos[None, :, None]
        s = jnp.einsum('bhqd,bqkd->bhqk', qb.astype(jnp.float32), ksel) * HEAD_DIM ** -0.5
        s = jnp.where(valid[:, None], s, NEG_INF)
        p = jax.nn.softmax(s, -1)
        return jnp.einsum('bhqk,bqkd->bhqd', p, vsel)

    def to_blocks(t):
        return t.reshape(bsz, t.shape[1], nb, BLOCK, t.shape[-1]).transpose(2, 0, 1, 3, 4)

    iwb = iw.reshape(bsz, nb, BLOCK, IDX_HEADS).transpose(1, 0, 2, 3)
    out = lax.map(blk, (to_blocks(q), to_blocks(iq), iwb, jnp.arange(nb)))
    return out.transpose(1, 2, 0, 3, 4).reshape(bsz, h, L, hd)


def hybrid_mixer(x, w_in, sinks, lam_p, sub_g, w_out, layer_idx, cos, sin):
    b, L, _ = x.shape
    proj = jnp.einsum('bld,dk->blk', x, w_in)
    points = [int(p) for p in np.cumsum(IN_SPLITS)[:-1]]
    (aq, ak, av, bq, bk, bv, cq, ck, cv, dq, dk, dv, iq, ik, iw) = jnp.split(proj, points, axis=-1)

    def heads(t, n):
        return t.reshape(b, L, n, -1).transpose(0, 2, 1, 3)

    def merge(o):
        return o.transpose(0, 2, 1, 3).reshape(b, L, -1)

    qa = apply_rope(heads(aq, A_HEADS), cos, sin).reshape(b, A_KV_HEADS, A_HEADS // A_KV_HEADS, L, HEAD_DIM)
    ka = apply_rope(heads(ak, A_KV_HEADS), cos, sin)
    va = heads(av, A_KV_HEADS)
    acc, m, l = banded_attention(qa, ka, va, SWA_WINDOW - 1)
    sink = sinks.astype(jnp.float32).reshape(1, A_KV_HEADS, -1, 1)
    m_all = jnp.maximum(m, sink)
    corr = jnp.exp(m - m_all)
    den = l * corr + jnp.exp(sink - m_all)
    oa = (acc * (corr / den)[..., None]).reshape(b, A_HEADS, L, HEAD_DIM)

    bq2 = bq.reshape(b, L, B_HEADS, 2, HEAD_DIM).transpose(3, 0, 2, 1, 4)
    bk2 = bk.reshape(b, L, B_HEADS, 2, HEAD_DIM).transpose(3, 0, 2, 1, 4)
    lam_init = 0.8 - 0.6 * math.exp(-0.3 * layer_idx)
    lp = lam_p.astype(jnp.float32)
    lam = jnp.exp(jnp.sum(lp[0] * lp[1])) - jnp.exp(jnp.sum(lp[2] * lp[3])) + lam_init
    ob = diff_attention(apply_rope(bq2[0], cos, sin), apply_rope(bq2[1], cos, sin),
                        apply_rope(bk2[0], cos, sin), apply_rope(bk2[1], cos, sin),
                        heads(bv, B_HEADS), lam)
    ob = ob * lax.rsqrt(jnp.mean(jnp.square(ob), -1, keepdims=True) + RMS_EPS) \
        * sub_g.astype(jnp.float32) * (1.0 - lam_init)

    oc = dilated_mixture(apply_rope(heads(cq, C_HEADS), cos, sin), apply_rope(heads(ck, C_HEADS), cos, sin),
                         heads(cv, C_HEADS))

    topk = min(DSA_TOPK_MAX, L // 4)
    od = dsa_attention(apply_rope(heads(dq, D_HEADS), cos, sin), apply_rope(dk, cos, sin), dv,
                       apply_rope(heads(iq, IDX_HEADS), cos, sin), apply_rope(ik, cos, sin), iw, topk)

    mixed = jnp.concatenate([merge(oa), merge(ob), merge(oc), merge(od)], -1).astype(x.dtype)
    return jnp.einsum('blk,kd->bld', mixed, w_out)


def peer_ffn(x, wq, sub_keys, u, v):
    b, L, d = x.shape
    q = jnp.einsum('bld,dk->blk', x, wq).reshape(b, L, PEER_HEADS, 2, PEER_HALF).astype(jnp.float32)
    s = jnp.einsum('blhpc,hpnc->blhpn', q, sub_keys.astype(jnp.float32))
    s1, i1 = lax.top_k(s[..., 0, :], PEER_TOPK)
    s2, i2 = lax.top_k(s[..., 1, :], PEER_TOPK)
    cand = (s1[..., :, None] + s2[..., None, :]).reshape(b, L, PEER_HEADS, PEER_TOPK * PEER_TOPK)
    cidx = (i1[..., :, None] * N_KEYS + i2[..., None, :]).reshape(b, L, PEER_HEADS, PEER_TOPK * PEER_TOPK)
    top_s, pos = lax.top_k(cand, PEER_TOPK)
    eidx = jnp.take_along_axis(cidx, pos, axis=-1)
    g = jax.nn.softmax(top_s, -1)
    n_sel = PEER_HEADS * PEER_TOPK
    nb = (b * L) // PEER_BLOCK
    xb = x.reshape(nb, PEER_BLOCK, d)
    eb = eidx.reshape(nb, PEER_BLOCK, n_sel)
    gb = g.reshape(nb, PEER_BLOCK, n_sel)

    def blk(inp):
        xt, et, gt = inp
        h = jnp.einsum('td,tkd->tk', xt, u[et]).astype(jnp.float32)
        a = gt * jax.nn.gelu(h, approximate=False)
        return jnp.einsum('tk,tkd->td', a.astype(v.dtype), v[et])

    out = lax.map(blk, (xb, eb, gb))
    return out.reshape(b, L, d).astype(x.dtype)


def setup_inputs(seed: int = 0) -> dict:
    key = jax.random.key(seed)
    ks = jax.random.split(key, 14)
    f = jnp.float32
    offsets = np.concatenate([[0], np.cumsum(IN_SPLITS)])
    col_scale = np.ones((IN_WIDTH,), np.float32)
    for slot in VALUE_SLOTS:
        col_scale[offsets[slot]:offsets[slot + 1]] = BETA
    x = jax.random.normal(ks[0], (BATCH, SEQ, D_MODEL), f)
    w_in = jax.random.normal(ks[1], (DEPTH, D_MODEL, IN_WIDTH), f) * (D_MODEL ** -0.5) * jnp.asarray(col_scale)
    attn_sinks = 0.5 * jax.random.normal(ks[2], (DEPTH, A_HEADS), f)
    diff_lambda = 0.1 * jax.random.normal(ks[3], (DEPTH, 4, HEAD_DIM), f)
    diff_norm_g = 1.0 + 0.02 * jax.random.normal(ks[4], (DEPTH, B_VDIM), f)
    w_out = jax.random.normal(ks[5], (DEPTH, MIX_WIDTH, D_MODEL), f) * (MIX_WIDTH ** -0.5) * BETA
    ln1_g = 1.0 + 0.02 * jax.random.normal(ks[6], (DEPTH, D_MODEL), f)
    ln1_b = 0.02 * jax.random.normal(ks[7], (DEPTH, D_MODEL), f)
    peer_wq = jax.random.normal(ks[8], (DEPTH, D_MODEL, PEER_HEADS * PEER_QDIM), f) * (D_MODEL ** -0.5)
    peer_keys = jax.random.normal(ks[9], (DEPTH, PEER_HEADS, 2, N_KEYS, PEER_HALF), f) * (PEER_HALF ** -0.5)
    peer_u = jax.random.normal(ks[10], (DEPTH, N_EXPERTS, D_MODEL), f) * (D_MODEL ** -0.5)
    peer_v = jax.random.normal(ks[11], (DEPTH, N_EXPERTS, D_MODEL), f) * BETA * (PEER_HEADS ** -0.5)
    ln2_g = 1.0 + 0.02 * jax.random.normal(ks[12], (DEPTH, D_MODEL), f)
    ln2_b = 0.02 * jax.random.normal(ks[13], (DEPTH, D_MODEL), f)
    return {'x': x, 'w_in': w_in, 'attn_sinks': attn_sinks, 'diff_lambda': diff_lambda,
            'diff_norm_g': diff_norm_g, 'w_out': w_out, 'ln1_g': ln1_g, 'ln1_b': ln1_b,
            'peer_wq': peer_wq, 'peer_keys': peer_keys, 'peer_u': peer_u, 'peer_v': peer_v,
            'ln2_g': ln2_g, 'ln2_b': ln2_b}


def reference(x, w_in, attn_sinks, diff_lambda, diff_norm_g, w_out, ln1_g, ln1_b,
              peer_wq, peer_keys, peer_u, peer_v, ln2_g, ln2_b):
    L = x.shape[1]
    cos, sin = rope_tables(L)
    for i in range(DEPTH):
        y = hybrid_mixer(x, w_in[i], attn_sinks[i], diff_lambda[i], diff_norm_g[i], w_out[i], i, cos, sin)
        x = layer_norm(ALPHA * x + y, ln1_g[i], ln1_b[i])
        y = peer_ffn(x, peer_wq[i], peer_keys[i], peer_u[i], peer_v[i])
        x = layer_norm(ALPHA * x + y, ln2_g[i], ln2_b[i])
    return x
```

```cpp
#include <hip/hip_runtime.h>
#include <hip/hip_bf16.h>
#include <cstdio>
#include <cstdint>
#include <cmath>
namespace pg8 {
#define PG8_LAS __attribute__((address_space(3)))
typedef unsigned short bf16_t;
typedef short bf16x8 __attribute__((ext_vector_type(8)));
typedef float f32x4 __attribute__((ext_vector_type(4)));
typedef unsigned u32x4 __attribute__((ext_vector_type(4)));
constexpr int BM = 256, BK = 64, HALF = 128, HTB = HALF * BK * 2  , STAGE_BYTES = 8 * HTB, NXCD = 8, WGM = 8;

__host__ __device__ __forceinline__ int lds_byte(int r, int c) { const int st = (r >> 4) * 2 + (c >> 5), rr = r & 15, cc = c & 31, ob = rr * 64 + cc * 2; return st * 1024 + (ob ^ (((ob >> 9) & 1) << 5)); }
__host__ __device__ __forceinline__ void stage_rc(int b, int& R, int& C) { const int st = b / 1024, sb = b % 1024, swz = sb ^ (((sb >> 9) & 1) << 5); R = (st >> 1) * 16 + swz / 64; C = (st & 1) * 32 + (swz % 64) / 2; }
__host__ __device__ __forceinline__ int perm32(int rho) { const int n = rho >> 4, i = rho & 15; return 8 * (i >> 2) + 4 * n + (i & 3); }

struct Unit { int pm, pn; };
struct Gemm { const bf16_t* A; const bf16_t* Bt; int M, N, K; };

struct StaticOrder {
    int nM, nN, nwg, G, c;
    __host__ __device__ void init(int M, int N, int G_, int c_) { nM = M / BM; nN = N / BM; nwg = nM * nN; G = G_; c = c_; }
    __host__ __device__ bool next(int i, Unit& u) const {
        const long L = (long)i * G + c; if (L >= nwg) return false;
        int wgid = (int)L; { const int q = nwg / NXCD, r = nwg % NXCD, xcd = wgid % NXCD, off = wgid / NXCD; wgid = (xcd < r ? xcd * (q + 1) : r * (q + 1) + (xcd - r) * q) + off; }
        const int nig = WGM * nN, gid = wgid / nig, fm = gid * WGM, gsz = (nM - fm) < WGM ? (nM - fm) : WGM;
        u.pm = fm + ((wgid % nig) % gsz); u.pn = (wgid % nig) / gsz; return true;
    }
    __device__ __forceinline__ void a_ready(const Unit&) const {}
    __device__ __forceinline__ void done(const Unit&) const {}
};

__device__ __forceinline__ unsigned cvt_pk_bf16(float lo, float hi) { unsigned r; asm volatile("v_cvt_pk_bf16_f32 %0, %1, %2" : "=v"(r) : "v"(lo), "v"(hi)); return r; }
typedef float f32x2 __attribute__((ext_vector_type(2)));
__device__ __forceinline__ f32x2 gelu_pk(f32x2 v) {
    const f32x2 av = __builtin_elementwise_abs(v), d = av * 0.2316418882f + 1.0f;
    f32x2 t; t.x = __builtin_amdgcn_rcpf(d.x); t.y = __builtin_amdgcn_rcpf(d.y);
    f32x2 q = t * 0.5307027145f + (-0.7265760135f); q = q * t + 0.7107068705f; q = q * t + (-0.142248368f); q = q * t + 0.127414796f; q = q * t;
    const f32x2 s = (v * v) * (-0.72134752044f);
    f32x2 e; e.x = __builtin_amdgcn_exp2f(s.x); e.y = __builtin_amdgcn_exp2f(s.y);
    const f32x2 m = v * (q * e), r = v - m;
    f32x2 o; o.x = v.x < 0.f ? m.x : r.x; o.y = v.y < 0.f ? m.y : r.y; return o;
}

template <int ACT  > struct EpiBf16 {
    static constexpr bool PERM = true, AFTER_DRAIN = false; static_assert(ACT == 0 || ACT == 1, "EpiBf16: ACT is 0 (none) or 1 (gelu_pk)");
    bf16_t* O; int ldc; const float* bias; int split_cols; size_t split_stride; float scale0;
    __device__ __forceinline__ void operator()(const f32x4 (&acc)[2][2][4][2], const Unit& u, int wr, int wc, int fr, int fq) const {
        const int row0 = u.pm * BM + wr * 64 + fr; int colt = u.pn * BM; bf16_t* base = O;
        float sc = 1.f; if (split_cols) { const int t = colt / split_cols; base += (size_t)t * split_stride; colt -= t * split_cols; if (t == 0) sc = scale0; }
        const int col0 = colt + wc * 32 + 8 * fq, bcol0 = u.pn * BM + wc * 32 + 8 * fq;
        f32x4 bv[2][2];
#pragma unroll
        for (int bj = 0; bj < 2; ++bj)
#pragma unroll
            for (int n = 0; n < 2; ++n) bv[bj][n] = bias ? *(const f32x4*)(bias + bcol0 + bj * HALF + 4 * n) : (f32x4){0.f, 0.f, 0.f, 0.f};
#pragma unroll
        for (int ai = 0; ai < 2; ++ai)
#pragma unroll
            for (int m = 0; m < 4; ++m) { bf16_t* rowp = base + (size_t)(row0 + ai * HALF + m * 16) * ldc + col0;
#pragma unroll
                for (int bj = 0; bj < 2; ++bj) { f32x4 v0 = acc[ai][bj][m][0] + bv[bj][0], v1 = acc[ai][bj][m][1] + bv[bj][1];
                    if (ACT == 1) { f32x2 a = gelu_pk((f32x2){v0[0], v0[1]}), b = gelu_pk((f32x2){v0[2], v0[3]}), c = gelu_pk((f32x2){v1[0], v1[1]}), d = gelu_pk((f32x2){v1[2], v1[3]});
                        v0 = (f32x4){a.x, a.y, b.x, b.y}; v1 = (f32x4){c.x, c.y, d.x, d.y}; }
                    v0 = v0 * sc; v1 = v1 * sc; u32x4 w; w.x = cvt_pk_bf16(v0[0], v0[1]); w.y = cvt_pk_bf16(v0[2], v0[3]); w.z = cvt_pk_bf16(v1[0], v1[1]); w.w = cvt_pk_bf16(v1[2], v1[3]);
                    *(u32x4*)(rowp + bj * HALF) = w; } }
    }
};

__device__ __forceinline__ bool chunk_is_rope(int c) { return (c < 10) || (c >= 12 && c < 28) || (c >= 36 && c < 52) || (c >= 60 && c < 69) || (c >= 70 && c < 79); }
__device__ __forceinline__ float chunk_scale(int c) {
    const float C2 = 0.125f * 1.4426950408889634f;
    if (c < 8 || (c >= 12 && c < 20) || (c >= 36 && c < 44) || (c >= 60 && c < 68)) return C2;
    if (c >= 70 && c < 78) return 0.125f;
    return 1.0f;
}
struct EpiInProj {
    static constexpr bool PERM = true, AFTER_DRAIN = false;
    bf16_t* O; int ldc; const float* cosT; const float* sinT;
    __device__ __forceinline__ void operator()(const f32x4 (&acc)[2][2][4][2], const Unit& u, int wr, int wc, int fr, int fq) const {
        const int row0 = u.pm * BM + wr * 64 + fr;
#pragma unroll
        for (int bj = 0; bj < 2; ++bj) {
            const int col0 = u.pn * BM + bj * HALF + wc * 32 + 8 * fq;
            const int chunk = __builtin_amdgcn_readfirstlane(col0 >> 6);
            const bool rope = chunk_is_rope(chunk); const float sc = chunk_scale(chunk);
            const int i0 = (col0 & 63) >> 1;
#pragma unroll
            for (int ai = 0; ai < 2; ++ai)
#pragma unroll
                for (int m = 0; m < 4; ++m) {
                    const int row = row0 + ai * HALF + m * 16;
                    f32x4 v0 = acc[ai][bj][m][0], v1 = acc[ai][bj][m][1];
                    if (rope) {
                        const f32x4 c = *(const f32x4*)(cosT + (size_t)row * 32 + i0), s = *(const f32x4*)(sinT + (size_t)row * 32 + i0);
                        f32x4 y0, y1;
                        y0[0] = v0[0] * c[0] - v0[1] * s[0]; y0[1] = v0[0] * s[0] + v0[1] * c[0];
                        y0[2] = v0[2] * c[1] - v0[3] * s[1]; y0[3] = v0[2] * s[1] + v0[3] * c[1];
                        y1[0] = v1[0] * c[2] - v1[1] * s[2]; y1[1] = v1[0] * s[2] + v1[1] * c[2];
                        y1[2] = v1[2] * c[3] - v1[3] * s[3]; y1[3] = v1[2] * s[3] + v1[3] * c[3];
                        v0 = y0; v1 = y1;
                    }
                    v0 = v0 * sc; v1 = v1 * sc;
                    u32x4 w; w.x = cvt_pk_bf16(v0[0], v0[1]); w.y = cvt_pk_bf16(v0[2], v0[3]); w.z = cvt_pk_bf16(v1[0], v1[1]); w.w = cvt_pk_bf16(v1[2], v1[3]);
                    *(u32x4*)(O + (size_t)row * ldc + col0) = w;
                }
        }
    }
};
struct EpiResid {
    static constexpr bool PERM = false, AFTER_DRAIN = false;
    float* Z; const float* X; int ldc; float alpha;
    __device__ __forceinline__ void operator()(const f32x4 (&acc)[2][2][4][2], const Unit& u, int wr, int wc, int fr, int fq) const {
        const int row0 = u.pm * BM + wr * 64 + fr, col0 = u.pn * BM + wc * 32 + 4 * fq;
#pragma unroll
        for (int ai = 0; ai < 2; ++ai)
#pragma unroll
            for (int m = 0; m < 4; ++m) {
                const size_t off = (size_t)(row0 + ai * HALF + m * 16) * ldc + col0;
#pragma unroll
                for (int bj = 0; bj < 2; ++bj)
#pragma unroll
                    for (int n = 0; n < 2; ++n) { const f32x4 xv = *(const f32x4*)(X + off + bj * HALF + n * 16); *(f32x4*)(Z + off + bj * HALF + n * 16) = xv * alpha + acc[ai][bj][m][n]; }
            }
    }
};
template <class Epi, class Sched, bool ALIGN_EPI = false, bool SP2 = false>
__device__ __forceinline__ void gemm_phase(PG8_LAS unsigned char* lds, const Gemm g, const Sched& S, const Epi& E) {
    int tid_ = threadIdx.x; asm volatile("" : "+v"(tid_));
    const int tid = tid_, wid = __builtin_amdgcn_readfirstlane(tid >> 6), lane = tid & 63, wr = wid >> 2, wc = wid & 3, fr = lane & 15, fq = lane >> 4;
    const int K = g.K, nt = K / BK;
    unsigned voffA[2], voffB[2];
#pragma unroll
    for (int i = 0; i < 2; ++i) { int R, C; stage_rc(tid * 16 + i * 8192, R, C); const int Rb = Epi::PERM ? ((R & ~31) + perm32(R & 31)) : R;
        voffA[i] = (unsigned)(R * K + C) * 2u; voffB[i] = (unsigned)(Rb * K + C) * 2u; }
    const size_t kstep = (size_t)(BK * 2);
    const size_t hstep = (size_t)HALF * K * 2;
    const size_t tstep = 2 * hstep;
    const unsigned ldsw = (unsigned)wid * 1024u;
    const int aoff = lds_byte(wr * 64 + fr, fq * 8), boff = lds_byte(wc * 32 + fr, fq * 8);
#define PG8_SA(b, h) (((b) * 2 + (h)) * HTB)
#define PG8_SB(b, h) ((4 + (b) * 2 + (h)) * HTB)
#define PG8_STAGE(bufoff, gbase, voff) do { _Pragma("unroll") for (int _i = 0; _i < 2; ++_i) \
        __builtin_amdgcn_global_load_lds((const unsigned*)((const char*)(gbase) + (voff)[_i]), (PG8_LAS unsigned*)(lds + (bufoff) + ldsw + _i * 8192), 16, 0, 0); } while (0)
#define PG8_LDA(dst, b, h) do { _Pragma("unroll") for (int m = 0; m < 4; ++m) _Pragma("unroll") for (int k = 0; k < 2; ++k) dst[m][k] = *(const PG8_LAS bf16x8*)(lds + PG8_SA(b, h) + aoff + m * 2048 + k * 1024); } while (0)
#define PG8_LDB(dst, b, h) do { _Pragma("unroll") for (int n = 0; n < 2; ++n) _Pragma("unroll") for (int k = 0; k < 2; ++k) dst[n][k] = *(const PG8_LAS bf16x8*)(lds + PG8_SB(b, h) + boff + n * 2048 + k * 1024); } while (0)
#define PG8_MMA(ai, bj, At, Bt) do { __builtin_amdgcn_s_setprio(1); _Pragma("unroll") for (int m = 0; m < 4; ++m) _Pragma("unroll") for (int n = 0; n < 2; ++n) _Pragma("unroll") for (int k = 0; k < 2; ++k) \
        acc[ai][bj][m][n] = __builtin_amdgcn_mfma_f32_16x16x32_bf16(Bt[n][k], At[m][k], acc[ai][bj][m][n], 0, 0, 0); __builtin_amdgcn_s_setprio(0); } while (0)
#define PG8_WAIT_V(n) asm volatile("s_waitcnt vmcnt(" #n ")" ::: "memory")
#define PG8_WAIT_L(n) asm volatile("s_waitcnt lgkmcnt(" #n ")" ::: "memory")
#define PG8_BAR __builtin_amdgcn_s_barrier()
#define PG8_SCHED __builtin_amdgcn_sched_barrier(0)
    Unit cur, nxt; int ui = 0;
    if (!S.next(0, cur)) return;
    f32x4 acc[2][2][4][2];
#pragma unroll
    for (int a = 0; a < 2; ++a)
#pragma unroll
        for (int b = 0; b < 2; ++b)
#pragma unroll
            for (int m = 0; m < 4; ++m)
#pragma unroll
                for (int n = 0; n < 2; ++n) acc[a][b][m][n] = (f32x4){0.f, 0.f, 0.f, 0.f};
    bf16x8 At[4][2], B0[2][2], B1[2][2];
    const char* cA = (const char*)g.A + (size_t)cur.pm * tstep; const char* cB = (const char*)g.Bt + (size_t)cur.pn * tstep;
    S.a_ready(cur);
    if constexpr (SP2) {
        PG8_STAGE(PG8_SB(0, 0), cB, voffB); PG8_STAGE(PG8_SB(0, 1), cB + hstep, voffB); PG8_STAGE(PG8_SA(0, 0), cA, voffA); PG8_STAGE(PG8_SA(0, 1), cA + hstep, voffA);
        if (wr == 1) PG8_BAR;
        PG8_WAIT_V(2); PG8_BAR;
        PG8_STAGE(PG8_SB(1, 0), cB + kstep, voffB); PG8_STAGE(PG8_SA(1, 0), cA + kstep, voffA); PG8_STAGE(PG8_SB(1, 1), cB + hstep + kstep, voffB);
        PG8_WAIT_V(6); PG8_BAR;
    } else {
        PG8_STAGE(PG8_SB(0, 0), cB, voffB); PG8_STAGE(PG8_SA(0, 0), cA, voffA); PG8_STAGE(PG8_SB(0, 1), cB + hstep, voffB); PG8_STAGE(PG8_SA(0, 1), cA + hstep, voffA);
        if (wr == 1) PG8_BAR;
        PG8_WAIT_V(4); PG8_BAR;
        PG8_STAGE(PG8_SB(1, 0), cB + kstep, voffB); PG8_STAGE(PG8_SA(1, 0), cA + kstep, voffA); PG8_STAGE(PG8_SB(1, 1), cB + hstep + kstep, voffB);
        PG8_WAIT_V(6); PG8_BAR;
    }
    for (;;) {
        const bool has_next = S.next(ui + 1, nxt);
        const char* nA = has_next ? (const char*)g.A + (size_t)nxt.pm * tstep : cA; const char* nB = has_next ? (const char*)g.Bt + (size_t)nxt.pn * tstep : cB;
        for (int t = 0; t < nt; t += 2) {
            const bool last = (t == nt - 2);
            const char* a1 = cA + (size_t)(t + 1) * kstep;
            const char* a2 = last ? nA : cA + (size_t)(t + 2) * kstep; const char* b2 = last ? nB : cB + (size_t)(t + 2) * kstep;
            const char* a3 = a2 + kstep; const char* b3 = b2 + kstep;
            if (last && has_next) S.a_ready(nxt);
            if constexpr (SP2) {
            PG8_LDB(B0, 0, 0); PG8_LDB(B1, 0, 1); PG8_SCHED; PG8_LDA(At, 0, 0); PG8_STAGE(PG8_SA(1, 1), a1 + hstep, voffA);
            PG8_WAIT_V(8); PG8_WAIT_L(0); PG8_BAR; PG8_MMA(0, 0, At, B0); PG8_MMA(0, 1, At, B1); PG8_BAR; PG8_SCHED;
            PG8_LDA(At, 0, 1); PG8_STAGE(PG8_SB(0, 0), b2, voffB); PG8_STAGE(PG8_SB(0, 1), b2 + hstep, voffB); PG8_STAGE(PG8_SA(0, 0), a2, voffA);
            PG8_WAIT_V(8); PG8_WAIT_L(0); PG8_BAR; PG8_MMA(1, 0, At, B0); PG8_MMA(1, 1, At, B1); PG8_BAR; PG8_SCHED;
            PG8_LDB(B0, 1, 0); PG8_LDB(B1, 1, 1); PG8_SCHED; PG8_LDA(At, 1, 0); PG8_STAGE(PG8_SA(0, 1), a2 + hstep, voffA);
            PG8_WAIT_V(8); PG8_WAIT_L(0); PG8_BAR; PG8_MMA(0, 0, At, B0); PG8_MMA(0, 1, At, B1); PG8_BAR; PG8_SCHED;
            PG8_LDA(At, 1, 1); PG8_STAGE(PG8_SB(1, 0), b3, voffB); PG8_STAGE(PG8_SB(1, 1), b3 + hstep, voffB); PG8_STAGE(PG8_SA(1, 0), a3, voffA);
            PG8_WAIT_V(8); PG8_WAIT_L(0); PG8_BAR; PG8_MMA(1, 0, At, B0); PG8_MMA(1, 1, At, B1); PG8_BAR; PG8_SCHED;
            } else {
            PG8_LDB(B0, 0, 0); PG8_SCHED; PG8_LDA(At, 0, 0); PG8_STAGE(PG8_SA(1, 1), a1 + hstep, voffA);
            PG8_WAIT_L(8); PG8_BAR; PG8_WAIT_L(0); PG8_MMA(0, 0, At, B0); PG8_BAR; PG8_SCHED;
            PG8_LDB(B1, 0, 1); PG8_STAGE(PG8_SB(0, 0), b2, voffB);
            PG8_BAR; PG8_WAIT_L(0); PG8_MMA(0, 1, At, B1); PG8_BAR;
            PG8_LDA(At, 0, 1); PG8_STAGE(PG8_SA(0, 0), a2, voffA);
            PG8_BAR; PG8_WAIT_L(0); PG8_MMA(1, 0, At, B0); PG8_BAR; PG8_SCHED;
            PG8_STAGE(PG8_SB(0, 1), b2 + hstep, voffB);
            PG8_WAIT_V(6); PG8_BAR; PG8_MMA(1, 1, At, B1); PG8_BAR;
            PG8_LDB(B0, 1, 0); PG8_SCHED; PG8_LDA(At, 1, 0); PG8_STAGE(PG8_SA(0, 1), a2 + hstep, voffA);
            PG8_WAIT_L(8); PG8_BAR; PG8_WAIT_L(0); PG8_MMA(0, 0, At, B0); PG8_BAR; PG8_SCHED;
            PG8_LDB(B1, 1, 1); PG8_STAGE(PG8_SB(1, 0), b3, voffB);
            PG8_BAR; PG8_WAIT_L(0); PG8_MMA(0, 1, At, B1); PG8_BAR;
            PG8_LDA(At, 1, 1); PG8_STAGE(PG8_SA(1, 0), a3, voffA);
            PG8_BAR; PG8_WAIT_L(0); PG8_MMA(1, 0, At, B0); PG8_BAR; PG8_SCHED;
            PG8_STAGE(PG8_SB(1, 1), b3 + hstep, voffB);
            PG8_WAIT_V(6); PG8_BAR; PG8_MMA(1, 1, At, B1); PG8_BAR;
            }
        }
        if constexpr (ALIGN_EPI) { if (wr == 0) PG8_BAR; }
        if constexpr (!Epi::AFTER_DRAIN) { E(acc, cur, wr, wc, fr, fq); S.done(cur); }
        if (!has_next) break;
#pragma unroll
        for (int a = 0; a < 2; ++a)
#pragma unroll
            for (int b = 0; b < 2; ++b)
#pragma unroll
                for (int m = 0; m < 4; ++m)
#pragma unroll
                    for (int n = 0; n < 2; ++n) acc[a][b][m][n] = (f32x4){0.f, 0.f, 0.f, 0.f};
        cur = nxt; cA = nA; cB = nB; ++ui;
        if constexpr (ALIGN_EPI) { if (wr == 1) PG8_BAR; }
    }
    PG8_WAIT_V(0);
    if constexpr (!ALIGN_EPI) { if (wr == 0) PG8_BAR; }
    PG8_BAR;
    if constexpr (Epi::AFTER_DRAIN) { E.fused(acc, cur, wr, wc, fr, fq, lds, wid, lane); S.done(cur); }
#undef PG8_SA
#undef PG8_SB
#undef PG8_STAGE
#undef PG8_LDA
#undef PG8_LDB
#undef PG8_MMA
#undef PG8_WAIT_V
#undef PG8_WAIT_L
#undef PG8_BAR
#undef PG8_SCHED
}
}
namespace attn_body {
using bf16=__hip_bfloat16;
using bf16x8=__attribute__((ext_vector_type(8)))short;
using s16x4=__attribute__((ext_vector_type(4)))short;
using f32x16=__attribute__((ext_vector_type(16)))float;
using u32x4=__attribute__((ext_vector_type(4)))unsigned;
constexpr int SEQ=8192,D=64,DM=5120,ODM=1024;
constexpr int NW=8,QBLK=32,QB=QBLK*NW,KVBLK=64,NQB=SEQ/QB;
constexpr int ATTN_PITCH=DM, ATTN_UNIT_ROWS=QB;
__device__ __forceinline__ int crow(int r,int hi){return (r&3)+8*(r>>2)+4*hi;}
#define SBAR() __builtin_amdgcn_sched_barrier(0)
__device__ __forceinline__ void cmask(f32x16&p0,f32x16&p1,int jb,int qrel,int hi){
  const float NEG=-INFINITY; int kb=64*jb+4*hi;
  #pragma unroll
  for(int r=0;r<16;++r){int kv=kb+(r&3)+8*(r>>2); if(kv>qrel)p0[r]=NEG; if(kv+32>qrel)p1[r]=NEG;}
}

constexpr int NSLOT=3, SLOTB=8192;
constexpr int LDS_K=0, LDS_V=NSLOT*SLOTB, LDS_WS=2*NSLOT*SLOTB, LDS_OST=LDS_WS+NW*64*4, LDS_BYTES=LDS_OST+NW*4096;
constexpr float C2=0.125f*1.4426950408889634f;
__device__ __forceinline__ void glds16(const void*gsrc,unsigned lds_dst){unsigned keep;
  asm volatile("s_mov_b32 %0, m0\n\ts_mov_b32 m0, %2\n\ts_nop 0\n\tglobal_load_lds_dwordx4 %1, off\n\ts_mov_b32 m0, %0":"=&s"(keep):"v"(gsrc),"s"(lds_dst):"memory");}
__device__ __forceinline__ float max3f(float a,float b,float c){float r;asm("v_max3_f32 %0, %1, %2, %3":"=v"(r):"v"(a),"v"(b),"v"(c));return r;}
__device__ __forceinline__ float max2f(float a,float b){float r;asm("v_max_f32_e32 %0, %1, %2":"=v"(r):"v"(a),"v"(b));return r;}
__device__ __forceinline__ float fadd_s(float a,float b){float r;asm("v_add_f32_e32 %0, %1, %2":"=v"(r):"v"(a),"v"(b));return r;}
__device__ __forceinline__ float fsub_s(float a,float b){float r;asm("v_sub_f32_e32 %0, %1, %2":"=v"(r):"v"(a),"v"(b));return r;}
typedef float f32x2_t __attribute__((ext_vector_type(2))); typedef __bf16 bf16x2_t __attribute__((ext_vector_type(2)));
__device__ __forceinline__ unsigned cvtpk_s(float lo,float hi){f32x2_t v={lo,hi};bf16x2_t b=__builtin_convertvector(v,bf16x2_t);return __builtin_bit_cast(unsigned,b);}
#define WAIT_BAR(N) asm volatile("s_waitcnt vmcnt(" #N ") lgkmcnt(0)\n\ts_barrier":::"memory")

__device__ __forceinline__ void qkt(f32x16&p0,f32x16&p1,const char*Kslot,const bf16x8*qr,const f32x16&negm,int r32,int hi){
  const char*kb=Kslot+hi*1024+r32*16;
  #pragma unroll
  for(int d0=0;d0<4;++d0){
    const bf16x8 b0=*reinterpret_cast<const bf16x8*>(kb+d0*2048);
    const bf16x8 b1=*reinterpret_cast<const bf16x8*>(kb+d0*2048+512);
    if(d0==0){p0=__builtin_amdgcn_mfma_f32_32x32x16_bf16(b0,qr[0],negm,0,0,0);p1=__builtin_amdgcn_mfma_f32_32x32x16_bf16(b1,qr[0],negm,0,0,0);}
    else{p0=__builtin_amdgcn_mfma_f32_32x32x16_bf16(b0,qr[d0],p0,0,0,0);p1=__builtin_amdgcn_mfma_f32_32x32x16_bf16(b1,qr[d0],p1,0,0,0);}}
}
typedef __attribute__((address_space(3))) const char* lds_cptr;
typedef short v4i16_t __attribute__((ext_vector_type(4)));
__device__ __forceinline__ void kload8(bf16x8*kf,lds_cptr kp){
  kf[0]=*(const __attribute__((address_space(3))) bf16x8*)(kp);      kf[1]=*(const __attribute__((address_space(3))) bf16x8*)(kp+512);
  kf[2]=*(const __attribute__((address_space(3))) bf16x8*)(kp+2048); kf[3]=*(const __attribute__((address_space(3))) bf16x8*)(kp+2560);
  kf[4]=*(const __attribute__((address_space(3))) bf16x8*)(kp+4096); kf[5]=*(const __attribute__((address_space(3))) bf16x8*)(kp+4608);
  kf[6]=*(const __attribute__((address_space(3))) bf16x8*)(kp+6144); kf[7]=*(const __attribute__((address_space(3))) bf16x8*)(kp+6656);
}
__device__ __forceinline__ void kload2(bf16x8*kf,lds_cptr kp,int j){ kf[2*j]=*(const __attribute__((address_space(3))) bf16x8*)(kp+j*2048); kf[2*j+1]=*(const __attribute__((address_space(3))) bf16x8*)(kp+j*2048+512); }
__device__ __forceinline__ s16x4 vtr(lds_cptr p){ return __builtin_bit_cast(s16x4,__builtin_amdgcn_ds_read_tr16_b64_v4i16((__attribute__((address_space(3))) v4i16_t*)p)); }
__device__ __forceinline__ float rowmax(const f32x16&p0,const f32x16&p1){
  float a=max3f(p0[0],p0[1],p1[0]),b=max3f(p0[2],p0[3],p1[1]);a=max3f(a,p1[2],p1[3]);
  #pragma unroll
  for(int r=4;r<16;r+=4){a=max3f(a,p0[r],p0[r+1]);b=max3f(b,p0[r+2],p0[r+3]);a=max3f(a,p1[r],p1[r+1]);b=max3f(b,p1[r+2],p1[r+3]);}
  const float m=max2f(a,b);
  auto rr=__builtin_amdgcn_permlane32_swap(__float_as_uint(m),__float_as_uint(m),false,false);
  return max2f(__uint_as_float(rr[0]),__uint_as_float(rr[1]));
}
__device__ __forceinline__ void pv(f32x16*o,int vb,bf16x8 pa0,bf16x8 pa1,bf16x8 pa2,bf16x8 pa3){
  #pragma unroll
  for(int d0=0;d0<2;++d0){s16x4 lo[4],hi[4];
    #pragma unroll
    for(int ks=0;ks<4;++ks){
      asm volatile("ds_read_b64_tr_b16 %0,%1 offset:%c2":"=&v"(lo[ks]):"v"(vb),"i"(d0*4096+ks*1024):"memory");
      asm volatile("ds_read_b64_tr_b16 %0,%1 offset:%c2":"=&v"(hi[ks]):"v"(vb),"i"(d0*4096+ks*1024+512):"memory");}
    asm volatile("s_waitcnt lgkmcnt(0)":::"memory");SBAR();
    #define PK(k) (bf16x8){lo[k][0],lo[k][1],lo[k][2],lo[k][3],hi[k][0],hi[k][1],hi[k][2],hi[k][3]}
    o[d0]=__builtin_amdgcn_mfma_f32_32x32x16_bf16(pa0,PK(0),o[d0],0,0,0);
    o[d0]=__builtin_amdgcn_mfma_f32_32x32x16_bf16(pa1,PK(1),o[d0],0,0,0);
    o[d0]=__builtin_amdgcn_mfma_f32_32x32x16_bf16(pa2,PK(2),o[d0],0,0,0);
    o[d0]=__builtin_amdgcn_mfma_f32_32x32x16_bf16(pa3,PK(3),o[d0],0,0,0);
    #undef PK
  }
}

#ifndef ATTN_STORE16
#define ATTN_STORE16(p,v) (*(u32x4*)(p)=(v))
#endif
template<int THRL> __device__ __forceinline__ void attn_unit(int qb,const bf16*Qh,const bf16* Kh,const bf16* Vh,bf16*Oh,char*shm){
  int tid_=threadIdx.x; asm volatile("":"+v"(tid_));
  const int tid=tid_,lane=tid&63,r32=lane&31,hi=lane>>5; const int wid=__builtin_amdgcn_readfirstlane(tid>>6);
  const int q0=qb*QB;
  const bf16*Qw=Qh+(long)(q0+wid*QBLK)*DM;
  const unsigned lds0=(unsigned)(uintptr_t)shm;
  float*wsf=(float*)(shm+LDS_WS)+wid*64;
  const bf16*ksrc=Kh+(long)lane*DM+wid*8;
  const bf16*vsrc=Vh+(long)(16*(wid&3)+(lane>>2))*DM+(wid>>2)*32+(lane&3)*8;
  const unsigned kdst=lds0+LDS_K+wid*1024, vdst=lds0+LDS_V+wid*1024;
  #define DMA_K(t,slot) glds16(ksrc+(long)(t)*KVBLK*DM,(unsigned)__builtin_amdgcn_readfirstlane(kdst+(slot)))
  #define DMA_V(t,slot) glds16(vsrc+(long)(t)*KVBLK*DM,(unsigned)__builtin_amdgcn_readfirstlane(vdst+(slot)))
  const int vb0=(int)(lds0+LDS_V)+((lane>>4)&1)*32+(lane&3)*8+(4*hi+((lane&15)>>2))*64;
  const char*Kbase=shm+LDS_K; bf16x8 kf[8];
  const lds_cptr shm3=(lds_cptr)shm; const lds_cptr kp0=shm3+LDS_K+hi*1024+r32*16; const lds_cptr vp0=shm3+LDS_V+((lane>>4)&1)*32+(lane&3)*8+(4*hi+((lane&15)>>2))*64;
  const int NT=(q0+QB)/KVBLK;
  DMA_K(0,0);DMA_V(0,0);DMA_K(1,SLOTB);
  bf16x8 qr[4];
  #pragma unroll
  for(int d0=0;d0<4;++d0)qr[d0]=*reinterpret_cast<const bf16x8*>(&Qw[(long)r32*DM+d0*16+hi*8]);
  float mhat=0.f,l_reg=0.f;f32x16 o[2];o[0]=f32x16{};o[1]=f32x16{};f32x16 negm=f32x16{};asm volatile("":"+v"(negm));
  const int qrel=wid*QBLK+r32;
  #define CMASK(P0,P1,t) do{int jb_=(t)-(NT-4); if(jb_>=0)cmask(P0,P1,jb_,qrel,hi);}while(0)
  bool resc=false;
  #define START(P0,P1) do{ const float rm=rowmax(P0,P1); resc=false; \
    { const float dl=rm; mhat=fadd_s(mhat,dl); \
      _Pragma("unroll") for(int r=0;r<16;++r){P0[r]=fsub_s(P0[r],dl);P1[r]=fsub_s(P1[r],dl);} \
      _Pragma("unroll") for(int r=0;r<16;++r)negm[r]=-mhat; asm volatile("":"+v"(negm)); } \
    _Pragma("unroll") for(int r=0;r<16;++r)P0[r]=__builtin_amdgcn_exp2f(P0[r]); }while(0)
  #define RESC() do{ if(resc){ asm volatile("s_waitcnt lgkmcnt(0)":::"memory"); \
      _Pragma("unroll") for(int d_=0;d_<2;++d_) _Pragma("unroll") for(int r=0;r<16;++r)o[d_][r]*=wsf[crow(r,hi)]; } }while(0)
  f32x16 pA0,pA1,pB0,pB1;
  int sl_prev=0,sl_cur=0,sl_next=SLOTB;
  #define ROT() do{sl_prev=sl_cur;sl_cur=sl_next;sl_next=(sl_next==(NSLOT-1)*SLOTB)?0:sl_next+SLOTB;}while(0)
  DMA_K(2,2*SLOTB);
  WAIT_BAR(3);
  qkt(pA0,pA1,Kbase,qr,negm,r32,hi);asm volatile("s_nop 15\n\ts_nop 7":"+v"(pA0),"+v"(pA1));CMASK(pA0,pA1,0);
  START(pA0,pA1);
  _Pragma("unroll") for(int r=0;r<16;++r)pA1[r]=__builtin_amdgcn_exp2f(pA1[r]);
  WAIT_BAR(0);
  DMA_K(3,0);DMA_V(1,SLOTB);
  ROT();
  kload8(kf,kp0+sl_cur);
  WAIT_BAR(2);
  s16x4 vlo[8],vhi[8]; u32x4 pw0,pw1,pw2,pw3;
  #define PKW(P,B) cvtpk_s(P[B],P[B+1])
  #define PAF(k) __builtin_bit_cast(bf16x8,pw##k)
  #define VFR(i) (bf16x8){vlo[i][0],vlo[i][1],vlo[i][2],vlo[i][3],vhi[i][0],vhi[i][1],vhi[i][2],vhi[i][3]}
  #define PIN(x) asm volatile("":"+v"(x))
  #define MX3(a,b,c) __builtin_fmaxf(__builtin_fmaxf((a),(b)),(c))
  #define GAPA(MF,A0,A1,A2,A3,W0,W1,PW) do{ MF; sacc+=A0; sacc+=A1; sacc+=A2; sacc+=A3; PIN(sacc); W0; W1; PIN(PW); SBAR(); }while(0)
  #define EX(v) __builtin_amdgcn_exp2f(v)
  #define GAPB(MF,X,B) do{ MF; X[B]=EX(X[B]); X[B+1]=EX(X[B+1]); X[B+2]=EX(X[B+2]); X[B+3]=EX(X[B+3]); PIN(X); SBAR(); }while(0)
  #define VRD(i) do{ vlo[i]=vtr(vp_+(((i)>>2)*4096+((i)&3)*1024)); vhi[i]=vtr(vp_+(((i)>>2)*4096+((i)&3)*1024+512)); }while(0)
  #define KRD(G,j) do{ if(G){ kload2(kf,kp0+sl_next,j); SBAR(); } }while(0)
  #define STEP(C0,C1,P0,P1,t,GK,GV,GL) do{ SBAR(); \
    const lds_cptr vp_=vp0+sl_prev; \
    VRD(0); SBAR(); float sacc=(P0[0]+P0[1]); \
    GAPA(C0=__builtin_amdgcn_mfma_f32_32x32x16_bf16(kf[0],qr[0],negm,0,0,0), P0[2],P0[3],P0[4],P0[5],     pw0[0]=PKW(P0,0), pw0[1]=PKW(P0,2), pw0); \
    VRD(4); SBAR(); GAPA(C1=__builtin_amdgcn_mfma_f32_32x32x16_bf16(kf[1],qr[0],negm,0,0,0), P0[6],P0[7],P0[8],P0[9],     pw0[2]=PKW(P0,4), pw0[3]=PKW(P0,6), pw0); \
    VRD(1); SBAR(); GAPA(C0=__builtin_amdgcn_mfma_f32_32x32x16_bf16(kf[2],qr[1],C0,0,0,0),   P0[10],P0[11],P0[12],P0[13], pw1[0]=PKW(P0,8), pw1[1]=PKW(P0,10), pw1); \
    VRD(5); SBAR(); GAPA(C1=__builtin_amdgcn_mfma_f32_32x32x16_bf16(kf[3],qr[1],C1,0,0,0),   P0[14],P0[15],P1[0],P1[1],   pw1[2]=PKW(P0,12),pw1[3]=PKW(P0,14), pw1); \
    VRD(2); SBAR(); GAPA(C0=__builtin_amdgcn_mfma_f32_32x32x16_bf16(kf[4],qr[2],C0,0,0,0),   P1[2],P1[3],P1[4],P1[5],     pw2[0]=PKW(P1,0), pw2[1]=PKW(P1,2), pw2); \
    VRD(6); SBAR(); GAPA(C1=__builtin_amdgcn_mfma_f32_32x32x16_bf16(kf[5],qr[2],C1,0,0,0),   P1[6],P1[7],P1[8],P1[9],     pw2[2]=PKW(P1,4), pw2[3]=PKW(P1,6), pw2); \
    VRD(3); SBAR(); GAPA(C0=__builtin_amdgcn_mfma_f32_32x32x16_bf16(kf[6],qr[3],C0,0,0,0),   P1[10],P1[11],P1[12],P1[13], pw3[0]=PKW(P1,8), pw3[1]=PKW(P1,10), pw3); \
    VRD(7); SBAR(); GAPA(C1=__builtin_amdgcn_mfma_f32_32x32x16_bf16(kf[7],qr[3],C1,0,0,0),   P1[14],P1[15],0.f,0.f,       pw3[2]=PKW(P1,12),pw3[3]=PKW(P1,14), pw3); \
    l_reg+=sacc; \
    if(GK){DMA_K((t)+3,sl_cur);} if(GV){DMA_V((t)+1,sl_next);} \
    CMASK(C0,C1,t); \
    { float a=MX3(C0[0],C0[1],C1[0]),b=MX3(C0[2],C0[3],C1[1]); a=MX3(a,C1[2],C1[3]); \
      _Pragma("unroll") for(int r=4;r<16;r+=4){a=MX3(a,C0[r],C0[r+1]);b=MX3(b,C0[r+2],C0[r+3]);a=MX3(a,C1[r],C1[r+1]);b=MX3(b,C1[r+2],C1[r+3]);} \
      float rm=__builtin_fmaxf(a,b); { auto rr=__builtin_amdgcn_permlane32_swap(__float_as_uint(rm),__float_as_uint(rm),false,false); rm=__builtin_fmaxf(__uint_as_float(rr[0]),__uint_as_float(rr[1])); } \
      resc=false; \
      if(__builtin_expect(__any(rm>(float)THRL),0)){ const float dl=__builtin_fmaxf(rm,0.f); mhat+=dl; \
        _Pragma("unroll") for(int r=0;r<16;++r){C0[r]-=dl;C1[r]-=dl;} \
        _Pragma("unroll") for(int r=0;r<16;++r)negm[r]=-mhat; asm volatile("":"+v"(negm)); \
        const float f=__builtin_amdgcn_exp2f(-dl); l_reg*=f; if(hi==0)wsf[r32]=f; resc=true; } } \
    SBAR(); \
    GAPB(o[0]=__builtin_amdgcn_mfma_f32_32x32x16_bf16(PAF(0),VFR(0),o[0],0,0,0), C0,0); \
    GAPB(o[1]=__builtin_amdgcn_mfma_f32_32x32x16_bf16(PAF(0),VFR(4),o[1],0,0,0), C0,4); \
    KRD(GL,0); GAPB(o[0]=__builtin_amdgcn_mfma_f32_32x32x16_bf16(PAF(1),VFR(1),o[0],0,0,0), C0,8); \
    KRD(GL,1); GAPB(o[1]=__builtin_amdgcn_mfma_f32_32x32x16_bf16(PAF(1),VFR(5),o[1],0,0,0), C0,12); \
    KRD(GL,2); GAPB(o[0]=__builtin_amdgcn_mfma_f32_32x32x16_bf16(PAF(2),VFR(2),o[0],0,0,0), C1,0); \
    KRD(GL,3); GAPB(o[1]=__builtin_amdgcn_mfma_f32_32x32x16_bf16(PAF(2),VFR(6),o[1],0,0,0), C1,4); \
    GAPB(o[0]=__builtin_amdgcn_mfma_f32_32x32x16_bf16(PAF(3),VFR(3),o[0],0,0,0), C1,8); \
    GAPB(o[1]=__builtin_amdgcn_mfma_f32_32x32x16_bf16(PAF(3),VFR(7),o[1],0,0,0), C1,12); \
    }while(0)
  int t=1;
  #undef CMASK
  #define CMASK(P0,P1,t) do{}while(0)
  for(;t+5<NT;t+=2){
    STEP(pB0,pB1,pA0,pA1,t,true,true,true);     WAIT_BAR(2); RESC(); ROT();
    STEP(pA0,pA1,pB0,pB1,t+1,true,true,true);   WAIT_BAR(2); RESC(); ROT();
  }
  #undef CMASK
  #define CMASK(P0,P1,t) do{int jb_=(t)-(NT-4); if(jb_>=0)cmask(P0,P1,jb_,qrel,hi);}while(0)
  #define ENDW(tt) do{ if((tt)+3<NT){WAIT_BAR(2);} else if((tt)+2<NT){WAIT_BAR(1);} else {WAIT_BAR(0);} }while(0)
  for(;t+1<NT;t+=2){
    STEP(pB0,pB1,pA0,pA1,t,(t+3<NT),(t+1<NT),(t+1<NT));       ENDW(t);   RESC(); ROT();
    STEP(pA0,pA1,pB0,pB1,t+1,(t+4<NT),(t+2<NT),(t+2<NT));     ENDW(t+1); RESC(); ROT();
  }
  STEP(pB0,pB1,pA0,pA1,NT-1,false,false,false); RESC();
  { float sacc=pB0[0]+pB0[1]; _Pragma("unroll") for(int r=2;r<16;++r)sacc+=pB0[r]; _Pragma("unroll") for(int r=0;r<16;++r)sacc+=pB1[r]; l_reg+=sacc;
    pw0=(u32x4){PKW(pB0,0),PKW(pB0,2),PKW(pB0,4),PKW(pB0,6)};pw1=(u32x4){PKW(pB0,8),PKW(pB0,10),PKW(pB0,12),PKW(pB0,14)};pw2=(u32x4){PKW(pB1,0),PKW(pB1,2),PKW(pB1,4),PKW(pB1,6)};pw3=(u32x4){PKW(pB1,8),PKW(pB1,10),PKW(pB1,12),PKW(pB1,14)};
    SBAR(); pv(o,vb0+sl_cur,PAF(0),PAF(1),PAF(2),PAF(3)); }
  #undef PKW
  #undef PAF
  #undef VFR
  #undef PIN
  #undef MX3
  #undef GAPA
  #undef GAPB
  #undef EX
  #undef VRD
  #undef KRD
  #undef STEP
  #undef ENDW
  {auto rr=__builtin_amdgcn_permlane32_swap(__float_as_uint(l_reg),__float_as_uint(l_reg),false,false);l_reg=__uint_as_float(rr[0])+__uint_as_float(rr[1]);}
  if(hi==0)wsf[32+r32]=l_reg;asm volatile("s_waitcnt lgkmcnt(0)":::"memory");
  float rli[16];
  #pragma unroll
  for(int r=0;r<16;++r)rli[r]=__builtin_amdgcn_rcpf(wsf[32+crow(r,hi)]);
  bf16*Ow=Oh+(long)(q0+wid*QBLK)*ODM;
  { bf16*stg=(bf16*)(shm+LDS_OST)+wid*2048;
    #pragma unroll
    for(int r=0;r<16;++r){const int orow=crow(r,hi);
      #pragma unroll
      for(int d0=0;d0<2;++d0)stg[orow*64+d0*32+r32]=__float2bfloat16(o[d0][r]*rli[r]);}
    asm volatile("s_waitcnt lgkmcnt(0)":::"memory");
    #pragma unroll
    for(int i=0;i<4;++i){const int row=i*8+(lane>>3),ch=lane&7; const u32x4 v=*(const u32x4*)(stg+row*64+ch*8); ATTN_STORE16(Ow+(long)row*ODM+ch*8,v);} }
  asm volatile("s_waitcnt lgkmcnt(0)\n\ts_barrier":::"memory");
  #undef DMA_K
  #undef DMA_V
  #undef CMASK
  #undef START
  #undef RESC
  #undef ROT
}
constexpr int ATTN_LDS_BYTES=LDS_BYTES;
#undef SBAR
#undef WAIT_BAR
}
#define GAS __attribute__((address_space(1)))
#define LAS __attribute__((address_space(3)))
typedef unsigned short bf16;
typedef unsigned v4u __attribute__((ext_vector_type(4)));
typedef float f32x4 __attribute__((ext_vector_type(4)));
typedef short bf16x8 __attribute__((ext_vector_type(8)));
typedef GAS unsigned gu32;
typedef GAS unsigned long long gu64;
#define RLX_AGENT __ATOMIC_RELAXED, __HIP_MEMORY_SCOPE_AGENT
#define LDS_WAIT() asm volatile("s_waitcnt lgkmcnt(0)" ::: "memory")
#define VM_WAIT() asm volatile("s_waitcnt vmcnt(0)" ::: "memory")
__device__ __forceinline__ unsigned long long rt() { return __builtin_amdgcn_s_memrealtime(); }
__device__ __forceinline__ unsigned f2bf(float f) { unsigned u = __builtin_bit_cast(unsigned, f); return (u + 0x7fffu + ((u >> 16) & 1u)) >> 16; }
__device__ __forceinline__ unsigned pk2(float lo, float hi) { return f2bf(lo) | (f2bf(hi) << 16); }

#define XB_TMO      128
#define XB_XCNT(j)  (256  + 64 * (j))
#define XB_XSUB(j)  (1280 + 64 * (j))
#define XB_XGEN(j)  (2304 + 64 * (j))
#define XB_TOP      3328
#define XB_TOPGEN   3392
#define XCD_BAR_WORDS 3456
#define XB_SPIN_CAP (1u << 18)

__device__ __forceinline__ unsigned xb_ld(unsigned* p)              { return __hip_atomic_load(p, __ATOMIC_RELAXED, __HIP_MEMORY_SCOPE_AGENT); }
__device__ __forceinline__ unsigned xb_add(unsigned* p, unsigned v) { return __hip_atomic_fetch_add(p, v, __ATOMIC_RELAXED, __HIP_MEMORY_SCOPE_AGENT); }
__device__ __forceinline__ unsigned xb_xcc_id() { return (unsigned)__builtin_amdgcn_s_getreg((3 << 11) | 20) & 0xFu; }
#define XB_SPIN(cond, bar) do { unsigned _sp = 0; while (cond) { __builtin_amdgcn_s_sleep(1); \
    if ((++_sp & 255u) == 0u) { if (xb_ld(&(bar)[XB_TMO])) break; if (_sp > XB_SPIN_CAP) { atomicAdd(&(bar)[XB_TMO], 1u); break; } } } } while (0)

struct XcdBarrier {
    unsigned* bar; unsigned x;
    volatile LAS unsigned* st;
};

__device__ __forceinline__ XcdBarrier xcd_barrier_post(unsigned* bar, volatile LAS unsigned* st) {
    XcdBarrier b; b.bar = bar; b.x = xb_xcc_id(); b.st = st;
    if (threadIdx.x == 0) (void)xb_add(&bar[XB_XCNT(b.x)], 1u);
    return b;
}
__device__ __forceinline__ void xcd_barrier_complete(unsigned* bar, unsigned x, unsigned& nloc, unsigned& nx) {
    const unsigned G = gridDim.x * gridDim.y * gridDim.z;
    unsigned sum, cnt, mine, sp = 0u;
    for (;;) {
        sum = 0u; cnt = 0u; mine = 0u;
#pragma unroll
        for (unsigned j = 0; j < 16; ++j) { const unsigned c = xb_ld(&bar[XB_XCNT(j)]); sum += c; cnt += (c > 0u) ? 1u : 0u; mine = (j == x) ? c : mine; }
        if (sum == G) break;
        __builtin_amdgcn_s_sleep(1);
        if ((++sp & 255u) == 0u) { if (xb_ld(&bar[XB_TMO])) break; if (sp > XB_SPIN_CAP) { atomicAdd(&bar[XB_TMO], 1u); break; } }
    }
    nloc = mine > 0u ? mine : 1u; nx = cnt > 0u ? cnt : 1u;
}

__device__ __forceinline__ void xcd_barrier(const XcdBarrier& b) {
    asm volatile("s_waitcnt vmcnt(0)" ::: "memory");
    __syncthreads();
    if (threadIdx.x == 0) {
        unsigned* bar = b.bar;
        __builtin_amdgcn_s_waitcnt(0);
        unsigned nloc = b.st[0], nx = b.st[1];
        if (nloc == 0u) { xcd_barrier_complete(bar, b.x, nloc, nx); b.st[0] = nloc; b.st[1] = nx; }
        const unsigned old = xb_add(&bar[XB_XSUB(b.x)], 1u);
        const unsigned gen = old / nloc;
        if (old + 1u == (gen + 1u) * nloc) {
            __builtin_amdgcn_fence(__ATOMIC_RELEASE, "agent");
            asm volatile("s_waitcnt vmcnt(0)" ::: "memory");
            const unsigned og = xb_add(&bar[XB_TOP], 1u);
            const unsigned tg = og / nx;
            if (og + 1u == (tg + 1u) * nx) xb_add(&bar[XB_TOPGEN], 1u);
            else XB_SPIN(xb_ld(&bar[XB_TOPGEN]) == tg, bar);
            __builtin_amdgcn_fence(__ATOMIC_ACQUIRE, "agent");
            xb_add(&bar[XB_XGEN(b.x)], 1u);
            asm volatile("s_waitcnt vmcnt(0)" ::: "memory");
        } else {
            XB_SPIN(xb_ld(&bar[XB_XGEN(b.x)]) == gen, bar);
            __builtin_amdgcn_fence(__ATOMIC_ACQUIRE, "agent");
            asm volatile("s_waitcnt vmcnt(0)" ::: "memory");
        }
    }
    __syncthreads();
}

namespace cw {
typedef unsigned short u16;
typedef short bf16x8 __attribute__((ext_vector_type(8)));
typedef float f32x16 __attribute__((ext_vector_type(16)));
typedef float f32x4 __attribute__((ext_vector_type(4)));
typedef unsigned u32x4 __attribute__((ext_vector_type(4)));
typedef unsigned u32x2 __attribute__((ext_vector_type(2)));
typedef __bf16 bf16x2_t __attribute__((ext_vector_type(2)));
#define CW_LAS __attribute__((address_space(3)))
constexpr int SEQ = 8192, DMODEL = 2048, PITCH = 5120;
constexpr int AQ = 0, AK = 512, AV = 640, BQ = 768, BK_ = 1280, BV = 1792, CQ = 2304, CK = 2816, CV = 3328, DQ = 3840, DK = 4352, DV = 4416, IQ = 4480, IK = 4992, IW = 5056;
constexpr float LOG2E = 1.4426950408889634f;
constexpr float NEGINF = -INFINITY;

__device__ __forceinline__ int crow(int r, int hi) { return (r & 3) + 8 * (r >> 2) + 4 * hi; }
__device__ __forceinline__ float bf2f(unsigned b) { return __uint_as_float(b << 16); }
__device__ __forceinline__ unsigned f2bf(float f) { unsigned u = __float_as_uint(f); return (u + 0x7fffu + ((u >> 16) & 1u)) >> 16; }
__device__ __forceinline__ unsigned pk2(float lo, float hi) { return f2bf(lo) | (f2bf(hi) << 16); }
__device__ __forceinline__ float ex2(float x) { return __builtin_amdgcn_exp2f(x); }
__device__ __forceinline__ float pair_max(float v) { auto rr = __builtin_amdgcn_permlane32_swap(__float_as_uint(v), __float_as_uint(v), false, false); return fmaxf(__uint_as_float(rr[0]), __uint_as_float(rr[1])); }
__device__ __forceinline__ float pair_sum(float v) { auto rr = __builtin_amdgcn_permlane32_swap(__float_as_uint(v), __float_as_uint(v), false, false); return __uint_as_float(rr[0]) + __uint_as_float(rr[1]); }
__device__ __forceinline__ float wave_sum(float v) {
#pragma unroll
    for (int o = 1; o < 64; o <<= 1) v += __shfl_xor(v, o);
    return v;
}
__device__ __forceinline__ bf16x8 ld8(const u16* p) { return *(const bf16x8*)p; }

struct BState { f32x16 o0, o1; float m, l; };
__device__ __forceinline__ void band_accum(BState& st, const bf16x8 (&qf)[4], const u16* Kb, const u16* Vb, int kres, int kdil, int pq, int pstart, int ntiles, int maxd, int lane) {
    const int r32 = lane & 31, hi = lane >> 5;
    const int pmax = (SEQ - 1 - kres) / kdil;
    for (int kt = 0; kt < ntiles; ++kt) {
        const int p0 = pstart + 32 * kt;
        int pk = p0 + r32; pk = pk > pmax ? pmax : pk;
        const u16* krow = Kb + (size_t)(kres + kdil * pk) * PITCH + 8 * hi;
        bf16x8 kf[4];
#pragma unroll
        for (int d0 = 0; d0 < 4; ++d0) kf[d0] = ld8(krow + 16 * d0);
        unsigned vw[2][2][4];
#pragma unroll
        for (int s = 0; s < 2; ++s)
#pragma unroll
            for (int j = 0; j < 8; j += 2) {
                int pa = p0 + 16 * s + (j & 3) + 8 * (j >> 2) + 4 * hi, pb = pa + 1;
                pa = pa > pmax ? pmax : pa; pb = pb > pmax ? pmax : pb;
                const u16* va = Vb + (size_t)(kres + kdil * pa) * PITCH + r32; const u16* vb = Vb + (size_t)(kres + kdil * pb) * PITCH + r32;
#pragma unroll
                for (int b = 0; b < 2; ++b) vw[s][b][j >> 1] = (unsigned)va[32 * b] | ((unsigned)vb[32 * b] << 16);
            }
        f32x16 s16 = {0.f, 0.f, 0.f, 0.f, 0.f, 0.f, 0.f, 0.f, 0.f, 0.f, 0.f, 0.f, 0.f, 0.f, 0.f, 0.f};
#pragma unroll
        for (int d0 = 0; d0 < 4; ++d0) s16 = __builtin_amdgcn_mfma_f32_32x32x16_bf16(kf[d0], qf[d0], s16, 0, 0, 0);
        float rm = NEGINF;
#pragma unroll
        for (int r = 0; r < 16; ++r) { const int dist = pq - (p0 + crow(r, hi)); const bool ok = (dist >= 0) && (dist <= maxd); s16[r] = ok ? s16[r] : NEGINF; rm = fmaxf(rm, s16[r]); }
        rm = pair_max(rm);
        const float mn = fmaxf(st.m, rm), mu = (mn == NEGINF) ? 0.f : mn;
        const float alpha = ex2(st.m - mu);
        float ps = 0.f;
#pragma unroll
        for (int r = 0; r < 16; ++r) { s16[r] = ex2(s16[r] - mu); ps += s16[r]; }
        ps = pair_sum(ps);
        st.l = st.l * alpha + ps; st.m = mn;
#pragma unroll
        for (int r = 0; r < 16; ++r) { st.o0[r] *= alpha; st.o1[r] *= alpha; }
#pragma unroll
        for (int s = 0; s < 2; ++s) {
            u32x4 pw; pw.x = pk2(s16[8 * s + 0], s16[8 * s + 1]); pw.y = pk2(s16[8 * s + 2], s16[8 * s + 3]); pw.z = pk2(s16[8 * s + 4], s16[8 * s + 5]); pw.w = pk2(s16[8 * s + 6], s16[8 * s + 7]);
            const bf16x8 pf = __builtin_bit_cast(bf16x8, pw);
            u32x4 v0; v0.x = vw[s][0][0]; v0.y = vw[s][0][1]; v0.z = vw[s][0][2]; v0.w = vw[s][0][3];
            u32x4 v1; v1.x = vw[s][1][0]; v1.y = vw[s][1][1]; v1.z = vw[s][1][2]; v1.w = vw[s][1][3];
            st.o0 = __builtin_amdgcn_mfma_f32_32x32x16_bf16(__builtin_bit_cast(bf16x8, v0), pf, st.o0, 0, 0, 0);
            st.o1 = __builtin_amdgcn_mfma_f32_32x32x16_bf16(__builtin_bit_cast(bf16x8, v1), pf, st.o1, 0, 0, 0);
        }
    }
}
__device__ __forceinline__ void bstate_init(BState& st) {
#pragma unroll
    for (int r = 0; r < 16; ++r) { st.o0[r] = 0.f; st.o1[r] = 0.f; }
    st.m = NEGINF; st.l = 0.f;
}
__device__ __forceinline__ void bstate_store(const BState& st, float f, u16* orow, int hi) {
#pragma unroll
    for (int b = 0; b < 2; ++b)
#pragma unroll
        for (int g = 0; g < 4; ++g) {
            const f32x16& o = b ? st.o1 : st.o0;
            u32x2 w; w.x = pk2(o[4 * g] * f, o[4 * g + 1] * f); w.y = pk2(o[4 * g + 2] * f, o[4 * g + 3] * f);
            *(u32x2*)(orow + 32 * b + 8 * g + 4 * hi) = w;
        }
}
__device__ __forceinline__ void swa_item(const u16* proj, u16* mixed, const float* sinks, int hq, int qt, int lane) {
    const int r32 = lane & 31, hi = lane >> 5, t0 = 32 * qt, kvh = hq >> 2;
    const u16* qrow = proj + (size_t)(t0 + r32) * PITCH + AQ + hq * 64 + 8 * hi;
    bf16x8 qf[4];
#pragma unroll
    for (int d0 = 0; d0 < 4; ++d0) qf[d0] = ld8(qrow + 16 * d0);
    BState st; bstate_init(st);
    int pstart = t0 - 127; pstart = pstart < 0 ? 0 : pstart;
    const int ntiles = (t0 + 31 - pstart) / 32 + 1;
    band_accum(st, qf, proj + AK + kvh * 64, proj + AV + kvh * 64, 0, 1, t0 + r32, pstart, ntiles, 127, lane);
    const float sink2 = sinks[hq] * LOG2E;
    const float mall = fmaxf(st.m, sink2), corr = ex2(st.m - mall), den = st.l * corr + ex2(sink2 - mall);
    bstate_store(st, corr / den, mixed + (size_t)(t0 + r32) * DMODEL + 0 + hq * 64, hi);
}
__device__ __forceinline__ void dil_item(const u16* proj, u16* mixed, int h, int r16, int jb, int lane) {
    const int r32 = lane & 31, hi = lane >> 5;
    const int tq = r16 + 16 * (32 * jb + r32);
    const int tq_lo = r16 + 16 * (32 * jb), tq_hi = tq_lo + 16 * 31;
    const u16* qrow = proj + (size_t)tq * PITCH + CQ + h * 64 + 8 * hi;
    bf16x8 qf[4];
#pragma unroll
    for (int d0 = 0; d0 < 4; ++d0) qf[d0] = ld8(qrow + 16 * d0);
    BState st; bstate_init(st);
    const u16* Kb = proj + CK + h * 64; const u16* Vb = proj + CV + h * 64;
    {
        int ps = tq_lo - 128; ps = ps < 0 ? 0 : ps; const int nt = (tq_hi - ps) / 32 + 1;
        band_accum(st, qf, Kb, Vb, 0, 1, tq, ps, nt, 128, lane);
    }
    {
        const int res = r16 & 3; int ps = (tq_lo >> 2) - 128; ps = ps < 0 ? 0 : ps; const int nt = ((tq_hi >> 2) - ps) / 32 + 1;
        band_accum(st, qf, Kb, Vb, res, 4, tq >> 2, ps, nt, 128, lane);
    }
    {
        int ps = (tq_lo >> 4) - 128; ps = ps < 0 ? 0 : ps; const int nt = ((tq_hi >> 4) - ps) / 32 + 1;
        band_accum(st, qf, Kb, Vb, r16, 16, tq >> 4, ps, nt, 128, lane);
    }
    bstate_store(st, 1.0f / st.l, mixed + (size_t)tq * DMODEL + 1024 + h * 64, hi);
}

__device__ __forceinline__ void idx_item(const u16* proj, float* scores, int qt, int c, int lane) {
    const int q = lane & 15, kq = lane >> 4, t = 16 * qt + q;
    const u16* qrow = proj + (size_t)t * PITCH + IQ + 8 * kq;
    bf16x8 qf[8][2];
#pragma unroll
    for (int h = 0; h < 8; ++h) { qf[h][0] = ld8(qrow + h * 64); qf[h][1] = ld8(qrow + h * 64 + 32); }
    float w[8];
    { const u32x4 wv = *(const u32x4*)(proj + (size_t)t * PITCH + IW);
      const float sc = 0.35355339059327373f;
      w[0] = bf2f(wv.x & 0xffffu) * sc; w[1] = bf2f(wv.x >> 16) * sc; w[2] = bf2f(wv.y & 0xffffu) * sc; w[3] = bf2f(wv.y >> 16) * sc;
      w[4] = bf2f(wv.z & 0xffffu) * sc; w[5] = bf2f(wv.z >> 16) * sc; w[6] = bf2f(wv.w & 0xffffu) * sc; w[7] = bf2f(wv.w >> 16) * sc; }
    const int kt_end = (32 * c + 31 < qt) ? 32 * c + 31 : qt;
    for (int kt = 32 * c; kt <= kt_end; ++kt) {
        const u16* krow = proj + (size_t)(16 * kt + q) * PITCH + IK + 8 * kq;
        const bf16x8 k0 = ld8(krow), k1 = ld8(krow + 32);
        f32x4 acc = {0.f, 0.f, 0.f, 0.f};
#pragma unroll
        for (int h = 0; h < 8; ++h) {
            f32x4 s4 = {0.f, 0.f, 0.f, 0.f};
            s4 = __builtin_amdgcn_mfma_f32_16x16x32_bf16(k0, qf[h][0], s4, 0, 0, 0);
            s4 = __builtin_amdgcn_mfma_f32_16x16x32_bf16(k1, qf[h][1], s4, 0, 0, 0);
#pragma unroll
            for (int r = 0; r < 4; ++r) acc[r] += w[h] * fmaxf(s4[r], 0.f);
        }
        *(f32x4*)(scores + (size_t)t * SEQ + 16 * kt + 4 * kq) = acc;
    }
}

__device__ __forceinline__ unsigned okey(float x) { unsigned u = __float_as_uint(x); if ((u << 1) == 0u) u = 0u; return (u & 0x80000000u) ? ~u : (u | 0x80000000u); }
template <int NB>
__device__ __forceinline__ int select_bin(CW_LAS unsigned* hist, int& k, int lane) {
    constexpr int PER = NB / 64;
    unsigned tot = 0;
#pragma unroll
    for (int i = 0; i < PER; ++i) tot += hist[lane * PER + i];
    unsigned incl = tot;
#pragma unroll
    for (int off = 1; off < 64; off <<= 1) { const unsigned tt = __shfl_down(incl, off); if (lane + off < 64) incl += tt; }
    const unsigned excl = incl - tot;
    const bool mine = (excl < (unsigned)k) && ((unsigned)k <= incl);
    int b = 0, kk = 0;
    if (mine) {
        unsigned cacc = excl;
        for (int i = PER - 1; i >= 0; --i) { const unsigned hc = hist[lane * PER + i]; if (cacc + hc >= (unsigned)k) { b = lane * PER + i; kk = k - (int)cacc; break; } cacc += hc; }
    }
    const unsigned long long mk = __ballot(mine);
    const int src = mk ? __builtin_ctzll(mk) : 0;
    b = __shfl(b, src); kk = __shfl(kk, src);
    k = kk;
    return b;
}
__device__ __forceinline__ void dsa_row(const u16* proj, const float* scores, u16* mixed, int t, CW_LAS unsigned char* ws_lds, int lane) {
    CW_LAS unsigned* hist = (CW_LAS unsigned*)ws_lds;
    CW_LAS float* Pl = (CW_LAS float*)ws_lds;
    CW_LAS int* idxl = (CW_LAS int*)(ws_lds + 8192);
    const float* srow = scores + (size_t)t * SEQ;
    const int n = t + 1; int nsel;
#ifdef NO_SEL
    if (true) {
#else
    if (n <= 256) {
#endif
        for (int i = lane; i < 256; i += 64) idxl[i] = (i < n) ? i : 0;
        nsel = n;
    } else {
        nsel = 256; int k = 256;
        for (int i = lane; i < 2048; i += 64) hist[i] = 0u;
        asm volatile("s_waitcnt lgkmcnt(0)" ::: "memory");
        for (int i = lane; i < n; i += 64) { const unsigned u = okey(srow[i]); __hip_atomic_fetch_add(hist + (u >> 21), 1u, __ATOMIC_RELAXED, __HIP_MEMORY_SCOPE_WAVEFRONT); }
        asm volatile("s_waitcnt lgkmcnt(0)" ::: "memory");
        const unsigned b1 = (unsigned)select_bin<2048>(hist, k, lane);
        asm volatile("s_waitcnt lgkmcnt(0)" ::: "memory");
        for (int i = lane; i < 2048; i += 64) hist[i] = 0u;
        asm volatile("s_waitcnt lgkmcnt(0)" ::: "memory");
        for (int i = lane; i < n; i += 64) { const unsigned u = okey(srow[i]); if ((u >> 21) == b1) __hip_atomic_fetch_add(hist + ((u >> 10) & 2047u), 1u, __ATOMIC_RELAXED, __HIP_MEMORY_SCOPE_WAVEFRONT); }
        asm volatile("s_waitcnt lgkmcnt(0)" ::: "memory");
        const unsigned b2 = (unsigned)select_bin<2048>(hist, k, lane);
        asm volatile("s_waitcnt lgkmcnt(0)" ::: "memory");
        const unsigned pre = (b1 << 11) | b2;
        for (int i = lane; i < 1024; i += 64) hist[i] = 0u;
        asm volatile("s_waitcnt lgkmcnt(0)" ::: "memory");
        for (int i = lane; i < n; i += 64) { const unsigned u = okey(srow[i]); if ((u >> 10) == pre) __hip_atomic_fetch_add(hist + (u & 1023u), 1u, __ATOMIC_RELAXED, __HIP_MEMORY_SCOPE_WAVEFRONT); }
        asm volatile("s_waitcnt lgkmcnt(0)" ::: "memory");
        const unsigned b3 = (unsigned)select_bin<1024>(hist, k, lane);
        asm volatile("s_waitcnt lgkmcnt(0)" ::: "memory");
        const unsigned T = (pre << 10) | b3; const int need_eq = k, cnt_gt = 256 - k;
        int cg = 0, ce = 0;
        const unsigned long long lt_mask = (1ull << lane) - 1ull;
        for (int base = 0; base < n; base += 64) {
            const int i = base + lane; const bool v = i < n; const unsigned u = v ? okey(srow[i]) : 0u;
            const bool g = v && (u > T), e = v && (u == T);
            const unsigned long long mg = __ballot(g), me = __ballot(e);
            const int pg = __builtin_popcountll(mg & lt_mask), pe = __builtin_popcountll(me & lt_mask);
            if (g && (cg + pg) < cnt_gt) idxl[cg + pg] = i;
            if (e && (ce + pe) < need_eq) idxl[cnt_gt + ce + pe] = i;
            cg += __builtin_popcountll(mg); ce += __builtin_popcountll(me);
        }
    }
    asm volatile("s_waitcnt lgkmcnt(0)" ::: "memory");
    const int r32 = lane & 31, hi = lane >> 5;
    const u16* qrow = proj + (size_t)t * PITCH + DQ + (r32 & 7) * 64 + 8 * hi;
    bf16x8 qa[4];
#pragma unroll
    for (int d0 = 0; d0 < 4; ++d0) qa[d0] = ld8(qrow + 16 * d0);
    float sreg[8][4];
#pragma unroll
    for (int kt = 0; kt < 8; ++kt) {
        const int slot = 32 * kt + r32;
        const int key = idxl[slot];
        const u16* krow = proj + (size_t)key * PITCH + DK + 8 * hi;
        f32x16 s16 = {0.f, 0.f, 0.f, 0.f, 0.f, 0.f, 0.f, 0.f, 0.f, 0.f, 0.f, 0.f, 0.f, 0.f, 0.f, 0.f};
#pragma unroll
        for (int d0 = 0; d0 < 4; ++d0) s16 = __builtin_amdgcn_mfma_f32_32x32x16_bf16(qa[d0], ld8(krow + 16 * d0), s16, 0, 0, 0);
#pragma unroll
        for (int r = 0; r < 4; ++r) sreg[kt][r] = (slot < nsel) ? s16[r] : NEGINF;
    }
    float mx[4], sm[4];
#pragma unroll
    for (int r = 0; r < 4; ++r) {
        float m = sreg[0][r];
#pragma unroll
        for (int kt = 1; kt < 8; ++kt) m = fmaxf(m, sreg[kt][r]);
#pragma unroll
        for (int o = 1; o < 32; o <<= 1) m = fmaxf(m, __shfl_xor(m, o));
        mx[r] = m;
        float s = 0.f;
#pragma unroll
        for (int kt = 0; kt < 8; ++kt) { sreg[kt][r] = ex2(sreg[kt][r] - m); s += sreg[kt][r]; }
#pragma unroll
        for (int o = 1; o < 32; o <<= 1) s += __shfl_xor(s, o);
        sm[r] = 1.0f / s;
    }
#pragma unroll
    for (int kt = 0; kt < 8; ++kt) *(CW_LAS f32x4*)(Pl + (32 * kt + r32) * 8 + 4 * hi) = (f32x4){sreg[kt][0] * sm[0], sreg[kt][1] * sm[1], sreg[kt][2] * sm[2], sreg[kt][3] * sm[3]};
    asm volatile("s_waitcnt lgkmcnt(0)" ::: "memory");
#ifndef NO_PV
    float o[8] = {0.f, 0.f, 0.f, 0.f, 0.f, 0.f, 0.f, 0.f};
    const u16* vcol = proj + DV + lane;
    for (int kk = 0; kk < nsel; ++kk) {
        const int key = idxl[kk];
        const float v = bf2f((unsigned)vcol[(size_t)key * PITCH]);
        const f32x4 pa = *(CW_LAS f32x4*)(Pl + kk * 8), pb = *(CW_LAS f32x4*)(Pl + kk * 8 + 4);
        o[0] += pa.x * v; o[1] += pa.y * v; o[2] += pa.z * v; o[3] += pa.w * v; o[4] += pb.x * v; o[5] += pb.y * v; o[6] += pb.z * v; o[7] += pb.w * v;
    }
    u16* orow = mixed + (size_t)t * DMODEL + 1536 + lane;
#pragma unroll
    for (int h = 0; h < 8; ++h) orow[h * 64] = (u16)f2bf(o[h]);
#endif
    asm volatile("s_waitcnt lgkmcnt(0)" ::: "memory");
}

__device__ __forceinline__ void diff_combine_row(const u16* OB, u16* mixed, const float* sub_g, float lam, float lam_init, int t, int lane) {
    const u16* orow = OB + (size_t)t * 1024;
#pragma unroll
    for (int h = 0; h < 4; ++h) {
        const float a0 = bf2f(orow[(h * 4 + 0) * 64 + lane]), a1 = bf2f(orow[(h * 4 + 1) * 64 + lane]);
        const float b0 = bf2f(orow[(h * 4 + 2) * 64 + lane]), b1 = bf2f(orow[(h * 4 + 3) * 64 + lane]);
        const float d0 = a0 - lam * b0, d1 = a1 - lam * b1;
        const float ms = wave_sum(d0 * d0 + d1 * d1) * (1.0f / 128.0f);
        const float rs = (1.0f / sqrtf(ms + 1e-5f)) * (1.0f - lam_init);
        u16* mrow = mixed + (size_t)t * DMODEL + 512 + h * 128;
        mrow[lane] = (u16)f2bf(d0 * rs * sub_g[lane]); mrow[64 + lane] = (u16)f2bf(d1 * rs * sub_g[64 + lane]);
    }
}

__device__ __forceinline__ void ln_row(const float* in, float* outf, u16* outb, const float* g, const float* b, int lane) {
    f32x4 v[8]; float s = 0.f;
#pragma unroll
    for (int j = 0; j < 8; ++j) { v[j] = *(const f32x4*)(in + 256 * j + 4 * lane); s += (v[j].x + v[j].y) + (v[j].z + v[j].w); }
    const float mean = wave_sum(s) * (1.0f / 2048.0f); float s2 = 0.f;
#pragma unroll
    for (int j = 0; j < 8; ++j) { v[j] = v[j] - mean; s2 += (v[j].x * v[j].x + v[j].y * v[j].y) + (v[j].z * v[j].z + v[j].w * v[j].w); }
    const float rstd = 1.0f / sqrtf(wave_sum(s2) * (1.0f / 2048.0f) + 1e-5f);
#pragma unroll
    for (int j = 0; j < 8; ++j) {
        const f32x4 gg = *(const f32x4*)(g + 256 * j + 4 * lane), bb = *(const f32x4*)(b + 256 * j + 4 * lane);
        const f32x4 y = v[j] * rstd * gg + bb;
        *(f32x4*)(outf + 256 * j + 4 * lane) = y;
        if (outb) { u32x2 w; w.x = pk2(y.x, y.y); w.y = pk2(y.z, y.w); *(u32x2*)(outb + 256 * j + 4 * lane) = w; }
    }
}

__device__ __forceinline__ void ins16(unsigned (&a)[16], unsigned e) {
#pragma unroll
    for (int i = 0; i < 16; ++i) { const unsigned hi_ = a[i] > e ? a[i] : e; e = a[i] > e ? e : a[i]; a[i] = hi_; }
}
__device__ __forceinline__ float key2val(unsigned k) { const unsigned u = (k & 0x80000000u) ? (k ^ 0x80000000u) : ~k; return __uint_as_float(u & ~127u); }
__device__ __forceinline__ void peer_topk_item(const u16* qp, const u16* keysb, int* eidx, float* gate, int tt, int h, CW_LAS unsigned* cand, int lane) {
    const int r32 = lane & 31, hi = lane >> 5, t = 32 * tt + r32;
    unsigned top[2][16];
#pragma unroll
    for (int p = 0; p < 2; ++p) {
        const int hp = h * 2 + p;
        const u16* qrow = qp + (size_t)t * DMODEL + hp * 128 + 8 * hi;
        bf16x8 qb[8];
#pragma unroll
        for (int s = 0; s < 8; ++s) qb[s] = ld8(qrow + 16 * s);
#pragma unroll
        for (int i = 0; i < 16; ++i) top[p][i] = 0u;
#pragma unroll
        for (int nt = 0; nt < 4; ++nt) {
            const u16* krow = keysb + ((size_t)hp * 128 + 32 * nt + r32) * 128 + 8 * hi;
            f32x16 s16 = {0.f, 0.f, 0.f, 0.f, 0.f, 0.f, 0.f, 0.f, 0.f, 0.f, 0.f, 0.f, 0.f, 0.f, 0.f, 0.f};
#pragma unroll
            for (int s = 0; s < 8; ++s) s16 = __builtin_amdgcn_mfma_f32_32x32x16_bf16(ld8(krow + 16 * s), qb[s], s16, 0, 0, 0);
#pragma unroll
            for (int r = 0; r < 16; ++r) { const unsigned n = (unsigned)(32 * nt + crow(r, hi)); const unsigned u = __float_as_uint(s16[r]); const unsigned k = (u & 0x80000000u) ? ~u : (u | 0x80000000u); ins16(top[p], (k & ~127u) | n); }
        }
        unsigned oth[16];
#pragma unroll
        for (int i = 0; i < 16; ++i) oth[i] = __shfl_xor(top[p][i], 32);
#pragma unroll
        for (int i = 0; i < 16; ++i) ins16(top[p], oth[i]);
    }
    float v1[16], v2[16];
#pragma unroll
    for (int i = 0; i < 16; ++i) { v1[i] = key2val(top[0][i]); v2[i] = key2val(top[1][i]); }
    unsigned best[16];
#pragma unroll
    for (int i = 0; i < 16; ++i) best[i] = 0u;
    {
        int cnum = 0;
#pragma unroll
        for (int a = 0; a < 16; ++a)
#pragma unroll
            for (int b = 0; b < 16; ++b) {
                if ((a + 1) * (b + 1) > 16) continue;
                const float ev = v1[a] + v2[b]; const unsigned u = __float_as_uint(ev); const unsigned k = (u & 0x80000000u) ? ~u : (u | 0x80000000u);
                cand[cnum * 64 + lane] = ((top[0][a] & 127u) << 7) | (top[1][b] & 127u);
                ins16(best, (k & ~63u) | (unsigned)cnum);
                ++cnum;
            }
    }
    asm volatile("s_waitcnt lgkmcnt(0)" ::: "memory");
    float cv[16]; unsigned ci[16];
#pragma unroll
    for (int i = 0; i < 16; ++i) { const unsigned k = best[i]; const unsigned u = (k & 0x80000000u) ? (k ^ 0x80000000u) : ~k; cv[i] = __uint_as_float(u & ~63u); ci[i] = cand[(k & 63u) * 64 + lane]; }
    float den = 0.f; const float cmax = cv[0];
#pragma unroll
    for (int i = 0; i < 16; ++i) { cv[i] = ex2((cv[i] - cmax) * LOG2E); den += cv[i]; }
    const float inv = 1.0f / den;
    if (hi == 0) {
        int* ep = eidx + (size_t)t * 128 + h * 16; float* gp = gate + (size_t)t * 128 + h * 16;
#pragma unroll
        for (int i = 0; i < 16; i += 4) { *(u32x4*)(ep + i) = (u32x4){ci[i], ci[i + 1], ci[i + 2], ci[i + 3]}; *(f32x4*)(gp + i) = (f32x4){cv[i] * inv, cv[i + 1] * inv, cv[i + 2] * inv, cv[i + 3] * inv}; }
    }
    asm volatile("s_waitcnt lgkmcnt(0)" ::: "memory");
}

__device__ __forceinline__ float fdot2(unsigned a, unsigned b, float c) { return __builtin_amdgcn_fdot2_f32_bf16(__builtin_bit_cast(bf16x2_t, a), __builtin_bit_cast(bf16x2_t, b), c, false); }
__device__ __forceinline__ void peer_token(const float* x1, const u16* x1b, const u16* ub, const u16* vb, const int* eidx, const float* gate, float alpha,
                                           const float* g2, const float* b2, float* outf, u16* outb, int t, int lane) {
    u32x4 xb[4];
#pragma unroll
    for (int c = 0; c < 4; ++c) xb[c] = *(const u32x4*)(x1b + (size_t)t * DMODEL + 512 * c + 8 * lane);
    const int e_lo = eidx[(size_t)t * 128 + lane], e_hi = eidx[(size_t)t * 128 + 64 + lane];
    const float g_lo = gate[(size_t)t * 128 + lane], g_hi = gate[(size_t)t * 128 + 64 + lane];
    float h_lo = 0.f, h_hi = 0.f;
    for (int k0 = 0; k0 < 128; k0 += 4) {
        float part[4];
#pragma unroll
        for (int kk = 0; kk < 4; ++kk) {
            const int k = k0 + kk; const int e = __builtin_amdgcn_readlane(k0 < 64 ? e_lo : e_hi, k & 63);
            const u16* urow = ub + (size_t)e * DMODEL + 8 * lane;
            float s = 0.f;
#pragma unroll
            for (int c = 0; c < 4; ++c) { const u32x4 uv = *(const u32x4*)(urow + 512 * c); s = fdot2(uv.x, xb[c].x, s); s = fdot2(uv.y, xb[c].y, s); s = fdot2(uv.z, xb[c].z, s); s = fdot2(uv.w, xb[c].w, s); }
            part[kk] = s;
        }
#pragma unroll
        for (int o = 1; o < 64; o <<= 1) {
#pragma unroll
            for (int kk = 0; kk < 4; ++kk) part[kk] += __shfl_xor(part[kk], o);
        }
#pragma unroll
        for (int kk = 0; kk < 4; ++kk) { const int k = k0 + kk; if (lane == (k & 63)) { if (k0 < 64) h_lo = part[kk]; else h_hi = part[kk]; } }
    }
    const float a_lo = g_lo * 0.5f * h_lo * (1.0f + erff(h_lo * 0.70710678118654752f)), a_hi = g_hi * 0.5f * h_hi * (1.0f + erff(h_hi * 0.70710678118654752f));
    float acc[4][8];
#pragma unroll
    for (int c = 0; c < 4; ++c)
#pragma unroll
        for (int i = 0; i < 8; ++i) acc[c][i] = 0.f;
    for (int k0 = 0; k0 < 128; k0 += 2) {
#pragma unroll
        for (int kk = 0; kk < 2; ++kk) {
            const int k = k0 + kk; const int e = __builtin_amdgcn_readlane(k0 < 64 ? e_lo : e_hi, k & 63);
            const float a = __uint_as_float((unsigned)__builtin_amdgcn_readlane((int)__float_as_uint(k0 < 64 ? a_lo : a_hi), k & 63));
            const u16* vrow = vb + (size_t)e * DMODEL + 8 * lane;
#pragma unroll
            for (int c = 0; c < 4; ++c) { const u32x4 vv = *(const u32x4*)(vrow + 512 * c);
                acc[c][0] += a * bf2f(vv.x & 0xffffu); acc[c][1] += a * bf2f(vv.x >> 16); acc[c][2] += a * bf2f(vv.y & 0xffffu); acc[c][3] += a * bf2f(vv.y >> 16);
                acc[c][4] += a * bf2f(vv.z & 0xffffu); acc[c][5] += a * bf2f(vv.z >> 16); acc[c][6] += a * bf2f(vv.w & 0xffffu); acc[c][7] += a * bf2f(vv.w >> 16); }
        }
    }
    float s = 0.f;
#pragma unroll
    for (int c = 0; c < 4; ++c) { const f32x4 xa = *(const f32x4*)(x1 + (size_t)t * DMODEL + 512 * c + 8 * lane), xc = *(const f32x4*)(x1 + (size_t)t * DMODEL + 512 * c + 8 * lane + 4);
        acc[c][0] += alpha * xa.x; acc[c][1] += alpha * xa.y; acc[c][2] += alpha * xa.z; acc[c][3] += alpha * xa.w; acc[c][4] += alpha * xc.x; acc[c][5] += alpha * xc.y; acc[c][6] += alpha * xc.z; acc[c][7] += alpha * xc.w;
#pragma unroll
        for (int i = 0; i < 8; ++i) s += acc[c][i]; }
    const float mean = wave_sum(s) * (1.0f / 2048.0f); float s2 = 0.f;
#pragma unroll
    for (int c = 0; c < 4; ++c)
#pragma unroll
        for (int i = 0; i < 8; ++i) { acc[c][i] -= mean; s2 += acc[c][i] * acc[c][i]; }
    const float rstd = 1.0f / sqrtf(wave_sum(s2) * (1.0f / 2048.0f) + 1e-5f);
#pragma unroll
    for (int c = 0; c < 4; ++c) {
        const int col = 512 * c + 8 * lane;
        const f32x4 ga = *(const f32x4*)(g2 + col), gb = *(const f32x4*)(g2 + col + 4), ba = *(const f32x4*)(b2 + col), bb = *(const f32x4*)(b2 + col + 4);
        const f32x4 ya = (f32x4){acc[c][0], acc[c][1], acc[c][2], acc[c][3]} * rstd * ga + ba, yb = (f32x4){acc[c][4], acc[c][5], acc[c][6], acc[c][7]} * rstd * gb + bb;
        *(f32x4*)(outf + (size_t)t * DMODEL + col) = ya; *(f32x4*)(outf + (size_t)t * DMODEL + col + 4) = yb;
        if (outb) { u32x4 w; w.x = pk2(ya.x, ya.y); w.y = pk2(ya.z, ya.w); w.z = pk2(yb.x, yb.y); w.w = pk2(yb.z, yb.w); *(u32x4*)(outb + (size_t)t * DMODEL + col) = w; }
    }
}
}

constexpr int NWAVES = 8;
constexpr int T = 8192, D = 2048, NIN = 5064, NINP = 5120, NEXP = 16384, DEPTH = 2;
constexpr float LN_EPS = 1e-5f;
constexpr float ALPHA = 1.4142135623730951f;
constexpr size_t MiB = 1u << 20;
constexpr size_t WS_CTL = 0, CTL_ZERO_BYTES = 1 * MiB;
constexpr size_t WS_ROPE = 1 * MiB;
constexpr size_t WS_KEYSB = 3 * MiB;
constexpr size_t WS_WINT = 4 * MiB;
constexpr size_t WS_WOUTT = 44 * MiB;
constexpr size_t WS_WQT = 60 * MiB;
constexpr size_t WS_UB = 76 * MiB;
constexpr size_t WS_VB = 204 * MiB;
constexpr size_t WS_XB = 332 * MiB;
constexpr size_t WS_PROJ = 364 * MiB;
constexpr size_t WS_OB = 444 * MiB;
constexpr size_t WS_MIXED = 460 * MiB;
constexpr size_t WS_X2 = 492 * MiB;
constexpr size_t WS_SCORES = 556 * MiB;
constexpr size_t WS_Z = WS_SCORES;
constexpr size_t WS_X1B = WS_SCORES + 64 * MiB;
constexpr size_t WS_QPEER = WS_SCORES + 96 * MiB;
constexpr size_t WS_EIDX = WS_SCORES + 128 * MiB;
constexpr size_t WS_GATE = WS_SCORES + 132 * MiB;
constexpr size_t WS_END = 812 * MiB;
constexpr int CW_TMO = 0, CW_CODE = 1, CW_BAR = 4096;
constexpr int RING_OFF = 0, RING_BYTES = 131072;
constexpr int LDSCTL_OFF = RING_BYTES, MISC_OFF = LDSCTL_OFF + 320;
constexpr int LDS_BYTES = 147456;
constexpr int NPH = 1 + 8 * DEPTH;
#ifndef SUBM
#define SUBM 15
#endif
#ifndef PHM
#define PHM 511
#endif
#ifndef MK_ONE_LAUNCH
#define MK_ONE_LAUNCH 0
#endif

__device__ __forceinline__ void p0_transpose_item(const float* W, int K, int N, bf16* WT, LAS float* scr, int item, int lane, bool permute) {
    const int nblk = N / 32, kb = item / nblk, nb = item % nblk, k0 = 64 * kb, n0 = 32 * nb;
#pragma unroll 8
    for (int i = 0; i < 32; ++i) { const int kk = 2 * i + (lane >> 5); scr[kk * 33 + (lane & 31)] = W[(size_t)(k0 + kk) * N + n0 + (lane & 31)]; }
    LDS_WAIT(); asm volatile("" ::: "memory");
    const int c = lane & 7;
#pragma unroll
    for (int j = 0; j < 4; ++j) { const int n = (lane >> 3) + 8 * j; const LAS float* s = scr + (8 * c) * 33 + n;
        v4u o; o.x = pk2(s[0 * 33], s[1 * 33]); o.y = pk2(s[2 * 33], s[3 * 33]); o.z = pk2(s[4 * 33], s[5 * 33]); o.w = pk2(s[6 * 33], s[7 * 33]);
        const int ng = n0 + n; int row = ng;
        if (permute && pg8::chunk_is_rope(ng >> 6)) row = (ng & ~63) + 2 * (ng & 31) + ((ng >> 5) & 1);
        *(GAS v4u*)(WT + (size_t)row * K + k0 + 8 * c) = o; }
    LDS_WAIT(); asm volatile("" ::: "memory");
}

struct Args { const float* in[14]; float* out; unsigned char* ws; int ph_lo, ph_hi; };

__global__ void __launch_bounds__(NWAVES * 64, 2) mega_fwd(Args args) {
    extern __shared__ __attribute__((aligned(16))) unsigned char lds[];
    LAS unsigned char* ldsl = (LAS unsigned char*)lds;
    volatile LAS unsigned* MISC = (volatile LAS unsigned*)(ldsl + MISC_OFF);
    const int tid = threadIdx.x;
    const int G = gridDim.x, bx = blockIdx.x, vcu = (G % 8 == 0) ? (bx % 8) * (G / 8) + bx / 8 : bx;
    const int NGW = G * NWAVES;
    const long NGT = (long)NGW * 64;
    unsigned char* ws = args.ws;
    gu32* ctl = (gu32*)(ws + WS_CTL);
    const float* x_in = args.in[0]; const float* w_in = args.in[1]; const float* attn_sinks = args.in[2]; const float* diff_lambda = args.in[3]; const float* diff_norm_g = args.in[4];
    const float* w_out = args.in[5]; const float* ln1_g = args.in[6]; const float* ln1_b = args.in[7]; const float* peer_wq = args.in[8]; const float* peer_keys = args.in[9];
    const float* peer_u = args.in[10]; const float* peer_v = args.in[11]; const float* ln2_g = args.in[12]; const float* ln2_b = args.in[13];
    float* cosT = (float*)(ws + WS_ROPE); float* sinT = cosT + T * 32;
    bf16* keysb = (bf16*)(ws + WS_KEYSB); bf16* winT = (bf16*)(ws + WS_WINT); bf16* woutT = (bf16*)(ws + WS_WOUTT); bf16* wqT = (bf16*)(ws + WS_WQT);
    bf16* ub = (bf16*)(ws + WS_UB); bf16* vb = (bf16*)(ws + WS_VB); bf16* xb = (bf16*)(ws + WS_XB); bf16* proj = (bf16*)(ws + WS_PROJ); bf16* ob = (bf16*)(ws + WS_OB);
    bf16* mixed = (bf16*)(ws + WS_MIXED); float* x2 = (float*)(ws + WS_X2); float* scores = (float*)(ws + WS_SCORES); float* zbuf = (float*)(ws + WS_Z);
    bf16* x1b = (bf16*)(ws + WS_X1B); bf16* qpeer = (bf16*)(ws + WS_QPEER); int* eidx = (int*)(ws + WS_EIDX); float* gate = (float*)(ws + WS_GATE);

    for (int u = tid; u < (LDS_BYTES - LDSCTL_OFF) / 4; u += NWAVES * 64) ((LAS unsigned*)(ldsl + LDSCTL_OFF))[u] = 0u;
    __syncthreads();
    const int lo = args.ph_lo, hi = args.ph_hi;
    XcdBarrier bar; bar.bar = (unsigned*)(ctl + CW_BAR); bar.x = 0; bar.st = nullptr;
    if (hi - lo > 1) bar = xcd_barrier_post((unsigned*)(ctl + CW_BAR), MISC + 8);

#pragma unroll 1
    for (int ph = lo; ph < hi; ++ph) {
        if (ph > lo) xcd_barrier(bar);
        int tid_ = threadIdx.x; asm volatile("" : "+v"(tid_));
        const int lane = tid_ & 63, wave = __builtin_amdgcn_readfirstlane(tid_ >> 6);
        const int gw = vcu * NWAVES + wave;
        const long gthr = (long)gw * 64 + lane;
        if (ph == 0) {
#if (PHM & 1)
            LAS float* scr = (LAS float*)(ldsl + RING_OFF + wave * 16384);
            constexpr int I_IN = (D / 64) * (NIN / 32), I_SQ = (D / 64) * (D / 32), I_LAYER = I_IN + 2 * I_SQ;
            for (int it = gw; it < DEPTH * I_LAYER; it += NGW) {
                const int L = it / I_LAYER; int r = it % I_LAYER;
                if (r < I_IN) { p0_transpose_item(w_in + (size_t)L * D * NIN, D, NIN, winT + (size_t)L * NINP * D, scr, r, lane, true); continue; } r -= I_IN;
                if (r < I_SQ) { p0_transpose_item(w_out + (size_t)L * D * D, D, D, woutT + (size_t)L * D * D, scr, r, lane, false); continue; } r -= I_SQ;
                p0_transpose_item(peer_wq + (size_t)L * D * D, D, D, wqT + (size_t)L * D * D, scr, r, lane, false);
            }
            for (long i = gthr; i < (long)DEPTH * 64 * D; i += NGT) { const int L = (int)(i / (64 * D)), rr = (int)(i % (64 * D)), n = 5056 + rr / D, k = rr % D;
                const float v = (n < NIN) ? w_in[(size_t)L * D * NIN + (size_t)k * NIN + n] : 0.f; winT[(size_t)L * NINP * D + (size_t)n * D + k] = (bf16)f2bf(v); }
            for (long i = gthr; i < (long)DEPTH * 16 * 128 * 128 / 8; i += NGT) { const f32x4 a = *(const f32x4*)(peer_keys + 8 * i), b = *(const f32x4*)(peer_keys + 8 * i + 4);
                v4u o; o.x = pk2(a.x, a.y); o.y = pk2(a.z, a.w); o.z = pk2(b.x, b.y); o.w = pk2(b.z, b.w); *(GAS v4u*)(keysb + 8 * i) = o; }
            for (long i = gthr; i < (long)DEPTH * NEXP * D / 8; i += NGT) {
                { const f32x4 a = *(const f32x4*)(peer_u + 8 * i), b = *(const f32x4*)(peer_u + 8 * i + 4); v4u o; o.x = pk2(a.x, a.y); o.y = pk2(a.z, a.w); o.z = pk2(b.x, b.y); o.w = pk2(b.z, b.w); *(GAS v4u*)(ub + 8 * i) = o; }
                { const f32x4 a = *(const f32x4*)(peer_v + 8 * i), b = *(const f32x4*)(peer_v + 8 * i + 4); v4u o; o.x = pk2(a.x, a.y); o.y = pk2(a.z, a.w); o.z = pk2(b.x, b.y); o.w = pk2(b.z, b.w); *(GAS v4u*)(vb + 8 * i) = o; }
            }
            for (long i = gthr; i < (long)T * D / 8; i += NGT) { const f32x4 a = *(const f32x4*)(x_in + 8 * i), b = *(const f32x4*)(x_in + 8 * i + 4);
                v4u o; o.x = pk2(a.x, a.y); o.y = pk2(a.z, a.w); o.z = pk2(b.x, b.y); o.w = pk2(b.z, b.w); *(GAS v4u*)(xb + 8 * i) = o; }
            for (long i = gthr; i < (long)T * 32; i += NGT) { const int t = (int)(i >> 5), f = (int)(i & 31);
                const float inv = powf(10000.0f, -(float)f / 32.0f); const float ang = (float)t * inv; float sv, cv; sincosf(ang, &sv, &cv); cosT[i] = cv; sinT[i] = sv; }
#endif
            continue;
        }
        const int L = (ph - 1) >> 3, sub = (ph - 1) & 7;
        if (sub == 0) {
#if (PHM & 2)
            pg8::Gemm g{xb, winT + (size_t)L * NINP * D, T, NINP, D}; pg8::StaticOrder S; S.init(T, NINP, G, bx);
            pg8::EpiInProj E{proj, NINP, cosT, sinT};
            pg8::gemm_phase<pg8::EpiInProj, pg8::StaticOrder, true, true>(ldsl + RING_OFF, g, S, E);
#endif
        } else if (sub == 1) {
#if (PHM & 4)
#if (SUBM & 1)
#pragma unroll 1
            for (int pi = vcu; pi < 256; pi += G) {
                const int vh = pi >> 4, s = pi & 15, h = vh >> 2, j = (vh >> 1) & 1, c = vh & 1;
                const attn_body::bf16* Qh = (const attn_body::bf16*)(proj + cw::BQ + h * 128 + j * 64);
                const attn_body::bf16* Kh = (const attn_body::bf16*)(proj + cw::BK_ + h * 128 + j * 64);
                const attn_body::bf16* Vh = (const attn_body::bf16*)(proj + cw::BV + h * 128 + c * 64);
                attn_body::bf16* Oh = (attn_body::bf16*)(ob + vh * 64);
#pragma unroll 1
                for (int ui = 0; ui < 2; ++ui) attn_body::attn_unit<8>(ui == 0 ? 31 - s : s, Qh, Kh, Vh, Oh, (char*)lds + RING_OFF);
            }
#endif
#if (SUBM & 2)
            for (int it = gw; it < 2048; it += NGW) cw::swa_item(proj, mixed, attn_sinks + L * 8, it & 7, it >> 3, lane);
#endif
#if (SUBM & 4)
            for (int it = gw; it < 2048; it += NGW) { const int rest = it >> 3; cw::dil_item(proj, mixed, it & 7, rest & 15, rest >> 4, lane); }
#endif
#if (SUBM & 8)
            for (int it = gw; it < 4352; it += NGW) { int c = 0; while (c < 15 && it >= 512 * (c + 1) - 16 * (c + 1) * c) ++c; cw::idx_item(proj, scores, 32 * c + (it - (512 * c - 16 * c * (c - 1))), c, lane); }
#endif
#endif
        } else if (sub == 2) {
#if (PHM & 8)
            LAS unsigned char* wsl = ldsl + RING_OFF + wave * 9216;
#pragma unroll 1
            for (int i4 = 4 * gw; i4 < 8192; i4 += 4 * NGW) {
#pragma unroll 1
                for (int k = 0; k < 4; ++k) { const int i = i4 >> 2; const int t = (k == 0) ? 8191 - i : (k == 1) ? 4096 + i : (k == 2) ? 4095 - i : i; cw::dsa_row(proj, scores, mixed, t, wsl, lane); }
            }
            const float* lp = diff_lambda + L * 256;
            const float lam_init = 0.8f - 0.6f * expf(-0.3f * (float)L);
            const float lam = expf(cw::wave_sum(lp[lane] * lp[64 + lane])) - expf(cw::wave_sum(lp[128 + lane] * lp[192 + lane])) + lam_init;
            for (int t = gw; t < T; t += NGW) cw::diff_combine_row(ob, mixed, diff_norm_g + L * 128, lam, lam_init, t, lane);
#endif
        } else if (sub == 3) {
#if (PHM & 16)
            pg8::Gemm g{mixed, woutT + (size_t)L * D * D, T, D, D}; pg8::StaticOrder S; S.init(T, D, G, bx);
            pg8::EpiResid E{zbuf, (L == 0) ? x_in : (const float*)x2, D, ALPHA};
            pg8::gemm_phase<pg8::EpiResid, pg8::StaticOrder, true, true>(ldsl + RING_OFF, g, S, E);
#endif
        } else if (sub == 4) {
#if (PHM & 32)
            for (int t = gw; t < T; t += NGW) cw::ln_row(zbuf + (size_t)t * D, zbuf + (size_t)t * D, x1b + (size_t)t * D, ln1_g + L * D, ln1_b + L * D, lane);
#endif
        } else if (sub == 5) {
#if (PHM & 64)
            pg8::Gemm g{x1b, wqT + (size_t)L * D * D, T, D, D}; pg8::StaticOrder S; S.init(T, D, G, bx);
            pg8::EpiBf16<0> E{qpeer, D, nullptr, 0, 0, 1.f};
            pg8::gemm_phase<pg8::EpiBf16<0>, pg8::StaticOrder, true, true>(ldsl + RING_OFF, g, S, E);
#endif
        } else if (sub == 6) {
#if (PHM & 128)
            LAS unsigned* cand = (LAS unsigned*)(ldsl + RING_OFF + wave * 12800);
#pragma unroll 1
            for (int it = gw; it < 2048; it += NGW) cw::peer_topk_item(qpeer, keysb + (size_t)L * 16 * 128 * 128, eidx, gate, it >> 3, it & 7, cand, lane);
#endif
        } else {
#if (PHM & 256)
            const bool last = (L == DEPTH - 1);
            for (int t = gw; t < T; t += NGW)
                cw::peer_token(zbuf, x1b, ub + (size_t)L * NEXP * D, vb + (size_t)L * NEXP * D, eidx, gate, ALPHA, ln2_g + L * D, ln2_b + L * D, last ? args.out : x2, last ? (bf16*)nullptr : xb, t, lane);
#endif
        }
    }
}

extern "C" void kernel_launch(void* const* d_in, const int* in_sizes, int n_in, void* d_out, int out_size, void* d_ws, size_t ws_size, hipStream_t stream) {
    static int grid = 0;
    if (grid == 0) {
        if (n_in != 14 || out_size != T * D || ws_size < WS_END) { fprintf(stderr, "kernel_launch: unexpected shapes (n_in %d, out %d, ws %zu < %zu); nothing launched\n", n_in, out_size, ws_size, (size_t)WS_END); grid = -1; return; }
        int dev = 0, cus = 0;
        if (hipGetDevice(&dev) != hipSuccess || hipDeviceGetAttribute(&cus, hipDeviceAttributeMultiprocessorCount, dev) != hipSuccess) { grid = -1; return; }
        if (hipFuncSetAttribute((const void*)mega_fwd, hipFuncAttributeMaxDynamicSharedMemorySize, LDS_BYTES) != hipSuccess) { fprintf(stderr, "kernel_launch: hipFuncSetAttribute failed\n"); grid = -1; return; }
        (void)hipGetLastError();
        grid = cus;
    }
    if (grid < 0) return;
    if (hipMemsetAsync((char*)d_ws + WS_CTL, 0, CTL_ZERO_BYTES, stream) != hipSuccess) { fprintf(stderr, "kernel_launch: memset failed\n"); return; }
    Args a{};
    for (int i = 0; i < 14; ++i) a.in[i] = (const float*)d_in[i];
    a.out = (float*)d_out; a.ws = (unsigned char*)d_ws;
#if MK_ONE_LAUNCH
    a.ph_lo = 0; a.ph_hi = NPH;
    hipLaunchKernelGGL(mega_fwd, dim3(grid), dim3(NWAVES * 64), LDS_BYTES, stream, a);
#else
    for (int ph = 0; ph < NPH; ++ph) { a.ph_lo = ph; a.ph_hi = ph + 1; hipLaunchKernelGGL(mega_fwd, dim3(grid), dim3(NWAVES * 64), LDS_BYTES, stream, a); }
#endif
}
```

```cpp
#include <hip/hip_runtime.h>
#include <hip/hip_bf16.h>
#include <cstdio>
#include <cstdint>
#include <cmath>
namespace pg8 {
#define PG8_LAS __attribute__((address_space(3)))
typedef unsigned short bf16_t;
typedef short bf16x8 __attribute__((ext_vector_type(8)));
typedef float f32x4 __attribute__((ext_vector_type(4)));
typedef unsigned u32x4 __attribute__((ext_vector_type(4)));
constexpr int BM = 256, BK = 64, HALF = 128, HTB = HALF * BK * 2  , STAGE_BYTES = 8 * HTB, NXCD = 8, WGM = 8;

__host__ __device__ __forceinline__ int lds_byte(int r, int c) { const int st = (r >> 4) * 2 + (c >> 5), rr = r & 15, cc = c & 31, ob = rr * 64 + cc * 2; return st * 1024 + (ob ^ (((ob >> 9) & 1) << 5)); }
__host__ __device__ __forceinline__ void stage_rc(int b, int& R, int& C) { const int st = b / 1024, sb = b % 1024, swz = sb ^ (((sb >> 9) & 1) << 5); R = (st >> 1) * 16 + swz / 64; C = (st & 1) * 32 + (swz % 64) / 2; }
__host__ __device__ __forceinline__ int perm32(int rho) { const int n = rho >> 4, i = rho & 15; return 8 * (i >> 2) + 4 * n + (i & 3); }

struct Unit { int pm, pn; };
struct Gemm { const bf16_t* A; const bf16_t* Bt; int M, N, K; };

struct StaticOrder {
    int nM, nN, nwg, G, c;
    __host__ __device__ void init(int M, int N, int G_, int c_) { nM = M / BM; nN = N / BM; nwg = nM * nN; G = G_; c = c_; }
    __host__ __device__ bool next(int i, Unit& u) const {
        const long L = (long)i * G + c; if (L >= nwg) return false;
        int wgid = (int)L; { const int q = nwg / NXCD, r = nwg % NXCD, xcd = wgid % NXCD, off = wgid / NXCD; wgid = (xcd < r ? xcd * (q + 1) : r * (q + 1) + (xcd - r) * q) + off; }
        const int nig = WGM * nN, gid = wgid / nig, fm = gid * WGM, gsz = (nM - fm) < WGM ? (nM - fm) : WGM;
        u.pm = fm + ((wgid % nig) % gsz); u.pn = (wgid % nig) / gsz; return true;
    }
    __device__ __forceinline__ void a_ready(const Unit&) const {}
    __device__ __forceinline__ void done(const Unit&) const {}
};

__device__ __forceinline__ unsigned cvt_pk_bf16(float lo, float hi) { unsigned r; asm volatile("v_cvt_pk_bf16_f32 %0, %1, %2" : "=v"(r) : "v"(lo), "v"(hi)); return r; }
typedef float f32x2 __attribute__((ext_vector_type(2)));
__device__ __forceinline__ f32x2 gelu_pk(f32x2 v) {
    const f32x2 av = __builtin_elementwise_abs(v), d = av * 0.2316418882f + 1.0f;
    f32x2 t; t.x = __builtin_amdgcn_rcpf(d.x); t.y = __builtin_amdgcn_rcpf(d.y);
    f32x2 q = t * 0.5307027145f + (-0.7265760135f); q = q * t + 0.7107068705f; q = q * t + (-0.142248368f); q = q * t + 0.127414796f; q = q * t;
    const f32x2 s = (v * v) * (-0.72134752044f);
    f32x2 e; e.x = __builtin_amdgcn_exp2f(s.x); e.y = __builtin_amdgcn_exp2f(s.y);
    const f32x2 m = v * (q * e), r = v - m;
    f32x2 o; o.x = v.x < 0.f ? m.x : r.x; o.y = v.y < 0.f ? m.y : r.y; return o;
}

template <int ACT  > struct EpiBf16 {
    static constexpr bool PERM = true, AFTER_DRAIN = false; static_assert(ACT == 0 || ACT == 1, "EpiBf16: ACT is 0 (none) or 1 (gelu_pk)");
    bf16_t* O; int ldc; const float* bias; int split_cols; size_t split_stride; float scale0;
    __device__ __forceinline__ void operator()(const f32x4 (&acc)[2][2][4][2], const Unit& u, int wr, int wc, int fr, int fq) const {
        const int row0 = u.pm * BM + wr * 64 + fr; int colt = u.pn * BM; bf16_t* base = O;
        float sc = 1.f; if (split_cols) { const int t = colt / split_cols; base += (size_t)t * split_stride; colt -= t * split_cols; if (t == 0) sc = scale0; }
        const int col0 = colt + wc * 32 + 8 * fq, bcol0 = u.pn * BM + wc * 32 + 8 * fq;
        f32x4 bv[2][2];
#pragma unroll
        for (int bj = 0; bj < 2; ++bj)
#pragma unroll
            for (int n = 0; n < 2; ++n) bv[bj][n] = bias ? *(const f32x4*)(bias + bcol0 + bj * HALF + 4 * n) : (f32x4){0.f, 0.f, 0.f, 0.f};
#pragma unroll
        for (int ai = 0; ai < 2; ++ai)
#pragma unroll
            for (int m = 0; m < 4; ++m) { bf16_t* rowp = base + (size_t)(row0 + ai * HALF + m * 16) * ldc + col0;
#pragma unroll
                for (int bj = 0; bj < 2; ++bj) { f32x4 v0 = acc[ai][bj][m][0] + bv[bj][0], v1 = acc[ai][bj][m][1] + bv[bj][1];
                    if (ACT == 1) { f32x2 a = gelu_pk((f32x2){v0[0], v0[1]}), b = gelu_pk((f32x2){v0[2], v0[3]}), c = gelu_pk((f32x2){v1[0], v1[1]}), d = gelu_pk((f32x2){v1[2], v1[3]});
                        v0 = (f32x4){a.x, a.y, b.x, b.y}; v1 = (f32x4){c.x, c.y, d.x, d.y}; }
                    v0 = v0 * sc; v1 = v1 * sc; u32x4 w; w.x = cvt_pk_bf16(v0[0], v0[1]); w.y = cvt_pk_bf16(v0[2], v0[3]); w.z = cvt_pk_bf16(v1[0], v1[1]); w.w = cvt_pk_bf16(v1[2], v1[3]);
                    *(u32x4*)(rowp + bj * HALF) = w; } }
    }
};

__device__ __forceinline__ bool chunk_is_rope(int c) { return (c < 10) || (c >= 12 && c < 28) || (c >= 36 && c < 52) || (c >= 60 && c < 69) || (c >= 70 && c < 79); }
__device__ __forceinline__ float chunk_scale(int c) {
    const float C2 = 0.125f * 1.4426950408889634f;
    if (c < 8 || (c >= 12 && c < 20) || (c >= 36 && c < 44) || (c >= 60 && c < 68)) return C2;
    if (c >= 70 && c < 78) return 0.125f;
    return 1.0f;
}
struct EpiInProj {
    static constexpr bool PERM = true, AFTER_DRAIN = false;
    bf16_t* O; int ldc; const float* cosT; const float* sinT;
    __device__ __forceinline__ void operator()(const f32x4 (&acc)[2][2][4][2], const Unit& u, int wr, int wc, int fr, int fq) const {
        const int row0 = u.pm * BM + wr * 64 + fr;
        const int colb = u.pn * BM + wc * 32 + 8 * fq;
        const int chunk0 = __builtin_amdgcn_readfirstlane(colb >> 6), chunk1 = chunk0 + 2;
        const bool rope0 = chunk_is_rope(chunk0), rope1 = chunk_is_rope(chunk1); const float sc0 = chunk_scale(chunk0), sc1 = chunk_scale(chunk1);
        const int i0 = (colb & 63) >> 1;
#pragma unroll
        for (int ai = 0; ai < 2; ++ai)
#pragma unroll
            for (int m = 0; m < 4; ++m) {
                const int row = row0 + ai * HALF + m * 16;
                f32x4 c = {1.f, 1.f, 1.f, 1.f}, s = {0.f, 0.f, 0.f, 0.f};
                if (rope0 || rope1) { c = *(const f32x4*)(cosT + (size_t)row * 32 + i0); s = *(const f32x4*)(sinT + (size_t)row * 32 + i0); }
#pragma unroll
                for (int bj = 0; bj < 2; ++bj) {
                    const bool rope = bj ? rope1 : rope0; const float sc = bj ? sc1 : sc0;
                    f32x4 v0 = acc[ai][bj][m][0], v1 = acc[ai][bj][m][1];
                    if (rope) {
                        f32x4 y0, y1;
                        y0[0] = v0[0] * c[0] - v0[1] * s[0]; y0[1] = v0[0] * s[0] + v0[1] * c[0];
                        y0[2] = v0[2] * c[1] - v0[3] * s[1]; y0[3] = v0[2] * s[1] + v0[3] * c[1];
                        y1[0] = v1[0] * c[2] - v1[1] * s[2]; y1[1] = v1[0] * s[2] + v1[1] * c[2];
                        y1[2] = v1[2] * c[3] - v1[3] * s[3]; y1[3] = v1[2] * s[3] + v1[3] * c[3];
                        v0 = y0; v1 = y1;
                    }
                    v0 = v0 * sc; v1 = v1 * sc;
                    u32x4 w; w.x = cvt_pk_bf16(v0[0], v0[1]); w.y = cvt_pk_bf16(v0[2], v0[3]); w.z = cvt_pk_bf16(v1[0], v1[1]); w.w = cvt_pk_bf16(v1[2], v1[3]);
                    *(u32x4*)(O + (size_t)row * ldc + colb + bj * HALF) = w;
                }
            }
    }
};
struct EpiResid {
    static constexpr bool PERM = false, AFTER_DRAIN = false;
    bf16_t* Z; const float* X; int ldc; float alpha;
    __device__ __forceinline__ void operator()(const f32x4 (&acc)[2][2][4][2], const Unit& u, int wr, int wc, int fr, int fq) const {
        const int row0 = u.pm * BM + wr * 64 + fr, col0 = u.pn * BM + wc * 32 + 4 * fq;
#pragma unroll
        for (int ai = 0; ai < 2; ++ai)
#pragma unroll
            for (int m = 0; m < 4; ++m) {
                const size_t off = (size_t)(row0 + ai * HALF + m * 16) * ldc + col0;
#pragma unroll
                for (int bj = 0; bj < 2; ++bj)
#pragma unroll
                    for (int n = 0; n < 2; ++n) { const f32x4 xv = *(const f32x4*)(X + off + bj * HALF + n * 16); const f32x4 zv = xv * alpha + acc[ai][bj][m][n]; typedef unsigned u32x2_ __attribute__((ext_vector_type(2))); *(u32x2_*)(Z + off + bj * HALF + n * 16) = (u32x2_){cvt_pk_bf16(zv[0], zv[1]), cvt_pk_bf16(zv[2], zv[3])}; }
            }
    }
};
template <class Epi, class Sched, bool ALIGN_EPI = false, bool SP2 = false>
__device__ __forceinline__ void gemm_phase(PG8_LAS unsigned char* lds, const Gemm g, const Sched& S, const Epi& E) {
    int tid_ = threadIdx.x; asm volatile("" : "+v"(tid_));
    const int tid = tid_, wid = __builtin_amdgcn_readfirstlane(tid >> 6), lane = tid & 63, wr = wid >> 2, wc = wid & 3, fr = lane & 15, fq = lane >> 4;
    const int K = g.K, nt = K / BK;
    unsigned voffA[2], voffB[2];
#pragma unroll
    for (int i = 0; i < 2; ++i) { int R, C; stage_rc(tid * 16 + i * 8192, R, C); const int Rb = Epi::PERM ? ((R & ~31) + perm32(R & 31)) : R;
        voffA[i] = (unsigned)(R * K + C) * 2u; voffB[i] = (unsigned)(Rb * K + C) * 2u; }
    const size_t kstep = (size_t)(BK * 2);
    const size_t hstep = (size_t)HALF * K * 2;
    const size_t tstep = 2 * hstep;
    const unsigned ldsw = (unsigned)wid * 1024u;
    const int aoff = lds_byte(wr * 64 + fr, fq * 8), boff = lds_byte(wc * 32 + fr, fq * 8);
#define PG8_SA(b, h) (((b) * 2 + (h)) * HTB)
#define PG8_SB(b, h) ((4 + (b) * 2 + (h)) * HTB)
#define PG8_STAGE(bufoff, gbase, voff) do { _Pragma("unroll") for (int _i = 0; _i < 2; ++_i) \
        __builtin_amdgcn_global_load_lds((const unsigned*)((const char*)(gbase) + (voff)[_i]), (PG8_LAS unsigned*)(lds + (bufoff) + ldsw + _i * 8192), 16, 0, 0); } while (0)
#define PG8_LDA(dst, b, h) do { _Pragma("unroll") for (int m = 0; m < 4; ++m) _Pragma("unroll") for (int k = 0; k < 2; ++k) dst[m][k] = *(const PG8_LAS bf16x8*)(lds + PG8_SA(b, h) + aoff + m * 2048 + k * 1024); } while (0)
#define PG8_LDB(dst, b, h) do { _Pragma("unroll") for (int n = 0; n < 2; ++n) _Pragma("unroll") for (int k = 0; k < 2; ++k) dst[n][k] = *(const PG8_LAS bf16x8*)(lds + PG8_SB(b, h) + boff + n * 2048 + k * 1024); } while (0)
#define PG8_MMA(ai, bj, At, Bt) do { __builtin_amdgcn_s_setprio(1); _Pragma("unroll") for (int m = 0; m < 4; ++m) _Pragma("unroll") for (int n = 0; n < 2; ++n) _Pragma("unroll") for (int k = 0; k < 2; ++k) \
        acc[ai][bj][m][n] = __builtin_amdgcn_mfma_f32_16x16x32_bf16(Bt[n][k], At[m][k], acc[ai][bj][m][n], 0, 0, 0); __builtin_amdgcn_s_setprio(0); } while (0)
#define PG8_WAIT_V(n) asm volatile("s_waitcnt vmcnt(" #n ")" ::: "memory")
#define PG8_WAIT_L(n) asm volatile("s_waitcnt lgkmcnt(" #n ")" ::: "memory")
#define PG8_BAR __builtin_amdgcn_s_barrier()
#define PG8_SCHED __builtin_amdgcn_sched_barrier(0)
    Unit cur, nxt; int ui = 0;
    if (!S.next(0, cur)) return;
    f32x4 acc[2][2][4][2];
#pragma unroll
    for (int a = 0; a < 2; ++a)
#pragma unroll
        for (int b = 0; b < 2; ++b)
#pragma unroll
            for (int m = 0; m < 4; ++m)
#pragma unroll
                for (int n = 0; n < 2; ++n) acc[a][b][m][n] = (f32x4){0.f, 0.f, 0.f, 0.f};
    bf16x8 At[4][2], B0[2][2], B1[2][2];
    const char* cA = (const char*)g.A + (size_t)cur.pm * tstep; const char* cB = (const char*)g.Bt + (size_t)cur.pn * tstep;
    S.a_ready(cur);
    if constexpr (SP2) {
        PG8_STAGE(PG8_SB(0, 0), cB, voffB); PG8_STAGE(PG8_SB(0, 1), cB + hstep, voffB); PG8_STAGE(PG8_SA(0, 0), cA, voffA); PG8_STAGE(PG8_SA(0, 1), cA + hstep, voffA);
        if (wr == 1) PG8_BAR;
        PG8_WAIT_V(2); PG8_BAR;
        PG8_STAGE(PG8_SB(1, 0), cB + kstep, voffB); PG8_STAGE(PG8_SA(1, 0), cA + kstep, voffA); PG8_STAGE(PG8_SB(1, 1), cB + hstep + kstep, voffB);
        PG8_WAIT_V(6); PG8_BAR;
    } else {
        PG8_STAGE(PG8_SB(0, 0), cB, voffB); PG8_STAGE(PG8_SA(0, 0), cA, voffA); PG8_STAGE(PG8_SB(0, 1), cB + hstep, voffB); PG8_STAGE(PG8_SA(0, 1), cA + hstep, voffA);
        if (wr == 1) PG8_BAR;
        PG8_WAIT_V(4); PG8_BAR;
        PG8_STAGE(PG8_SB(1, 0), cB + kstep, voffB); PG8_STAGE(PG8_SA(1, 0), cA + kstep, voffA); PG8_STAGE(PG8_SB(1, 1), cB + hstep + kstep, voffB);
        PG8_WAIT_V(6); PG8_BAR;
    }
    for (;;) {
        const bool has_next = S.next(ui + 1, nxt);
        const char* nA = has_next ? (const char*)g.A + (size_t)nxt.pm * tstep : cA; const char* nB = has_next ? (const char*)g.Bt + (size_t)nxt.pn * tstep : cB;
        for (int t = 0; t < nt; t += 2) {
            const bool last = (t == nt - 2);
            const char* a1 = cA + (size_t)(t + 1) * kstep;
            const char* a2 = last ? nA : cA + (size_t)(t + 2) * kstep; const char* b2 = last ? nB : cB + (size_t)(t + 2) * kstep;
            const char* a3 = a2 + kstep; const char* b3 = b2 + kstep;
            if (last && has_next) S.a_ready(nxt);
            if constexpr (SP2) {
            PG8_LDB(B0, 0, 0); PG8_LDB(B1, 0, 1); PG8_SCHED; PG8_LDA(At, 0, 0); PG8_STAGE(PG8_SA(1, 1), a1 + hstep, voffA);
            PG8_WAIT_V(8); PG8_WAIT_L(0); PG8_BAR; PG8_MMA(0, 0, At, B0); PG8_MMA(0, 1, At, B1); PG8_BAR; PG8_SCHED;
            PG8_LDA(At, 0, 1); PG8_STAGE(PG8_SB(0, 0), b2, voffB); PG8_STAGE(PG8_SB(0, 1), b2 + hstep, voffB); PG8_STAGE(PG8_SA(0, 0), a2, voffA);
            PG8_WAIT_V(8); PG8_WAIT_L(0); PG8_BAR; PG8_MMA(1, 0, At, B0); PG8_MMA(1, 1, At, B1); PG8_BAR; PG8_SCHED;
            PG8_LDB(B0, 1, 0); PG8_LDB(B1, 1, 1); PG8_SCHED; PG8_LDA(At, 1, 0); PG8_STAGE(PG8_SA(0, 1), a2 + hstep, voffA);
            PG8_WAIT_V(8); PG8_WAIT_L(0); PG8_BAR; PG8_MMA(0, 0, At, B0); PG8_MMA(0, 1, At, B1); PG8_BAR; PG8_SCHED;
            PG8_LDA(At, 1, 1); PG8_STAGE(PG8_SB(1, 0), b3, voffB); PG8_STAGE(PG8_SB(1, 1), b3 + hstep, voffB); PG8_STAGE(PG8_SA(1, 0), a3, voffA);
            PG8_WAIT_V(8); PG8_WAIT_L(0); PG8_BAR; PG8_MMA(1, 0, At, B0); PG8_MMA(1, 1, At, B1); PG8_BAR; PG8_SCHED;
            } else {
            PG8_LDB(B0, 0, 0); PG8_SCHED; PG8_LDA(At, 0, 0); PG8_STAGE(PG8_SA(1, 1), a1 + hstep, voffA);
            PG8_WAIT_L(8); PG8_BAR; PG8_WAIT_L(0); PG8_MMA(0, 0, At, B0); PG8_BAR; PG8_SCHED;
            PG8_LDB(B1, 0, 1); PG8_STAGE(PG8_SB(0, 0), b2, voffB);
            PG8_BAR; PG8_WAIT_L(0); PG8_MMA(0, 1, At, B1); PG8_BAR;
            PG8_LDA(At, 0, 1); PG8_STAGE(PG8_SA(0, 0), a2, voffA);
            PG8_BAR; PG8_WAIT_L(0); PG8_MMA(1, 0, At, B0); PG8_BAR; PG8_SCHED;
            PG8_STAGE(PG8_SB(0, 1), b2 + hstep, voffB);
            PG8_WAIT_V(6); PG8_BAR; PG8_MMA(1, 1, At, B1); PG8_BAR;
            PG8_LDB(B0, 1, 0); PG8_SCHED; PG8_LDA(At, 1, 0); PG8_STAGE(PG8_SA(0, 1), a2 + hstep, voffA);
            PG8_WAIT_L(8); PG8_BAR; PG8_WAIT_L(0); PG8_MMA(0, 0, At, B0); PG8_BAR; PG8_SCHED;
            PG8_LDB(B1, 1, 1); PG8_STAGE(PG8_SB(1, 0), b3, voffB);
            PG8_BAR; PG8_WAIT_L(0); PG8_MMA(0, 1, At, B1); PG8_BAR;
            PG8_LDA(At, 1, 1); PG8_STAGE(PG8_SA(1, 0), a3, voffA);
            PG8_BAR; PG8_WAIT_L(0); PG8_MMA(1, 0, At, B0); PG8_BAR; PG8_SCHED;
            PG8_STAGE(PG8_SB(1, 1), b3 + hstep, voffB);
            PG8_WAIT_V(6); PG8_BAR; PG8_MMA(1, 1, At, B1); PG8_BAR;
            }
        }
        if constexpr (ALIGN_EPI) { if (wr == 0) PG8_BAR; }
        if constexpr (!Epi::AFTER_DRAIN) { E(acc, cur, wr, wc, fr, fq); S.done(cur); }
        if (!has_next) break;
#pragma unroll
        for (int a = 0; a < 2; ++a)
#pragma unroll
            for (int b = 0; b < 2; ++b)
#pragma unroll
                for (int m = 0; m < 4; ++m)
#pragma unroll
                    for (int n = 0; n < 2; ++n) acc[a][b][m][n] = (f32x4){0.f, 0.f, 0.f, 0.f};
        cur = nxt; cA = nA; cB = nB; ++ui;
        if constexpr (ALIGN_EPI) { if (wr == 1) PG8_BAR; }
    }
    PG8_WAIT_V(0);
    if constexpr (!ALIGN_EPI) { if (wr == 0) PG8_BAR; }
    PG8_BAR;
    if constexpr (Epi::AFTER_DRAIN) { E.fused(acc, cur, wr, wc, fr, fq, lds, wid, lane); S.done(cur); }
#undef PG8_SA
#undef PG8_SB
#undef PG8_STAGE
#undef PG8_LDA
#undef PG8_LDB
#undef PG8_MMA
#undef PG8_WAIT_V
#undef PG8_WAIT_L
#undef PG8_BAR
#undef PG8_SCHED
}
}
namespace attn_body {
using bf16=__hip_bfloat16;
using bf16x8=__attribute__((ext_vector_type(8)))short;
using s16x4=__attribute__((ext_vector_type(4)))short;
using f32x16=__attribute__((ext_vector_type(16)))float;
using u32x4=__attribute__((ext_vector_type(4)))unsigned;
constexpr int SEQ=8192,D=64,DM=5184,ODM=1024;
constexpr int NW=8,QBLK=32,QB=QBLK*NW,KVBLK=64,NQB=SEQ/QB;
constexpr int ATTN_PITCH=DM, ATTN_UNIT_ROWS=QB;
__device__ __forceinline__ int crow(int r,int hi){return (r&3)+8*(r>>2)+4*hi;}
#define SBAR() __builtin_amdgcn_sched_barrier(0)
__device__ __forceinline__ void cmask(f32x16&p0,f32x16&p1,int jb,int qrel,int hi){
  const float NEG=-INFINITY; int kb=64*jb+4*hi;
  #pragma unroll
  for(int r=0;r<16;++r){int kv=kb+(r&3)+8*(r>>2); if(kv>qrel)p0[r]=NEG; if(kv+32>qrel)p1[r]=NEG;}
}

constexpr int NSLOT=3, SLOTB=8192;
constexpr int LDS_K=0, LDS_V=NSLOT*SLOTB, LDS_WS=2*NSLOT*SLOTB, LDS_OST=LDS_WS+NW*64*4, LDS_BYTES=LDS_OST+NW*4096;
constexpr float C2=0.125f*1.4426950408889634f;
__device__ __forceinline__ void glds16(const void*gsrc,unsigned lds_dst){unsigned keep;
  asm volatile("s_mov_b32 %0, m0\n\ts_mov_b32 m0, %2\n\ts_nop 0\n\tglobal_load_lds_dwordx4 %1, off\n\ts_mov_b32 m0, %0":"=&s"(keep):"v"(gsrc),"s"(lds_dst):"memory");}
__device__ __forceinline__ float max3f(float a,float b,float c){float r;asm("v_max3_f32 %0, %1, %2, %3":"=v"(r):"v"(a),"v"(b),"v"(c));return r;}
__device__ __forceinline__ float max2f(float a,float b){float r;asm("v_max_f32_e32 %0, %1, %2":"=v"(r):"v"(a),"v"(b));return r;}
__device__ __forceinline__ float fadd_s(float a,float b){float r;asm("v_add_f32_e32 %0, %1, %2":"=v"(r):"v"(a),"v"(b));return r;}
__device__ __forceinline__ float fsub_s(float a,float b){float r;asm("v_sub_f32_e32 %0, %1, %2":"=v"(r):"v"(a),"v"(b));return r;}
typedef float f32x2_t __attribute__((ext_vector_type(2))); typedef __bf16 bf16x2_t __attribute__((ext_vector_type(2)));
__device__ __forceinline__ unsigned cvtpk_s(float lo,float hi){f32x2_t v={lo,hi};bf16x2_t b=__builtin_convertvector(v,bf16x2_t);return __builtin_bit_cast(unsigned,b);}
#define WAIT_BAR(N) asm volatile("s_waitcnt vmcnt(" #N ") lgkmcnt(0)\n\ts_barrier":::"memory")

__device__ __forceinline__ void qkt(f32x16&p0,f32x16&p1,const char*Kslot,const bf16x8*qr,const f32x16&negm,int r32,int hi){
  const char*kb=Kslot+hi*1024+r32*16;
  #pragma unroll
  for(int d0=0;d0<4;++d0){
    const bf16x8 b0=*reinterpret_cast<const bf16x8*>(kb+d0*2048);
    const bf16x8 b1=*reinterpret_cast<const bf16x8*>(kb+d0*2048+512);
    if(d0==0){p0=__builtin_amdgcn_mfma_f32_32x32x16_bf16(b0,qr[0],negm,0,0,0);p1=__builtin_amdgcn_mfma_f32_32x32x16_bf16(b1,qr[0],negm,0,0,0);}
    else{p0=__builtin_amdgcn_mfma_f32_32x32x16_bf16(b0,qr[d0],p0,0,0,0);p1=__builtin_amdgcn_mfma_f32_32x32x16_bf16(b1,qr[d0],p1,0,0,0);}}
}
typedef __attribute__((address_space(3))) const char* lds_cptr;
typedef short v4i16_t __attribute__((ext_vector_type(4)));
__device__ __forceinline__ void kload8(bf16x8*kf,lds_cptr kp){
  kf[0]=*(const __attribute__((address_space(3))) bf16x8*)(kp);      kf[1]=*(const __attribute__((address_space(3))) bf16x8*)(kp+512);
  kf[2]=*(const __attribute__((address_space(3))) bf16x8*)(kp+2048); kf[3]=*(const __attribute__((address_space(3))) bf16x8*)(kp+2560);
  kf[4]=*(const __attribute__((address_space(3))) bf16x8*)(kp+4096); kf[5]=*(const __attribute__((address_space(3))) bf16x8*)(kp+4608);
  kf[6]=*(const __attribute__((address_space(3))) bf16x8*)(kp+6144); kf[7]=*(const __attribute__((address_space(3))) bf16x8*)(kp+6656);
}
__device__ __forceinline__ void kload2(bf16x8*kf,lds_cptr kp,int j){ kf[2*j]=*(const __attribute__((address_space(3))) bf16x8*)(kp+j*2048); kf[2*j+1]=*(const __attribute__((address_space(3))) bf16x8*)(kp+j*2048+512); }
__device__ __forceinline__ s16x4 vtr(lds_cptr p){ return __builtin_bit_cast(s16x4,__builtin_amdgcn_ds_read_tr16_b64_v4i16((__attribute__((address_space(3))) v4i16_t*)p)); }
__device__ __forceinline__ float rowmax(const f32x16&p0,const f32x16&p1){
  float a=max3f(p0[0],p0[1],p1[0]),b=max3f(p0[2],p0[3],p1[1]);a=max3f(a,p1[2],p1[3]);
  #pragma unroll
  for(int r=4;r<16;r+=4){a=max3f(a,p0[r],p0[r+1]);b=max3f(b,p0[r+2],p0[r+3]);a=max3f(a,p1[r],p1[r+1]);b=max3f(b,p1[r+2],p1[r+3]);}
  const float m=max2f(a,b);
  auto rr=__builtin_amdgcn_permlane32_swap(__float_as_uint(m),__float_as_uint(m),false,false);
  return max2f(__uint_as_float(rr[0]),__uint_as_float(rr[1]));
}
__device__ __forceinline__ void pv(f32x16*o,int vb,bf16x8 pa0,bf16x8 pa1,bf16x8 pa2,bf16x8 pa3){
  #pragma unroll
  for(int d0=0;d0<2;++d0){s16x4 lo[4],hi[4];
    #pragma unroll
    for(int ks=0;ks<4;++ks){
      asm volatile("ds_read_b64_tr_b16 %0,%1 offset:%c2":"=&v"(lo[ks]):"v"(vb),"i"(d0*4096+ks*1024):"memory");
      asm volatile("ds_read_b64_tr_b16 %0,%1 offset:%c2":"=&v"(hi[ks]):"v"(vb),"i"(d0*4096+ks*1024+512):"memory");}
    asm volatile("s_waitcnt lgkmcnt(0)":::"memory");SBAR();
    #define PK(k) (bf16x8){lo[k][0],lo[k][1],lo[k][2],lo[k][3],hi[k][0],hi[k][1],hi[k][2],hi[k][3]}
    o[d0]=__builtin_amdgcn_mfma_f32_32x32x16_bf16(pa0,PK(0),o[d0],0,0,0);
    o[d0]=__builtin_amdgcn_mfma_f32_32x32x16_bf16(pa1,PK(1),o[d0],0,0,0);
    o[d0]=__builtin_amdgcn_mfma_f32_32x32x16_bf16(pa2,PK(2),o[d0],0,0,0);
    o[d0]=__builtin_amdgcn_mfma_f32_32x32x16_bf16(pa3,PK(3),o[d0],0,0,0);
    #undef PK
  }
}

#ifndef ATTN_STORE16
#define ATTN_STORE16(p,v) (*(u32x4*)(p)=(v))
#endif
template<int THRL> __device__ __forceinline__ void attn_unit(int qb,const bf16*Qh,const bf16* Kh,const bf16* Vh,bf16*Oh,char*shm){
  int tid_=threadIdx.x; asm volatile("":"+v"(tid_));
  const int tid=tid_,lane=tid&63,r32=lane&31,hi=lane>>5; const int wid=__builtin_amdgcn_readfirstlane(tid>>6);
  const int q0=qb*QB;
  const bf16*Qw=Qh+(long)(q0+wid*QBLK)*DM;
  const unsigned lds0=(unsigned)(uintptr_t)shm;
  float*wsf=(float*)(shm+LDS_WS)+wid*64;
  const bf16*ksrc=Kh+(long)lane*DM+wid*8;
  const bf16*vsrc=Vh+(long)(16*(wid&3)+(lane>>2))*DM+(wid>>2)*32+(lane&3)*8;
  const unsigned kdst=lds0+LDS_K+wid*1024, vdst=lds0+LDS_V+wid*1024;
  #define DMA_K(t,slot) glds16(ksrc+(long)(t)*KVBLK*DM,(unsigned)__builtin_amdgcn_readfirstlane(kdst+(slot)))
  #define DMA_V(t,slot) glds16(vsrc+(long)(t)*KVBLK*DM,(unsigned)__builtin_amdgcn_readfirstlane(vdst+(slot)))
  const int vb0=(int)(lds0+LDS_V)+((lane>>4)&1)*32+(lane&3)*8+(4*hi+((lane&15)>>2))*64;
  const char*Kbase=shm+LDS_K; bf16x8 kf[8];
  const lds_cptr shm3=(lds_cptr)shm; const lds_cptr kp0=shm3+LDS_K+hi*1024+r32*16; const lds_cptr vp0=shm3+LDS_V+((lane>>4)&1)*32+(lane&3)*8+(4*hi+((lane&15)>>2))*64;
  const int NT=(q0+QB)/KVBLK;
  DMA_K(0,0);DMA_V(0,0);DMA_K(1,SLOTB);
  bf16x8 qr[4];
  #pragma unroll
  for(int d0=0;d0<4;++d0)qr[d0]=*reinterpret_cast<const bf16x8*>(&Qw[(long)r32*DM+d0*16+hi*8]);
  float mhat=0.f,l_reg=0.f;f32x16 o[2];o[0]=f32x16{};o[1]=f32x16{};f32x16 negm=f32x16{};asm volatile("":"+v"(negm));
  const int qrel=wid*QBLK+r32;
  #define CMASK(P0,P1,t) do{int jb_=(t)-(NT-4); if(jb_>=0)cmask(P0,P1,jb_,qrel,hi);}while(0)
  bool resc=false;
  #define START(P0,P1) do{ const float rm=rowmax(P0,P1); resc=false; \
    { const float dl=rm; mhat=fadd_s(mhat,dl); \
      _Pragma("unroll") for(int r=0;r<16;++r){P0[r]=fsub_s(P0[r],dl);P1[r]=fsub_s(P1[r],dl);} \
      _Pragma("unroll") for(int r=0;r<16;++r)negm[r]=-mhat; asm volatile("":"+v"(negm)); } \
    _Pragma("unroll") for(int r=0;r<16;++r)P0[r]=__builtin_amdgcn_exp2f(P0[r]); }while(0)
  #define RESC() do{ if(resc){ asm volatile("s_waitcnt lgkmcnt(0)":::"memory"); \
      _Pragma("unroll") for(int d_=0;d_<2;++d_) _Pragma("unroll") for(int r=0;r<16;++r)o[d_][r]*=wsf[crow(r,hi)]; } }while(0)
  f32x16 pA0,pA1,pB0,pB1;
  int sl_prev=0,sl_cur=0,sl_next=SLOTB;
  #define ROT() do{sl_prev=sl_cur;sl_cur=sl_next;sl_next=(sl_next==(NSLOT-1)*SLOTB)?0:sl_next+SLOTB;}while(0)
  DMA_K(2,2*SLOTB);
  WAIT_BAR(3);
  qkt(pA0,pA1,Kbase,qr,negm,r32,hi);asm volatile("s_nop 15\n\ts_nop 7":"+v"(pA0),"+v"(pA1));CMASK(pA0,pA1,0);
  START(pA0,pA1);
  _Pragma("unroll") for(int r=0;r<16;++r)pA1[r]=__builtin_amdgcn_exp2f(pA1[r]);
  WAIT_BAR(0);
  DMA_K(3,0);DMA_V(1,SLOTB);
  ROT();
  kload8(kf,kp0+sl_cur);
  WAIT_BAR(2);
  s16x4 vlo[8],vhi[8]; u32x4 pw0,pw1,pw2,pw3;
  #define PKW(P,B) cvtpk_s(P[B],P[B+1])
  #define PAF(k) __builtin_bit_cast(bf16x8,pw##k)
  #define VFR(i) (bf16x8){vlo[i][0],vlo[i][1],vlo[i][2],vlo[i][3],vhi[i][0],vhi[i][1],vhi[i][2],vhi[i][3]}
  #define PIN(x) asm volatile("":"+v"(x))
  #define MX3(a,b,c) __builtin_fmaxf(__builtin_fmaxf((a),(b)),(c))
  #define GAPA(MF,A0,A1,A2,A3,W0,W1,PW) do{ MF; sacc+=A0; sacc+=A1; sacc+=A2; sacc+=A3; PIN(sacc); W0; W1; PIN(PW); SBAR(); }while(0)
  #define EX(v) __builtin_amdgcn_exp2f(v)
  #define GAPB(MF,X,B) do{ MF; X[B]=EX(X[B]); X[B+1]=EX(X[B+1]); X[B+2]=EX(X[B+2]); X[B+3]=EX(X[B+3]); PIN(X); SBAR(); }while(0)
  #define VRD(i) do{ vlo[i]=vtr(vp_+(((i)>>2)*4096+((i)&3)*1024)); vhi[i]=vtr(vp_+(((i)>>2)*4096+((i)&3)*1024+512)); }while(0)
  #define KRD(G,j) do{ if(G){ kload2(kf,kp0+sl_next,j); SBAR(); } }while(0)
  #define STEP(C0,C1,P0,P1,t,GK,GV,GL) do{ SBAR(); \
    const lds_cptr vp_=vp0+sl_prev; \
    VRD(0); SBAR(); float sacc=(P0[0]+P0[1]); \
    GAPA(C0=__builtin_amdgcn_mfma_f32_32x32x16_bf16(kf[0],qr[0],negm,0,0,0), P0[2],P0[3],P0[4],P0[5],     pw0[0]=PKW(P0,0), pw0[1]=PKW(P0,2), pw0); \
    VRD(4); SBAR(); GAPA(C1=__builtin_amdgcn_mfma_f32_32x32x16_bf16(kf[1],qr[0],negm,0,0,0), P0[6],P0[7],P0[8],P0[9],     pw0[2]=PKW(P0,4), pw0[3]=PKW(P0,6), pw0); \
    VRD(1); SBAR(); GAPA(C0=__builtin_amdgcn_mfma_f32_32x32x16_bf16(kf[2],qr[1],C0,0,0,0),   P0[10],P0[11],P0[12],P0[13], pw1[0]=PKW(P0,8), pw1[1]=PKW(P0,10), pw1); \
    VRD(5); SBAR(); GAPA(C1=__builtin_amdgcn_mfma_f32_32x32x16_bf16(kf[3],qr[1],C1,0,0,0),   P0[14],P0[15],P1[0],P1[1],   pw1[2]=PKW(P0,12),pw1[3]=PKW(P0,14), pw1); \
    VRD(2); SBAR(); GAPA(C0=__builtin_amdgcn_mfma_f32_32x32x16_bf16(kf[4],qr[2],C0,0,0,0),   P1[2],P1[3],P1[4],P1[5],     pw2[0]=PKW(P1,0), pw2[1]=PKW(P1,2), pw2); \
    VRD(6); SBAR(); GAPA(C1=__builtin_amdgcn_mfma_f32_32x32x16_bf16(kf[5],qr[2],C1,0,0,0),   P1[6],P1[7],P1[8],P1[9],     pw2[2]=PKW(P1,4), pw2[3]=PKW(P1,6), pw2); \
    VRD(3); SBAR(); GAPA(C0=__builtin_amdgcn_mfma_f32_32x32x16_bf16(kf[6],qr[3],C0,0,0,0),   P1[10],P1[11],P1[12],P1[13], pw3[0]=PKW(P1,8), pw3[1]=PKW(P1,10), pw3); \
    VRD(7); SBAR(); GAPA(C1=__builtin_amdgcn_mfma_f32_32x32x16_bf16(kf[7],qr[3],C1,0,0,0),   P1[14],P1[15],0.f,0.f,       pw3[2]=PKW(P1,12),pw3[3]=PKW(P1,14), pw3); \
    l_reg+=sacc; \
    if(GK){DMA_K((t)+3,sl_cur);} if(GV){DMA_V((t)+1,sl_next);} \
    CMASK(C0,C1,t); \
    { float a=MX3(C0[0],C0[1],C1[0]),b=MX3(C0[2],C0[3],C1[1]); a=MX3(a,C1[2],C1[3]); \
      _Pragma("unroll") for(int r=4;r<16;r+=4){a=MX3(a,C0[r],C0[r+1]);b=MX3(b,C0[r+2],C0[r+3]);a=MX3(a,C1[r],C1[r+1]);b=MX3(b,C1[r+2],C1[r+3]);} \
      float rm=__builtin_fmaxf(a,b); { auto rr=__builtin_amdgcn_permlane32_swap(__float_as_uint(rm),__float_as_uint(rm),false,false); rm=__builtin_fmaxf(__uint_as_float(rr[0]),__uint_as_float(rr[1])); } \
      resc=false; \
      if(__builtin_expect(__any(rm>(float)THRL),0)){ const float dl=__builtin_fmaxf(rm,0.f); mhat+=dl; \
        _Pragma("unroll") for(int r=0;r<16;++r){C0[r]-=dl;C1[r]-=dl;} \
        _Pragma("unroll") for(int r=0;r<16;++r)negm[r]=-mhat; asm volatile("":"+v"(negm)); \
        const float f=__builtin_amdgcn_exp2f(-dl); l_reg*=f; if(hi==0)wsf[r32]=f; resc=true; } } \
    SBAR(); \
    GAPB(o[0]=__builtin_amdgcn_mfma_f32_32x32x16_bf16(PAF(0),VFR(0),o[0],0,0,0), C0,0); \
    GAPB(o[1]=__builtin_amdgcn_mfma_f32_32x32x16_bf16(PAF(0),VFR(4),o[1],0,0,0), C0,4); \
    KRD(GL,0); GAPB(o[0]=__builtin_amdgcn_mfma_f32_32x32x16_bf16(PAF(1),VFR(1),o[0],0,0,0), C0,8); \
    KRD(GL,1); GAPB(o[1]=__builtin_amdgcn_mfma_f32_32x32x16_bf16(PAF(1),VFR(5),o[1],0,0,0), C0,12); \
    KRD(GL,2); GAPB(o[0]=__builtin_amdgcn_mfma_f32_32x32x16_bf16(PAF(2),VFR(2),o[0],0,0,0), C1,0); \
    KRD(GL,3); GAPB(o[1]=__builtin_amdgcn_mfma_f32_32x32x16_bf16(PAF(2),VFR(6),o[1],0,0,0), C1,4); \
    GAPB(o[0]=__builtin_amdgcn_mfma_f32_32x32x16_bf16(PAF(3),VFR(3),o[0],0,0,0), C1,8); \
    GAPB(o[1]=__builtin_amdgcn_mfma_f32_32x32x16_bf16(PAF(3),VFR(7),o[1],0,0,0), C1,12); \
    }while(0)
  int t=1;
  #undef CMASK
  #define CMASK(P0,P1,t) do{}while(0)
  for(;t+5<NT;t+=2){
    STEP(pB0,pB1,pA0,pA1,t,true,true,true);     WAIT_BAR(2); RESC(); ROT();
    STEP(pA0,pA1,pB0,pB1,t+1,true,true,true);   WAIT_BAR(2); RESC(); ROT();
  }
  #undef CMASK
  #define CMASK(P0,P1,t) do{int jb_=(t)-(NT-4); if(jb_>=0)cmask(P0,P1,jb_,qrel,hi);}while(0)
  #define ENDW(tt) do{ if((tt)+3<NT){WAIT_BAR(2);} else if((tt)+2<NT){WAIT_BAR(1);} else {WAIT_BAR(0);} }while(0)
  for(;t+1<NT;t+=2){
    STEP(pB0,pB1,pA0,pA1,t,(t+3<NT),(t+1<NT),(t+1<NT));       ENDW(t);   RESC(); ROT();
    STEP(pA0,pA1,pB0,pB1,t+1,(t+4<NT),(t+2<NT),(t+2<NT));     ENDW(t+1); RESC(); ROT();
  }
  STEP(pB0,pB1,pA0,pA1,NT-1,false,false,false); RESC();
  { float sacc=pB0[0]+pB0[1]; _Pragma("unroll") for(int r=2;r<16;++r)sacc+=pB0[r]; _Pragma("unroll") for(int r=0;r<16;++r)sacc+=pB1[r]; l_reg+=sacc;
    pw0=(u32x4){PKW(pB0,0),PKW(pB0,2),PKW(pB0,4),PKW(pB0,6)};pw1=(u32x4){PKW(pB0,8),PKW(pB0,10),PKW(pB0,12),PKW(pB0,14)};pw2=(u32x4){PKW(pB1,0),PKW(pB1,2),PKW(pB1,4),PKW(pB1,6)};pw3=(u32x4){PKW(pB1,8),PKW(pB1,10),PKW(pB1,12),PKW(pB1,14)};
    SBAR(); pv(o,vb0+sl_cur,PAF(0),PAF(1),PAF(2),PAF(3)); }
  #undef PKW
  #undef PAF
  #undef VFR
  #undef PIN
  #undef MX3
  #undef GAPA
  #undef GAPB
  #undef EX
  #undef VRD
  #undef KRD
  #undef STEP
  #undef ENDW
  {auto rr=__builtin_amdgcn_permlane32_swap(__float_as_uint(l_reg),__float_as_uint(l_reg),false,false);l_reg=__uint_as_float(rr[0])+__uint_as_float(rr[1]);}
  if(hi==0)wsf[32+r32]=l_reg;asm volatile("s_waitcnt lgkmcnt(0)":::"memory");
  float rli[16];
  #pragma unroll
  for(int r=0;r<16;++r)rli[r]=__builtin_amdgcn_rcpf(wsf[32+crow(r,hi)]);
  bf16*Ow=Oh+(long)(q0+wid*QBLK)*ODM;
  { bf16*stg=(bf16*)(shm+LDS_OST)+wid*2048;
    #pragma unroll
    for(int r=0;r<16;++r){const int orow=crow(r,hi);
      #pragma unroll
      for(int d0=0;d0<2;++d0)stg[orow*64+d0*32+r32]=__float2bfloat16(o[d0][r]*rli[r]);}
    asm volatile("s_waitcnt lgkmcnt(0)":::"memory");
    #pragma unroll
    for(int i=0;i<4;++i){const int row=i*8+(lane>>3),ch=lane&7; const u32x4 v=*(const u32x4*)(stg+row*64+ch*8); ATTN_STORE16(Ow+(long)row*ODM+ch*8,v);} }
  asm volatile("s_waitcnt lgkmcnt(0)\n\ts_barrier":::"memory");
  #undef DMA_K
  #undef DMA_V
  #undef CMASK
  #undef START
  #undef RESC
  #undef ROT
}
constexpr int ATTN_LDS_BYTES=LDS_BYTES;
#undef SBAR
#undef WAIT_BAR
}
#define GAS __attribute__((address_space(1)))
#define LAS __attribute__((address_space(3)))
typedef unsigned short bf16;
typedef unsigned v4u __attribute__((ext_vector_type(4)));
typedef float f32x4 __attribute__((ext_vector_type(4)));
typedef short bf16x8 __attribute__((ext_vector_type(8)));
typedef GAS unsigned gu32;
typedef GAS unsigned long long gu64;
#define RLX_AGENT __ATOMIC_RELAXED, __HIP_MEMORY_SCOPE_AGENT
#define LDS_WAIT() asm volatile("s_waitcnt lgkmcnt(0)" ::: "memory")
#define VM_WAIT() asm volatile("s_waitcnt vmcnt(0)" ::: "memory")
__device__ __forceinline__ unsigned long long rt() { return __builtin_amdgcn_s_memrealtime(); }
__device__ __forceinline__ unsigned f2bf(float f) { unsigned u = __builtin_bit_cast(unsigned, f); return (u + 0x7fffu + ((u >> 16) & 1u)) >> 16; }
__device__ __forceinline__ unsigned pk2(float lo, float hi) { return f2bf(lo) | (f2bf(hi) << 16); }

#define XB_TMO      128
#define XB_XCNT(j)  (256  + 64 * (j))
#define XB_XSUB(j)  (1280 + 64 * (j))
#define XB_XGEN(j)  (2304 + 64 * (j))
#define XB_TOP      3328
#define XB_TOPGEN   3392
#define XCD_BAR_WORDS 3456
#define XB_SPIN_CAP (1u << 18)

__device__ __forceinline__ unsigned xb_ld(unsigned* p)              { return __hip_atomic_load(p, __ATOMIC_RELAXED, __HIP_MEMORY_SCOPE_AGENT); }
__device__ __forceinline__ unsigned xb_add(unsigned* p, unsigned v) { return __hip_atomic_fetch_add(p, v, __ATOMIC_RELAXED, __HIP_MEMORY_SCOPE_AGENT); }
__device__ __forceinline__ unsigned xb_xcc_id() { return (unsigned)__builtin_amdgcn_s_getreg((3 << 11) | 20) & 0xFu; }
#define XB_SPIN(cond, bar) do { unsigned _sp = 0; while (cond) { __builtin_amdgcn_s_sleep(1); \
    if ((++_sp & 255u) == 0u) { if (xb_ld(&(bar)[XB_TMO])) break; if (_sp > XB_SPIN_CAP) { atomicAdd(&(bar)[XB_TMO], 1u); break; } } } } while (0)

struct XcdBarrier {
    unsigned* bar; unsigned x;
    volatile LAS unsigned* st;
};

__device__ __forceinline__ XcdBarrier xcd_barrier_post(unsigned* bar, volatile LAS unsigned* st) {
    XcdBarrier b; b.bar = bar; b.x = xb_xcc_id(); b.st = st;
    if (threadIdx.x == 0) (void)xb_add(&bar[XB_XCNT(b.x)], 1u);
    return b;
}
__device__ __forceinline__ void xcd_barrier_complete(unsigned* bar, unsigned x, unsigned& nloc, unsigned& nx) {
    const unsigned G = gridDim.x * gridDim.y * gridDim.z;
    unsigned sum, cnt, mine, sp = 0u;
    for (;;) {
        sum = 0u; cnt = 0u; mine = 0u;
#pragma unroll
        for (unsigned j = 0; j < 16; ++j) { const unsigned c = xb_ld(&bar[XB_XCNT(j)]); sum += c; cnt += (c > 0u) ? 1u : 0u; mine = (j == x) ? c : mine; }
        if (sum == G) break;
        __builtin_amdgcn_s_sleep(1);
        if ((++sp & 255u) == 0u) { if (xb_ld(&bar[XB_TMO])) break; if (sp > XB_SPIN_CAP) { atomicAdd(&bar[XB_TMO], 1u); break; } }
    }
    nloc = mine > 0u ? mine : 1u; nx = cnt > 0u ? cnt : 1u;
}

__device__ __forceinline__ void xcd_barrier(const XcdBarrier& b) {
    asm volatile("s_waitcnt vmcnt(0)" ::: "memory");
    __syncthreads();
    if (threadIdx.x == 0) {
        unsigned* bar = b.bar;
        __builtin_amdgcn_s_waitcnt(0);
        unsigned nloc = b.st[0], nx = b.st[1];
        if (nloc == 0u) { xcd_barrier_complete(bar, b.x, nloc, nx); b.st[0] = nloc; b.st[1] = nx; }
        const unsigned old = xb_add(&bar[XB_XSUB(b.x)], 1u);
        const unsigned gen = old / nloc;
        if (old + 1u == (gen + 1u) * nloc) {
            __builtin_amdgcn_fence(__ATOMIC_RELEASE, "agent");
            asm volatile("s_waitcnt vmcnt(0)" ::: "memory");
            const unsigned og = xb_add(&bar[XB_TOP], 1u);
            const unsigned tg = og / nx;
            if (og + 1u == (tg + 1u) * nx) xb_add(&bar[XB_TOPGEN], 1u);
            else XB_SPIN(xb_ld(&bar[XB_TOPGEN]) == tg, bar);
            __builtin_amdgcn_fence(__ATOMIC_ACQUIRE, "agent");
            xb_add(&bar[XB_XGEN(b.x)], 1u);
            asm volatile("s_waitcnt vmcnt(0)" ::: "memory");
        } else {
            XB_SPIN(xb_ld(&bar[XB_XGEN(b.x)]) == gen, bar);
            __builtin_amdgcn_fence(__ATOMIC_ACQUIRE, "agent");
            asm volatile("s_waitcnt vmcnt(0)" ::: "memory");
        }
    }
    __syncthreads();
}

namespace cw {
typedef unsigned short u16;
typedef short bf16x8 __attribute__((ext_vector_type(8)));
typedef float f32x16 __attribute__((ext_vector_type(16)));
typedef float f32x4 __attribute__((ext_vector_type(4)));
typedef unsigned u32x4 __attribute__((ext_vector_type(4)));
typedef unsigned u32x2 __attribute__((ext_vector_type(2)));
typedef __bf16 bf16x2_t __attribute__((ext_vector_type(2)));
#define CW_LAS __attribute__((address_space(3)))
constexpr int SEQ = 8192, DMODEL = 2048, PITCH = 5184;
constexpr int AQ = 0, AK = 512, AV = 640, BQ = 768, BK_ = 1280, BV = 1792, CQ = 2304, CK = 2816, CV = 3328, DQ = 3840, DK = 4352, DV = 4416, IQ = 4480, IK = 4992, IW = 5056;
constexpr float LOG2E = 1.4426950408889634f;
constexpr float NEGINF = -INFINITY;
#ifndef PEER_G1
#define PEER_G1 4
#endif
#ifndef PEER_G2
#define PEER_G2 2
#endif
#ifndef DUPSUB
#define DUPSUB 0
#endif
#ifndef ABL
#define ABL 0
#endif
constexpr float KA = (ABL == 1) ? 0.f : 1.f, KC = (ABL == 2) ? 0.f : 1.f, KD = (ABL == 3) ? 0.f : 1.f, KP = (ABL == 4) ? 0.f : 1.f, KB = (ABL == 5) ? 0.f : 1.f;

__device__ __forceinline__ int crow(int r, int hi) { return (r & 3) + 8 * (r >> 2) + 4 * hi; }
__device__ __forceinline__ float bf2f(unsigned b) { return __uint_as_float(b << 16); }
__device__ __forceinline__ unsigned f2bf(float f) { unsigned u = __float_as_uint(f); return (u + 0x7fffu + ((u >> 16) & 1u)) >> 16; }
__device__ __forceinline__ unsigned pk2(float lo, float hi) { typedef float f2_ __attribute__((ext_vector_type(2))); typedef __bf16 b2_ __attribute__((ext_vector_type(2))); const f2_ v = {lo, hi}; return __builtin_bit_cast(unsigned, __builtin_convertvector(v, b2_)); }
__device__ __forceinline__ float ex2(float x) { return __builtin_amdgcn_exp2f(x); }
__device__ __forceinline__ float pair_max(float v) { auto rr = __builtin_amdgcn_permlane32_swap(__float_as_uint(v), __float_as_uint(v), false, false); return fmaxf(__uint_as_float(rr[0]), __uint_as_float(rr[1])); }
__device__ __forceinline__ float pair_sum(float v) { auto rr = __builtin_amdgcn_permlane32_swap(__float_as_uint(v), __float_as_uint(v), false, false); return __uint_as_float(rr[0]) + __uint_as_float(rr[1]); }
__device__ __forceinline__ float wave_sum(float v) {
#pragma unroll
    for (int o = 1; o < 64; o <<= 1) v += __shfl_xor(v, o);
    return v;
}
__device__ __forceinline__ bf16x8 ld8(const u16* p) { return *(const bf16x8*)p; }
__device__ __forceinline__ unsigned pkh(float lo, float hi) { typedef _Float16 h2 __attribute__((ext_vector_type(2))); const h2 v = {(_Float16)lo, (_Float16)hi}; return __builtin_bit_cast(unsigned, v); }
__device__ __forceinline__ unsigned __builtin_amdgcn_mad_u32_u24_compat(unsigned a, unsigned b, unsigned c) { return __umul24(a, b) + c; }

struct BState { f32x16 o0, o1; float m, l; };
typedef short s16x4 __attribute__((ext_vector_type(4)));
template <bool GATHER = false>
__device__ __forceinline__ void band_accum(BState& st, const bf16x8 (&qf)[4], const u16* Kb, const u16* Vb, int kres, int kdil, int pq, int pstart, int ntiles, int maxd, int lane, CW_LAS unsigned char* bst, CW_LAS const u16* idx16 = nullptr) {
    const int r32 = lane & 31, hi = lane >> 5;
    const int pmax = (SEQ - 1 - kres) / kdil;
    const int lrow = lane >> 3; const unsigned kgo = 8u * (unsigned)((lane & 7) ^ (lrow & 7)), vgo = 8u * (unsigned)(lane & 7);
    CW_LAS const unsigned char* krd = bst + r32 * 128; const int kx = r32 & 7;
    CW_LAS const unsigned char* vrd = bst + 4096 + (4 * hi + ((lane & 15) >> 2)) * 128 + (16 * ((lane >> 4) & 1) + 4 * (lane & 3)) * 2;
#define BA_LOAD(buf, KT) do { const int p0_ = pstart + 32 * (KT); \
        _Pragma("unroll") for (int m_ = 0; m_ < 4; ++m_) { int pk_ = p0_ + 8 * m_ + lrow; size_t ro_; if constexpr (GATHER) ro_ = (size_t)((unsigned)idx16[pk_] & 0x1fffu) * PITCH; else { pk_ = pk_ > pmax ? pmax : pk_; ro_ = (size_t)(kres + kdil * pk_) * PITCH; } \
            __builtin_amdgcn_global_load_lds((const unsigned*)(Kb + ro_ + kgo), (CW_LAS unsigned*)(bst + (buf) * 8192 + m_ * 1024), 16, 0, 0); \
            __builtin_amdgcn_global_load_lds((const unsigned*)(Vb + ro_ + vgo), (CW_LAS unsigned*)(bst + (buf) * 8192 + 4096 + m_ * 1024), 16, 0, 0); } } while (0)
#define BA_READ(kf, vt, buf) do { \
        _Pragma("unroll") for (int d0 = 0; d0 < 4; ++d0) kf[d0] = *(const CW_LAS bf16x8*)(krd + (buf) * 8192 + 16 * ((2 * d0 + hi) ^ kx)); \
        _Pragma("unroll") for (int s_ = 0; s_ < 2; ++s_) _Pragma("unroll") for (int jh_ = 0; jh_ < 2; ++jh_) _Pragma("unroll") for (int b_ = 0; b_ < 2; ++b_) \
            vt[s_][jh_][b_] = __builtin_bit_cast(s16x4, __builtin_amdgcn_ds_read_tr16_b64_v4i16((CW_LAS s16x4*)(vrd + (buf) * 8192 + (16 * s_ + 8 * jh_) * 128 + 64 * b_))); } while (0)
#define BA_QK(s16, kf) do { s16 = (f32x16){0.f, 0.f, 0.f, 0.f, 0.f, 0.f, 0.f, 0.f, 0.f, 0.f, 0.f, 0.f, 0.f, 0.f, 0.f, 0.f}; \
        _Pragma("unroll") for (int d0 = 0; d0 < 4; ++d0) s16 = __builtin_amdgcn_mfma_f32_32x32x16_bf16(kf[d0], qf[d0], s16, 0, 0, 0); __builtin_amdgcn_sched_barrier(0); } while (0)
#define BA_SOFTPV(s16, vt, KT) do { const int p0_ = pstart + 32 * (KT); \
        float rm = NEGINF; \
        { const int mb_ = GATHER ? (maxd - p0_ - 4 * hi) : (pq - p0_ - 4 * hi);     \
        _Pragma("unroll") for (int r = 0; r < 16; ++r) { const int c_ = (r & 3) + 8 * (r >> 2); const bool ok = GATHER ? (c_ < mb_) : ((unsigned)(mb_ - c_) <= (unsigned)maxd); s16[r] = ok ? s16[r] : NEGINF; rm = fmaxf(rm, s16[r]); } } \
        rm = pair_max(rm); \
        const float mn = fmaxf(st.m, rm), mu = (mn == NEGINF) ? 0.f : mn; \
        const float alpha = ex2(st.m - mu); \
        float ps = 0.f; \
        _Pragma("unroll") for (int r = 0; r < 16; ++r) { s16[r] = ex2(s16[r] - mu); ps += s16[r]; } \
        ps = pair_sum(ps); \
        st.l = st.l * alpha + ps; st.m = mn; \
        if (__any(alpha != 1.0f)) { _Pragma("unroll") for (int r = 0; r < 16; ++r) { st.o0[r] *= alpha; st.o1[r] *= alpha; } }     \
        _Pragma("unroll") for (int s_ = 0; s_ < 2; ++s_) { \
            u32x4 pw; pw.x = pk2(s16[8 * s_ + 0], s16[8 * s_ + 1]); pw.y = pk2(s16[8 * s_ + 2], s16[8 * s_ + 3]); pw.z = pk2(s16[8 * s_ + 4], s16[8 * s_ + 5]); pw.w = pk2(s16[8 * s_ + 6], s16[8 * s_ + 7]); \
            const bf16x8 pf = __builtin_bit_cast(bf16x8, pw); \
            st.o0 = __builtin_amdgcn_mfma_f32_32x32x16_bf16(__builtin_shufflevector(vt[s_][0][0], vt[s_][1][0], 0, 1, 2, 3, 4, 5, 6, 7), pf, st.o0, 0, 0, 0); \
            st.o1 = __builtin_amdgcn_mfma_f32_32x32x16_bf16(__builtin_shufflevector(vt[s_][0][1], vt[s_][1][1], 0, 1, 2, 3, 4, 5, 6, 7), pf, st.o1, 0, 0, 0); } \
        __builtin_amdgcn_sched_barrier(0); } while (0)
#define BA_NEXT(kf, vt, s16, buf, KTL) do { asm volatile("s_waitcnt vmcnt(8)" ::: "memory"); BA_READ(kf, vt, buf); asm volatile("s_waitcnt lgkmcnt(0)" ::: "memory"); \
        { const int kn_ = ((KTL) < ntiles) ? (KTL) : ntiles - 1; BA_LOAD(buf, kn_); } BA_QK(s16, kf); } while (0)
    bf16x8 kfA[4], kfB[4]; s16x4 vtA[2][2][2], vtB[2][2][2]; f32x16 sA, sB;
    asm volatile("s_waitcnt lgkmcnt(0)" ::: "memory"); BA_LOAD(0, 0); BA_LOAD(1, (1 < ntiles) ? 1 : ntiles - 1);
    BA_NEXT(kfA, vtA, sA, 0, 2);
#pragma unroll 1
    for (int kt = 0; kt < ntiles; kt += 2) {
        if (kt + 1 < ntiles) BA_NEXT(kfB, vtB, sB, 1, kt + 3);
        BA_SOFTPV(sA, vtA, kt);
        if (kt + 1 < ntiles) {
            if (kt + 2 < ntiles) BA_NEXT(kfA, vtA, sA, 0, kt + 4);
            BA_SOFTPV(sB, vtB, kt + 1);
        }
    }
    asm volatile("s_waitcnt vmcnt(0)" ::: "memory");
#undef BA_LOAD
#undef BA_READ
#undef BA_QK
#undef BA_SOFTPV
#undef BA_NEXT
}
__device__ __forceinline__ void bstate_init(BState& st) {
#pragma unroll
    for (int r = 0; r < 16; ++r) { st.o0[r] = 0.f; st.o1[r] = 0.f; }
    st.m = NEGINF; st.l = 0.f;
}
__device__ __forceinline__ void bstate_store(const BState& st, float f, u16* orow, int hi) {
#pragma unroll
    for (int b = 0; b < 2; ++b)
#pragma unroll
        for (int g = 0; g < 4; ++g) {
            const f32x16& o = b ? st.o1 : st.o0;
            u32x2 w; w.x = pk2(o[4 * g] * f, o[4 * g + 1] * f); w.y = pk2(o[4 * g + 2] * f, o[4 * g + 3] * f);
            *(u32x2*)(orow + 32 * b + 8 * g + 4 * hi) = w;
        }
}
__device__ __forceinline__ void swa_item(const u16* proj, u16* mixed, const float* sinks, int hq, int qt, int lane, CW_LAS unsigned char* bst) {
    const int r32 = lane & 31, hi = lane >> 5, t0 = 32 * qt, kvh = hq >> 2;
    const u16* qrow = proj + (size_t)(t0 + r32) * PITCH + AQ + hq * 64 + 8 * hi;
    bf16x8 qf[4];
#pragma unroll
    for (int d0 = 0; d0 < 4; ++d0) qf[d0] = ld8(qrow + 16 * d0);
    BState st; bstate_init(st);
    int pstart = t0 - 127; pstart = pstart < 0 ? 0 : pstart;
    const int ntiles = (t0 + 31 - pstart) / 32 + 1;
    band_accum(st, qf, proj + AK + kvh * 64, proj + AV + kvh * 64, 0, 1, t0 + r32, pstart, ntiles, 127, lane, bst);
    const float sink2 = sinks[hq] * LOG2E;
    const float mall = fmaxf(st.m, sink2), corr = ex2(st.m - mall), den = st.l * corr + ex2(sink2 - mall);
    bstate_store(st, KA * corr / den, mixed + (size_t)(t0 + r32) * DMODEL + 0 + hq * 64, hi);
}
__device__ __forceinline__ void dil_item(const u16* proj, u16* mixed, int h, int r16, int jb, int lane, CW_LAS unsigned char* bst) {
    const int r32 = lane & 31, hi = lane >> 5;
    const int tq = r16 + 16 * (32 * jb + r32);
    const int tq_lo = r16 + 16 * (32 * jb), tq_hi = tq_lo + 16 * 31;
    const u16* qrow = proj + (size_t)tq * PITCH + CQ + h * 64 + 8 * hi;
    bf16x8 qf[4];
#pragma unroll
    for (int d0 = 0; d0 < 4; ++d0) qf[d0] = ld8(qrow + 16 * d0);
    BState st; bstate_init(st);
    const u16* Kb = proj + CK + h * 64; const u16* Vb = proj + CV + h * 64;
    {
        int ps = tq_lo - 128; ps = ps < 0 ? 0 : ps; const int nt = (tq_hi - ps) / 32 + 1;
        band_accum(st, qf, Kb, Vb, 0, 1, tq, ps, nt, 128, lane, bst);
    }
    {
        const int res = r16 & 3; int ps = (tq_lo >> 2) - 128; ps = ps < 0 ? 0 : ps; const int nt = ((tq_hi >> 2) - ps) / 32 + 1;
        band_accum(st, qf, Kb, Vb, res, 4, tq >> 2, ps, nt, 128, lane, bst);
    }
    {
        int ps = (tq_lo >> 4) - 128; ps = ps < 0 ? 0 : ps; const int nt = ((tq_hi >> 4) - ps) / 32 + 1;
        band_accum(st, qf, Kb, Vb, r16, 16, tq >> 4, ps, nt, 128, lane, bst);
    }
    bstate_store(st, KC * 1.0f / st.l, mixed + (size_t)tq * DMODEL + 1024 + h * 64, hi);
}

__device__ __forceinline__ void idx_item(const u16* proj, u16* scores, int qt, int c, int rot_seed, int lane, CW_LAS unsigned char* kst, bool do_store = true) {
    const int q = lane & 15, kq = lane >> 4, t = 16 * qt + q;
    asm volatile("s_waitcnt lgkmcnt(0)" ::: "memory");
    { const u16* qg = proj + (size_t)(16 * qt) * PITCH + IQ;
#pragma unroll
      for (int r = 0; r < 16; ++r) __builtin_amdgcn_global_load_lds((const unsigned*)(qg + (size_t)r * PITCH + 8 * (lane ^ r)), (CW_LAS unsigned*)(kst + r * 1024), 16, 0, 0); }
    float w[8];
    { const u32x4 wv = *(const u32x4*)(proj + (size_t)t * PITCH + IW);
      const float sc = 0.35355339059327373f;
      w[0] = bf2f(wv.x & 0xffffu) * sc; w[1] = bf2f(wv.x >> 16) * sc; w[2] = bf2f(wv.y & 0xffffu) * sc; w[3] = bf2f(wv.y >> 16) * sc;
      w[4] = bf2f(wv.z & 0xffffu) * sc; w[5] = bf2f(wv.z >> 16) * sc; w[6] = bf2f(wv.w & 0xffffu) * sc; w[7] = bf2f(wv.w >> 16) * sc; }
    asm volatile("s_waitcnt vmcnt(0)" ::: "memory");
    bf16x8 qf[8][2];
#pragma unroll
    for (int h = 0; h < 8; ++h)
#pragma unroll
        for (int s_ = 0; s_ < 2; ++s_) qf[h][s_] = *(const CW_LAS bf16x8*)(kst + q * 1024 + 16 * ((8 * h + 4 * s_ + kq) ^ q));
    asm volatile("s_waitcnt lgkmcnt(0)" ::: "memory");
    const int kt_end = (16 * c + 15 < qt) ? 16 * c + 15 : qt;
    const u16* kgl = proj + (size_t)(lane >> 3) * PITCH + IK + 8 * ((lane & 7) ^ ((lane >> 3) & 7));
    CW_LAS const unsigned char* krd = kst + q * 128;
    const int kp0 = 16 * (kq ^ (q & 7)), kp1 = 16 * ((4 + kq) ^ (q & 7));
#define IDX_STAGE(gb, ktg) do { _Pragma("unroll") for (int u_ = 0; u_ < 4; ++u_) { int kk_ = (ktg) + u_; kk_ = kk_ > kt_end ? kt_end : kk_; const u16* kr_ = kgl + (size_t)(16 * kk_) * PITCH; \
        __builtin_amdgcn_global_load_lds((const unsigned*)kr_, (CW_LAS unsigned*)(kst + (gb) * 8192 + u_ * 2048), 16, 0, 0); \
        __builtin_amdgcn_global_load_lds((const unsigned*)(kr_ + (size_t)8 * PITCH), (CW_LAS unsigned*)(kst + (gb) * 8192 + u_ * 2048 + 1024), 16, 0, 0); } } while (0)
#define IDX_COMP(gb, ktg) do { bf16x8 kf_[4][2];   \
        _Pragma("unroll") for (int u_ = 0; u_ < 4; ++u_) { kf_[u_][0] = *(const CW_LAS bf16x8*)(krd + (gb) * 8192 + u_ * 2048 + kp0); kf_[u_][1] = *(const CW_LAS bf16x8*)(krd + (gb) * 8192 + u_ * 2048 + kp1); } \
        _Pragma("unroll") for (int u_ = 0; u_ < 4; ++u_) { const int kk_ = (ktg) + u_; if (kk_ <= kt_end) { \
        f32x4 s8[8];   \
        _Pragma("unroll") for (int h = 0; h < 8; ++h) { s8[h] = (f32x4){0.f, 0.f, 0.f, 0.f}; s8[h] = __builtin_amdgcn_mfma_f32_16x16x32_bf16(kf_[u_][0], qf[h][0], s8[h], 0, 0, 0); } \
        _Pragma("unroll") for (int h = 0; h < 8; ++h) s8[h] = __builtin_amdgcn_mfma_f32_16x16x32_bf16(kf_[u_][1], qf[h][1], s8[h], 0, 0, 0); \
        f32x4 acc_ = {0.f, 0.f, 0.f, 0.f}; \
        _Pragma("unroll") for (int h = 0; h < 8; ++h) { _Pragma("unroll") for (int r = 0; r < 4; ++r) acc_[r] += w[h] * __builtin_amdgcn_fmed3f(s8[h][r], 0.f, INFINITY); } \
        if (do_store) *(u32x2*)(scores + (size_t)t * SEQ + 16 * kk_ + 4 * kq) = (u32x2){pkh(acc_[0], acc_[1]), pkh(acc_[2], acc_[3])}; else asm volatile("" :: "v"(acc_[0]), "v"(acc_[1]), "v"(acc_[2]), "v"(acc_[3])); } } } while (0)
    const int ng2 = (((kt_end - 16 * c) >> 2) + 2) & ~1, rot = rot_seed % ng2;
#define IDX_KT(gi) (16 * c + 4 * ((gi) + rot >= ng2 ? (gi) + rot - ng2 : (gi) + rot))
    IDX_STAGE(0, IDX_KT(0));
#pragma unroll 1
    for (int gi = 0; gi < ng2; gi += 2) {
        const int kta = IDX_KT(gi), ktb = IDX_KT(gi + 1), ktc = IDX_KT(gi + 2 < ng2 ? gi + 2 : gi);
        asm volatile("s_waitcnt lgkmcnt(0)" ::: "memory"); IDX_STAGE(1, ktb);
        asm volatile("s_waitcnt vmcnt(8)" ::: "memory"); IDX_COMP(0, kta);
        asm volatile("s_waitcnt lgkmcnt(0)" ::: "memory"); IDX_STAGE(0, ktc);
        asm volatile("s_waitcnt vmcnt(8)" ::: "memory"); IDX_COMP(1, ktb);
    }
    asm volatile("s_waitcnt vmcnt(0)" ::: "memory");
#undef IDX_KT
#undef IDX_STAGE
#undef IDX_COMP
}

__device__ __forceinline__ unsigned okey(float x) { unsigned u = __float_as_uint(x); if ((u << 1) == 0u) u = 0u; return (u & 0x80000000u) ? ~u : (u | 0x80000000u); }
template <int NB>
__device__ __forceinline__ int select_bin(CW_LAS unsigned* hist, int& k, int lane) {
    constexpr int PER = NB / 64;
    unsigned tot = 0;
#pragma unroll
    for (int i = 0; i < PER; i += 4) { const u32x4 hv = *(CW_LAS u32x4*)(hist + lane * PER + i); tot += (hv.x + hv.y) + (hv.z + hv.w); }
    unsigned incl = tot;
#pragma unroll
    for (int off = 1; off < 64; off <<= 1) { const unsigned tt = __shfl_down(incl, off); if (lane + off < 64) incl += tt; }
    const unsigned excl = incl - tot;
    const bool mine = (excl < (unsigned)k) && ((unsigned)k <= incl);
    int b = 0, kk = 0;
    if (mine) {
        unsigned cacc = excl;
        for (int i = PER - 1; i >= 0; --i) { const unsigned hc = hist[lane * PER + i]; if (cacc + hc >= (unsigned)k) { b = lane * PER + i; kk = k - (int)cacc; break; } cacc += hc; }
    }
    const unsigned long long mk = __ballot(mine);
    const int src = mk ? __builtin_ctzll(mk) : 0;
    b = __shfl(b, src); kk = __shfl(kk, src);
    k = kk;
    return b;
}
__device__ __forceinline__ unsigned okey16(unsigned h) { if ((h & 0x7fffu) == 0u) h = 0u; return (h & 0x8000u) ? (~h & 0xffffu) : (h | 0x8000u); }
__device__ __forceinline__ void dsa_select(const u16* scores, u16* sel, int t, CW_LAS unsigned char* ws_lds, int lane_in) {
    int lane = lane_in; asm volatile("" : "+v"(lane));
    CW_LAS unsigned* hist = (CW_LAS unsigned*)ws_lds;
    CW_LAS int* idxl = (CW_LAS int*)(ws_lds + 8192);
    const u16* srow = scores + (size_t)t * SEQ;
    const int n = t + 1;
    if (n <= 256) {
        for (int i = lane; i < 256; i += 64) idxl[i] = (i < n) ? i : 0;
    } else {
        int k = 256; unsigned b1s = 0, b2s = 0;
        const int nq = (n + 511) >> 9;
#define DSA_ELT(vvj, x) (((x) & 1) ? ((vvj)[(x) >> 1] >> 16) : ((vvj)[(x) >> 1] & 0xffffu))
#define DSA_PASS(COND, BIN) do { for (int j0 = 0; j0 < nq; j0 += 8) { u32x4 vv[8]; \
            _Pragma("unroll") for (int jj = 0; jj < 8; ++jj) { const int j = (j0 + jj < nq) ? j0 + jj : nq - 1; vv[jj] = *(const u32x4*)(srow + 512 * j + 8 * lane); } \
            _Pragma("unroll") for (int jj = 0; jj < 8; ++jj) { _Pragma("unroll") for (int x = 0; x < 8; ++x) { const int i = 512 * (j0 + jj) + 8 * lane + x; const unsigned u = okey16(DSA_ELT(vv[jj], x)); \
                const bool c_ = (j0 + jj < nq) && (i < n) && (COND);   \
                if (c_) __hip_atomic_fetch_add(hist + (BIN), 1u, __ATOMIC_RELAXED, __HIP_MEMORY_SCOPE_WAVEFRONT); } } } } while (0)
        for (int rp_ = 0; rp_ < ((DUPSUB & 16) ? 2 : 1); ++rp_) { k = 256;
        for (int i = lane; i < 256; i += 64) hist[i] = 0u;
        asm volatile("s_waitcnt lgkmcnt(0)" ::: "memory");
        DSA_PASS(true, u >> 8);
        asm volatile("s_waitcnt lgkmcnt(0)" ::: "memory");
        const unsigned b1 = (unsigned)select_bin<256>(hist, k, lane);
        asm volatile("s_waitcnt lgkmcnt(0)" ::: "memory");
        for (int i = lane; i < 256; i += 64) hist[i] = 0u;
        asm volatile("s_waitcnt lgkmcnt(0)" ::: "memory");
        DSA_PASS((u >> 8) == b1, u & 255u);
        asm volatile("s_waitcnt lgkmcnt(0)" ::: "memory");
        const unsigned b2 = (unsigned)select_bin<256>(hist, k, lane);
        asm volatile("s_waitcnt lgkmcnt(0)" ::: "memory");
        b1s = b1; b2s = b2; }
#undef DSA_PASS
        const unsigned T = (b1s << 8) | b2s; const int need_eq = k, cnt_gt = 256 - k;
        int cg = 0, ce = 0;
        const unsigned long long lt_mask = (1ull << lane) - 1ull;
        for (int j0 = 0; j0 < nq; j0 += 4) {
            u32x4 vv[4];
#pragma unroll
            for (int jj = 0; jj < 4; ++jj) { const int j = (j0 + jj < nq) ? j0 + jj : nq - 1; vv[jj] = *(const u32x4*)(srow + 512 * j + 8 * lane); }
#pragma unroll
            for (int jj = 0; jj < 4; ++jj) {
                if (j0 + jj < nq) {
                    bool g[8], e[8]; int pg = 0, pe = 0, tg = 0, te = 0;
#pragma unroll
                    for (int x = 0; x < 8; ++x) { const int i = 512 * (j0 + jj) + 8 * lane + x; const bool v = i < n; const unsigned u = okey16(DSA_ELT(vv[jj], x)); g[x] = v && (u > T); e[x] = v && (u == T);
                        const unsigned long long mg = __ballot(g[x]), me = __ballot(e[x]);
                        pg += __builtin_popcountll(mg & lt_mask); pe += __builtin_popcountll(me & lt_mask); tg += __builtin_popcountll(mg); te += __builtin_popcountll(me); }
                    int og = cg + pg, oe = ce + pe;
#pragma unroll
                    for (int x = 0; x < 8; ++x) { const int i = 512 * (j0 + jj) + 8 * lane + x;
                        const bool wg = g[x] && (og < cnt_gt), we = e[x] && (oe < need_eq);
                        if (wg || we) idxl[wg ? og : cnt_gt + oe] = i;
                        og += g[x] ? 1 : 0; oe += e[x] ? 1 : 0; }
                    cg += tg; ce += te;
                }
            }
        }
#undef DSA_ELT
    }
    asm volatile("s_waitcnt lgkmcnt(0)" ::: "memory");
    { const int a0 = idxl[4 * lane], a1 = idxl[4 * lane + 1], a2 = idxl[4 * lane + 2], a3 = idxl[4 * lane + 3];
      *(u32x2*)(sel + (size_t)t * 256 + 4 * lane) = (u32x2){(unsigned)a0 | ((unsigned)a1 << 16), (unsigned)a2 | ((unsigned)a3 << 16)}; }
    asm volatile("s_waitcnt lgkmcnt(0)" ::: "memory");
}
__device__ __forceinline__ void dsa_attend(const u16* proj, const u16* sel, u16* mixed, int t, CW_LAS unsigned char* bst, CW_LAS u16* idx16, int lane_in) {
    int lane = lane_in; asm volatile("" : "+v"(lane));
    const int nsel = (t + 1 < 256) ? t + 1 : 256, ntiles = (nsel + 31) >> 5;
    asm volatile("s_waitcnt lgkmcnt(0)" ::: "memory");
    *(CW_LAS u32x2*)(idx16 + 4 * lane) = *(const u32x2*)(sel + (size_t)t * 256 + 4 * lane);
    const int r32 = lane & 31, hi = lane >> 5;
    const u16* qrow = proj + (size_t)t * PITCH + DQ + (r32 & 7) * 64 + 8 * hi;
    bf16x8 qf[4];
#pragma unroll
    for (int d0 = 0; d0 < 4; ++d0) qf[d0] = ld8(qrow + 16 * d0);
    asm volatile("s_waitcnt lgkmcnt(0)" ::: "memory");
    BState st; bstate_init(st);
    band_accum<true>(st, qf, proj + DK, proj + DV, 0, 1, 0, 0, ntiles, nsel, lane, bst, idx16);
    if (r32 < 8) bstate_store(st, KD / st.l, mixed + (size_t)t * DMODEL + 1536 + r32 * 64, hi);
}

__device__ __forceinline__ void diff_combine_row(const u16* OB, u16* mixed, const float* sub_g, float lam, float lam_init, int t, int lane) {
    const u16* orow = OB + (size_t)t * 1024;
#pragma unroll
    for (int h = 0; h < 4; ++h) {
        const float a0 = bf2f(orow[(h * 4 + 0) * 64 + lane]), a1 = bf2f(orow[(h * 4 + 1) * 64 + lane]);
        const float b0 = bf2f(orow[(h * 4 + 2) * 64 + lane]), b1 = bf2f(orow[(h * 4 + 3) * 64 + lane]);
        const float d0 = a0 - lam * b0, d1 = a1 - lam * b1;
        const float ms = wave_sum(d0 * d0 + d1 * d1) * (1.0f / 128.0f);
        const float rs = KB * (1.0f / sqrtf(ms + 1e-5f)) * (1.0f - lam_init);
        u16* mrow = mixed + (size_t)t * DMODEL + 512 + h * 128;
        mrow[lane] = (u16)f2bf(d0 * rs * sub_g[lane]); mrow[64 + lane] = (u16)f2bf(d1 * rs * sub_g[64 + lane]);
    }
}

typedef float f32x2 __attribute__((ext_vector_type(2)));
typedef int i32x8 __attribute__((ext_vector_type(8)));
constexpr float X8_SCALE = 8.0f; constexpr size_t XLO_OFF = (size_t)16 << 20;
template <bool INB = false>
__device__ __forceinline__ void ln_row(const void* in_, float alpha, const u16* zs, int t, float* outf, u16* outb, unsigned char* xs8, const float* g, const float* b, int lane) {
    f32x4 v[8]; float s = 0.f;
#pragma unroll
    for (int j = 0; j < 8; ++j) {
        if constexpr (INB) { const u32x2 iw = *(const u32x2*)((const u16*)in_ + 256 * j + 4 * lane); v[j] = (f32x4){bf2f(iw.x & 0xffffu), bf2f(iw.x >> 16), bf2f(iw.y & 0xffffu), bf2f(iw.y >> 16)} * alpha; }
        else v[j] = *(const f32x4*)((const float*)in_ + 256 * j + 4 * lane) * alpha;
        if (zs) { const u32x2 zw = *(const u32x2*)(zs + ((size_t)(2 * j + (lane >> 5)) * SEQ + t) * 128 + ((4 * lane) & 127)); v[j] = v[j] + (f32x4){bf2f(zw.x & 0xffffu), bf2f(zw.x >> 16), bf2f(zw.y & 0xffffu), bf2f(zw.y >> 16)}; }
        s += (v[j].x + v[j].y) + (v[j].z + v[j].w); }
    const float mean = wave_sum(s) * (1.0f / 2048.0f); float s2 = 0.f;
#pragma unroll
    for (int j = 0; j < 8; ++j) { v[j] = v[j] - mean; s2 += (v[j].x * v[j].x + v[j].y * v[j].y) + (v[j].z * v[j].z + v[j].w * v[j].w); }
    const float rstd = 1.0f / sqrtf(wave_sum(s2) * (1.0f / 2048.0f) + 1e-5f);
#pragma unroll
    for (int j = 0; j < 8; ++j) {
        const f32x4 gg = *(const f32x4*)(g + 256 * j + 4 * lane), bb = *(const f32x4*)(b + 256 * j + 4 * lane);
        const f32x4 y = v[j] * rstd * gg + bb;
        if (outf) *(f32x4*)(outf + 256 * j + 4 * lane) = y;
        if (outb) { u32x2 w; w.x = pk2(y.x, y.y); w.y = pk2(y.z, y.w); *(u32x2*)(outb + 256 * j + 4 * lane) = w;
            if (xs8) {
                const f32x4 ys = {__builtin_amdgcn_fmed3f(y.x * X8_SCALE, -448.f, 448.f), __builtin_amdgcn_fmed3f(y.y * X8_SCALE, -448.f, 448.f), __builtin_amdgcn_fmed3f(y.z * X8_SCALE, -448.f, 448.f), __builtin_amdgcn_fmed3f(y.w * X8_SCALE, -448.f, 448.f)};
                int hw = __builtin_amdgcn_cvt_pk_fp8_f32(ys.x, ys.y, 0, false); hw = __builtin_amdgcn_cvt_pk_fp8_f32(ys.z, ys.w, hw, true);
                const f32x2 h0 = __builtin_amdgcn_cvt_pk_f32_fp8(hw, false), h1 = __builtin_amdgcn_cvt_pk_f32_fp8(hw, true);
                int lw = __builtin_amdgcn_cvt_pk_fp8_f32((ys.x - h0.x) * 16.f, (ys.y - h0.y) * 16.f, 0, false); lw = __builtin_amdgcn_cvt_pk_fp8_f32((ys.z - h1.x) * 16.f, (ys.w - h1.y) * 16.f, lw, true);
                unsigned char* xo = xs8 + ((size_t)(2 * j + (lane >> 5)) * SEQ + t) * 128 + ((4 * lane) & 127);
                *(int*)xo = hw; *(int*)(xo + XLO_OFF) = lw; } }
    }
}

__device__ __forceinline__ void ins16(unsigned (&a)[16], unsigned e) {
#pragma unroll
    for (int i = 0; i < 16; ++i) { const unsigned hi_ = a[i] > e ? a[i] : e; e = a[i] > e ? e : a[i]; a[i] = hi_; }
}
__device__ __forceinline__ float key2val(unsigned k) { const unsigned u = (k & 0x80000000u) ? (k ^ 0x80000000u) : ~k; return __uint_as_float(u & ~127u); }
__device__ __forceinline__ void peer_topk_item(const u16* qp, const u16* keysb, u16* eidx, u16* eidxT, float* gate, int tt, int h, CW_LAS unsigned* cand, int lane) {
    const int r32 = lane & 31, hi = lane >> 5, t = 32 * tt + r32;
    unsigned top[2][16];
#pragma unroll
    for (int p = 0; p < 2; ++p) {
        const int hp = h * 2 + p;
        const u16* qrow = qp + (size_t)t * DMODEL + hp * 128 + 8 * hi;
        bf16x8 qb[8];
#pragma unroll
        for (int s = 0; s < 8; ++s) qb[s] = ld8(qrow + 16 * s);
#pragma unroll
        for (int i = 0; i < 16; ++i) top[p][i] = 0u;
#pragma unroll
        for (int nt = 0; nt < 4; ++nt) {
            const u16* krow = keysb + ((size_t)hp * 128 + 32 * nt + r32) * 128 + 8 * hi;
            f32x16 s16 = {0.f, 0.f, 0.f, 0.f, 0.f, 0.f, 0.f, 0.f, 0.f, 0.f, 0.f, 0.f, 0.f, 0.f, 0.f, 0.f};
#pragma unroll
            for (int s = 0; s < 8; ++s) s16 = __builtin_amdgcn_mfma_f32_32x32x16_bf16(ld8(krow + 16 * s), qb[s], s16, 0, 0, 0);
#pragma unroll
            for (int r = 0; r < 16; ++r) { const unsigned n = (unsigned)(32 * nt + crow(r, hi)); const unsigned u = __float_as_uint(s16[r]); const unsigned k = (u & 0x80000000u) ? ~u : (u | 0x80000000u); ins16(top[p], (k & ~127u) | n); }
        }
        unsigned oth[16];
#pragma unroll
        for (int i = 0; i < 16; ++i) oth[i] = __shfl_xor(top[p][i], 32);
#pragma unroll
        for (int i = 0; i < 16; ++i) ins16(top[p], oth[i]);
    }
    float v1[16], v2[16];
#pragma unroll
    for (int i = 0; i < 16; ++i) { v1[i] = key2val(top[0][i]); v2[i] = key2val(top[1][i]); }
    unsigned best[16];
#pragma unroll
    for (int i = 0; i < 16; ++i) best[i] = 0u;
    {
        int cnum = 0;
#pragma unroll
        for (int a = 0; a < 16; ++a)
#pragma unroll
            for (int b = 0; b < 16; ++b) {
                if ((a + 1) * (b + 1) > 16) continue;
                const float ev = v1[a] + v2[b]; const unsigned u = __float_as_uint(ev); const unsigned k = (u & 0x80000000u) ? ~u : (u | 0x80000000u);
                cand[cnum * 64 + lane] = ((top[0][a] & 127u) << 7) | (top[1][b] & 127u);
                ins16(best, (k & ~63u) | (unsigned)cnum);
                ++cnum;
            }
    }
    asm volatile("s_waitcnt lgkmcnt(0)" ::: "memory");
    float cv[16]; unsigned ci[16];
#pragma unroll
    for (int i = 0; i < 16; ++i) { const unsigned k = best[i]; const unsigned u = (k & 0x80000000u) ? (k ^ 0x80000000u) : ~k; cv[i] = __uint_as_float(u & ~63u); ci[i] = cand[(k & 63u) * 64 + lane]; }
    float den = 0.f; const float cmax = cv[0];
#pragma unroll
    for (int i = 0; i < 16; ++i) { cv[i] = ex2((cv[i] - cmax) * LOG2E); den += cv[i]; }
    const float inv = 1.0f / den;
    if (hi == 0) {
        u16* ep = eidx + (size_t)t * 128 + h * 16; float* gp = gate + (size_t)t * 128 + h * 16;
        *(u32x4*)(ep) = (u32x4){ci[0] | (ci[1] << 16), ci[2] | (ci[3] << 16), ci[4] | (ci[5] << 16), ci[6] | (ci[7] << 16)};
        *(u32x4*)(ep + 8) = (u32x4){ci[8] | (ci[9] << 16), ci[10] | (ci[11] << 16), ci[12] | (ci[13] << 16), ci[14] | (ci[15] << 16)};
        { u16* et = eidxT + (size_t)t * 128 + h;
#pragma unroll
          for (int i = 0; i < 16; ++i) et[8 * i] = (u16)ci[i]; }
#pragma unroll
        for (int i = 0; i < 16; i += 4) *(f32x4*)(gp + i) = (f32x4){cv[i] * inv, cv[i + 1] * inv, cv[i + 2] * inv, cv[i + 3] * inv};
    }
    asm volatile("s_waitcnt lgkmcnt(0)" ::: "memory");
}

__device__ __forceinline__ float fdot2(unsigned a, unsigned b, float c) { return __builtin_amdgcn_fdot2_f32_bf16(__builtin_bit_cast(bf16x2_t, a), __builtin_bit_cast(bf16x2_t, b), c, false); }

constexpr float U_SCALE = 512.0f, V_SCALE = 64.0f;
template <int CTRL> __device__ __forceinline__ float dpp_f(float x) { return __builtin_bit_cast(float, __builtin_amdgcn_mov_dpp(__builtin_bit_cast(int, x), CTRL, 0xf, 0xf, true)); }
#define PEER_LOADE(ev, tt) do { const u32x4 w0_ = *(const u32x4*)(eidx + (size_t)(tt) * 128 + 16 * p), w1_ = *(const u32x4*)(eidx + (size_t)(tt) * 128 + 16 * p + 8); \
        ev[0] = w0_.x; ev[1] = w0_.y; ev[2] = w0_.z; ev[3] = w0_.w; ev[4] = w1_.x; ev[5] = w1_.y; ev[6] = w1_.z; ev[7] = w1_.w; } while (0)
#define PEER_EID(ev, g) (((g) & 1) ? (ev[(g) >> 1] >> 16) : (ev[(g) >> 1] & 0xffffu))
#define PEER_ROWS8(rv, ev, col, H) do { _Pragma("unroll") for (int g_ = 0; g_ < 8; ++g_) rv[g_] = *(const u32x4*)((const char*)(col) + (PEER_EID(ev, 8 * (H) + g_) * 128u + loff)); } while (0)
#define FP8_LO(w) __builtin_amdgcn_cvt_pk_f32_fp8((int)(w), false)
#define FP8_HI(w) __builtin_amdgcn_cvt_pk_f32_fp8((int)(w), true)
__device__ __forceinline__ void peer_dot_slice(const unsigned char* xs8, const unsigned char* ub8, const u16* eidxT, u16* ph, int t0, int tstep, int s, int lane) {
    const int j = lane & 15, kg = lane >> 4, rho = 4 * kg + (j >> 2), pi = j & 3;
    const unsigned char* ucol = ub8 + (size_t)s * (16384 * 128); const unsigned loff = 16u * (unsigned)pi;
    const __amdgpu_buffer_rsrc_t xr = __builtin_amdgcn_make_buffer_rsrc((void*)(xs8 + (size_t)s * SEQ * 128), (short)0, 0x2000000, 0x00020000);
    const unsigned xoff = (kg == (j >> 2)) ? 16u * (unsigned)pi : 0x7fff0000u;
    u16* ocol = ph + (size_t)s * SEQ * 128 + 16 * pi + rho;
    const int n = (SEQ - t0 + tstep - 1) / tstep;
    const int SC_ONE = 0x7f7f7f7f, SC_16TH = 0x7b7b7b7b;
    const bool p1 = (pi & 1) != 0, p2 = (pi & 2) != 0;
#define TOK(k) (t0 + ((k) < n ? (k) : n - 1) * tstep)
    u32x4 e0, e1, e2, e3; i32x8 r0[4], r1[4], r2[4], r3[4], xhA, xlA, xhB, xlB;
#define PD_LOADE(ev, tt) ev = *(const u32x4*)(eidxT + (size_t)(tt) * 128 + 8 * rho)
#define PD_EID(ev, p_) (((p_) & 1) ? (ev[(p_) >> 1] >> 16) : (ev[(p_) >> 1] & 0xffffu))
#define PD_ROWS4(rv, ev, H) do { _Pragma("unroll") for (int q_ = 0; q_ < 4; ++q_) { const unsigned o_ = PD_EID(ev, 4 * (H) + q_) * 128u + loff; \
            const u32x4 a_ = *(const u32x4*)(ucol + o_), b_ = *(const u32x4*)(ucol + o_ + 64); rv[q_] = (i32x8){(int)a_.x, (int)a_.y, (int)a_.z, (int)a_.w, (int)b_.x, (int)b_.y, (int)b_.z, (int)b_.w}; } } while (0)
#define PD_LOADX(xh, xl, tt) do { const unsigned o_ = xoff + 128u * (unsigned)(tt); \
            const u32x4 a_ = __builtin_amdgcn_raw_buffer_load_b128(xr, o_, 0, 0), b_ = __builtin_amdgcn_raw_buffer_load_b128(xr, o_ + 64u, 0, 0), \
                        c_ = __builtin_amdgcn_raw_buffer_load_b128(xr, o_, (int)XLO_OFF, 0), d_ = __builtin_amdgcn_raw_buffer_load_b128(xr, o_ + 64u, (int)XLO_OFF, 0); \
            xh = (i32x8){(int)a_.x, (int)a_.y, (int)a_.z, (int)a_.w, (int)b_.x, (int)b_.y, (int)b_.z, (int)b_.w}; xl = (i32x8){(int)c_.x, (int)c_.y, (int)c_.z, (int)c_.w, (int)d_.x, (int)d_.y, (int)d_.z, (int)d_.w}; } while (0)
#define PD_COMP4(rv, xh, xl, kk) do { f32x4 a_[4]; float u_[4]; \
            _Pragma("unroll") for (int q_ = 0; q_ < 4; ++q_) a_[q_] = __builtin_amdgcn_mfma_scale_f32_16x16x128_f8f6f4(xh, rv[q_], (f32x4){0.f, 0.f, 0.f, 0.f}, 0, 0, 0, SC_ONE, 0, SC_ONE); \
            _Pragma("unroll") for (int q_ = 0; q_ < 4; ++q_) a_[q_] = __builtin_amdgcn_mfma_scale_f32_16x16x128_f8f6f4(xl, rv[q_], a_[q_], 0, 0, 0, SC_16TH, 0, SC_ONE); \
            _Pragma("unroll") for (int q_ = 0; q_ < 4; ++q_) { const float lo_ = p1 ? a_[q_][1] : a_[q_][0], hi_ = p1 ? a_[q_][3] : a_[q_][2]; float v_ = p2 ? hi_ : lo_; v_ += dpp_f<0xB1>(v_); v_ += dpp_f<0x4E>(v_); u_[q_] = v_; } \
            { const float lo_ = p1 ? u_[1] : u_[0], hi_ = p1 ? u_[3] : u_[2]; kk = p2 ? hi_ : lo_; } } while (0)
#define PD_ITEM(rA, rB, eS, eN, xh, xl, k) do { const int tt_ = TOK(k); float k0_, k1_; \
        PD_COMP4(rA, xh, xl, k0_); __builtin_amdgcn_sched_barrier(0); PD_ROWS4(rA, eN, 0); __builtin_amdgcn_sched_barrier(0); \
        PD_COMP4(rB, xh, xl, k1_); __builtin_amdgcn_sched_barrier(0); PD_ROWS4(rB, eN, 1); __builtin_amdgcn_sched_barrier(0); \
        PD_LOADX(xh, xl, TOK((k) + 2)); \
        u16* o_ = ocol + (size_t)tt_ * 128; o_[0] = (u16)f2bf(k0_ * (1.0f / (U_SCALE * X8_SCALE))); o_[64] = (u16)f2bf(k1_ * (1.0f / (U_SCALE * X8_SCALE))); \
        PD_LOADE(eS, TOK((k) + 4)); __builtin_amdgcn_sched_barrier(0); } while (0)
    PD_LOADE(e0, TOK(0)); PD_LOADE(e1, TOK(1)); PD_LOADE(e2, TOK(2)); PD_LOADE(e3, TOK(3)); PD_LOADX(xhA, xlA, TOK(0)); PD_LOADX(xhB, xlB, TOK(1)); __builtin_amdgcn_sched_barrier(0);
    PD_ROWS4(r0, e0, 0); __builtin_amdgcn_sched_barrier(0); PD_ROWS4(r1, e0, 1); __builtin_amdgcn_sched_barrier(0); PD_ROWS4(r2, e1, 0); __builtin_amdgcn_sched_barrier(0); PD_ROWS4(r3, e1, 1); __builtin_amdgcn_sched_barrier(0);
#pragma unroll 1
    for (int i = 0; i < n; i += 4) {
        PD_ITEM(r0, r1, e0, e2, xhA, xlA, i);
        PD_ITEM(r2, r3, e1, e3, xhB, xlB, i + 1);
        PD_ITEM(r0, r1, e2, e0, xhA, xlA, i + 2);
        PD_ITEM(r2, r3, e3, e1, xhB, xlB, i + 3);
    }
#undef PD_ITEM
#undef PD_COMP4
#undef PD_LOADX
#undef PD_ROWS4
#undef PD_EID
#undef PD_LOADE
#undef TOK
}
__device__ __forceinline__ void peer_act_row(const u16* ph, const float* gate, float* aw, int t, int lane) {
    float h0 = 0.f, h1 = 0.f;
#pragma unroll 8
    for (int s = 0; s < 16; ++s) { const u16* r = ph + ((size_t)s * SEQ + t) * 128; h0 += bf2f(r[lane]); h1 += bf2f(r[64 + lane]); }
    const float g0 = gate[(size_t)t * 128 + lane], g1 = gate[(size_t)t * 128 + 64 + lane];
    aw[(size_t)t * 128 + lane] = KP * g0 * 0.5f * h0 * (1.0f + erff(h0 * 0.70710678118654752f));
    aw[(size_t)t * 128 + 64 + lane] = KP * g1 * 0.5f * h1 * (1.0f + erff(h1 * 0.70710678118654752f));
}
__device__ __forceinline__ void peer_axpy_slice(const unsigned char* vb8, const u16* eidx, const float* aw, u16* zs, int t0, int tstep, int s, int lane) {
    const int p = lane >> 3, sub = lane & 7;
    const unsigned char* vcol = vb8 + (size_t)s * (16384 * 128); const unsigned loff = 16u * (unsigned)sub;
    const __amdgpu_buffer_rsrc_t zr = __builtin_amdgcn_make_buffer_rsrc((void*)(zs + (size_t)s * SEQ * 128), (short)0, SEQ * 128 * 2, 0x00020000);
    const unsigned zoff = 32u * (unsigned)sub + 4u * (unsigned)p;
    const int n = (SEQ - t0 + tstep - 1) / tstep;
#define TOK(k) (t0 + ((k) < n ? (k) : n - 1) * tstep)
    unsigned e0[8], e1[8], e2[8], e3[8]; u32x4 r0[8], r1[8], r2[8], r3[8]; f32x4 avA[4], avB[4];
#define PA_LOADA(av, tt) do { _Pragma("unroll") for (int q_ = 0; q_ < 4; ++q_) av[q_] = *(const f32x4*)(aw + (size_t)(tt) * 128 + 16 * p + 4 * q_); } while (0)
#define PA_COMP8(vv, av, H) do { _Pragma("unroll") for (int g_ = 0; g_ < 8; ++g_) { const float a1_ = av[2 * (H) + (g_ >> 2)][g_ & 3]; const f32x2 a_ = {a1_, a1_}; \
            _Pragma("unroll") for (int w_ = 0; w_ < 4; ++w_) { acc[2 * w_] = __builtin_elementwise_fma(a_, FP8_LO(vv[g_][w_]), acc[2 * w_]); acc[2 * w_ + 1] = __builtin_elementwise_fma(a_, FP8_HI(vv[g_][w_]), acc[2 * w_ + 1]); } \
            if (g_ & 1) asm volatile("" : "+v"(acc[0]), "+v"(acc[1]), "+v"(acc[2]), "+v"(acc[3]), "+v"(acc[4]), "+v"(acc[5]), "+v"(acc[6]), "+v"(acc[7]));   } } while (0)
#define PA_ITEM(rA, rB, eS, eN, avS, k) do { const int tt_ = TOK(k); f32x2 acc[8]; _Pragma("unroll") for (int i_ = 0; i_ < 8; ++i_) acc[i_] = (f32x2){0.f, 0.f}; \
        PA_COMP8(rA, avS, 0); __builtin_amdgcn_sched_barrier(0); PEER_ROWS8(rA, eN, vcol, 0); __builtin_amdgcn_sched_barrier(0); \
        PA_COMP8(rB, avS, 1); __builtin_amdgcn_sched_barrier(0); PEER_ROWS8(rB, eN, vcol, 1); __builtin_amdgcn_sched_barrier(0); \
        PA_LOADA(avS, TOK((k) + 2)); \
          \
          \
        float w_[8], x_[4]; \
        _Pragma("unroll") for (int i_ = 0; i_ < 8; ++i_) { const auto rr_ = __builtin_amdgcn_permlane32_swap(__float_as_uint(acc[i_ >> 1][i_ & 1]), __float_as_uint(acc[(i_ + 8) >> 1][i_ & 1]), false, false); w_[i_] = __uint_as_float(rr_[0]) + __uint_as_float(rr_[1]); } \
        _Pragma("unroll") for (int i_ = 0; i_ < 4; ++i_) { const auto rr_ = __builtin_amdgcn_permlane16_swap(__float_as_uint(w_[i_]), __float_as_uint(w_[i_ + 4]), false, false); x_[i_] = __uint_as_float(rr_[0]) + __uint_as_float(rr_[1]); } \
        _Pragma("unroll") for (int i_ = 0; i_ < 4; ++i_) x_[i_] += dpp_f<0x128>(x_[i_]); \
        { const bool b3_ = (p & 1) != 0; const float lo_ = b3_ ? x_[2] : x_[0], hi_ = b3_ ? x_[3] : x_[1]; \
          __builtin_amdgcn_raw_buffer_store_b32(pk2(lo_ * (1.0f / V_SCALE), hi_ * (1.0f / V_SCALE)), zr, zoff + 256u * (unsigned)tt_, 0, 0); } \
        PEER_LOADE(eS, TOK((k) + 4)); __builtin_amdgcn_sched_barrier(0); } while (0)
    PEER_LOADE(e0, TOK(0)); PEER_LOADE(e1, TOK(1)); PEER_LOADE(e2, TOK(2)); PEER_LOADE(e3, TOK(3)); PA_LOADA(avA, TOK(0)); PA_LOADA(avB, TOK(1)); __builtin_amdgcn_sched_barrier(0);
    PEER_ROWS8(r0, e0, vcol, 0); __builtin_amdgcn_sched_barrier(0); PEER_ROWS8(r1, e0, vcol, 1); __builtin_amdgcn_sched_barrier(0); PEER_ROWS8(r2, e1, vcol, 0); __builtin_amdgcn_sched_barrier(0); PEER_ROWS8(r3, e1, vcol, 1); __builtin_amdgcn_sched_barrier(0);
#pragma unroll 1
    for (int i = 0; i < n; i += 4) {
        PA_ITEM(r0, r1, e0, e2, avA, i);
        PA_ITEM(r2, r3, e1, e3, avB, i + 1);
        PA_ITEM(r0, r1, e2, e0, avA, i + 2);
        PA_ITEM(r2, r3, e3, e1, avB, i + 3);
    }
#undef PA_ITEM
#undef PA_COMP8
#undef PA_LOADA
#undef TOK
}
#undef PEER_LOADE
#undef PEER_EID
#undef PEER_ROWS8
#undef FP8_LO
#undef FP8_HI
}

constexpr int NWAVES = 8;
constexpr int T = 8192, D = 2048, NIN = 5064, NINP = 5120, NEXP = 16384, DEPTH = 2;
constexpr float LN_EPS = 1e-5f;
constexpr float ALPHA = 1.4142135623730951f;
constexpr size_t MiB = 1u << 20;
constexpr size_t WS_CTL = 0, CTL_ZERO_BYTES = 1 * MiB;
constexpr size_t WS_ROPE = 1 * MiB;
constexpr size_t WS_KEYSB = 3 * MiB;
constexpr size_t WS_WINT = 4 * MiB;
constexpr size_t WS_WOUTT = 44 * MiB;
constexpr size_t WS_WQT = 60 * MiB;
constexpr size_t WS_UB = 76 * MiB;
constexpr size_t WS_VB = 204 * MiB;
constexpr size_t WS_XB = 332 * MiB;
constexpr size_t WS_PROJ = 364 * MiB;
constexpr size_t WS_OB = 450 * MiB;
constexpr size_t WS_MIXED = 466 * MiB;
constexpr size_t WS_X2 = 498 * MiB;
constexpr size_t WS_SCORES = 562 * MiB;
constexpr size_t WS_Z = WS_SCORES;
constexpr size_t WS_X1B = WS_SCORES + 64 * MiB;
constexpr size_t WS_QPEER = WS_SCORES + 96 * MiB;
constexpr size_t WS_EIDX = WS_SCORES + 128 * MiB;
constexpr size_t WS_GATE = WS_SCORES + 132 * MiB;
constexpr size_t WS_AACT = WS_SCORES + 136 * MiB;
constexpr size_t WS_XS = WS_SCORES + 140 * MiB;
constexpr size_t WS_ZS = WS_SCORES + 172 * MiB;
constexpr size_t WS_SEL = 818 * MiB;
constexpr size_t WS_END = 822 * MiB;
constexpr int CW_TMO = 0, CW_CODE = 1, CW_BAR = 4096;
constexpr int RING_OFF = 0, RING_BYTES = 131072;
constexpr int LDSCTL_OFF = RING_BYTES, MISC_OFF = LDSCTL_OFF + 320;
constexpr int LDS_BYTES = 147456;
#ifndef DUP
#define DUP -1
#endif
constexpr int NSUB = 12;
constexpr int NPH = 1 + (NSUB + ((DUP >= 0) ? 1 : 0)) * DEPTH;
#ifndef DUP
#define DUP -1
#endif
#ifndef CHECK
#define CHECK 0
#endif
#ifndef EXTRA_BAR
#define EXTRA_BAR 0
#endif
#ifndef DUPSUB
#define DUPSUB 0
#endif
#ifndef SUBM
#define SUBM 15
#endif
#ifndef PHM
#define PHM 511
#endif
#ifndef MK_ONE_LAUNCH
#define MK_ONE_LAUNCH 1
#endif

__device__ __forceinline__ void p0_tables_layer(const float* pu, const float* pv, unsigned char* u8, unsigned char* v8, int L, long gthr, long NGT) {
    constexpr long N4L = (long)NEXP * D / 4; const long base = (long)L * N4L;
    for (long i0 = gthr; i0 < N4L; i0 += 8 * NGT) {
        f32x4 au[8], av[8];
#pragma unroll
        for (int u = 0; u < 8; ++u) { long g = i0 + u * NGT; g = g < N4L ? g : N4L - 1; au[u] = *(const f32x4*)(pu + 4 * (base + g)); av[u] = *(const f32x4*)(pv + 4 * (base + g)); }
#pragma unroll
        for (int u = 0; u < 8; ++u) { const long g = i0 + u * NGT; if (g < N4L) {
            const int dg4 = (int)(g & 511); const int e = (int)(g >> 9);
            const size_t dst = (size_t)L * NEXP * D + ((size_t)(dg4 >> 5) * NEXP + e) * 128 + (dg4 & 31) * 4;
            { const f32x4 a = au[u] * cw::U_SCALE; int w = __builtin_amdgcn_cvt_pk_fp8_f32(a.x, a.y, 0, false); w = __builtin_amdgcn_cvt_pk_fp8_f32(a.z, a.w, w, true); *(GAS unsigned*)(u8 + dst) = (unsigned)w; }
            { const f32x4 a = av[u] * cw::V_SCALE; int w = __builtin_amdgcn_cvt_pk_fp8_f32(a.x, a.y, 0, false); w = __builtin_amdgcn_cvt_pk_fp8_f32(a.z, a.w, w, true); *(GAS unsigned*)(v8 + dst) = (unsigned)w; } } }
    }
}
__device__ __forceinline__ void p0_transpose_item(const float* W, int K, int N, bf16* WT, LAS float* scr, int item, int lane, bool permute) {
    const int nblk = N / 32, kb = item / nblk, nb = item % nblk, k0 = 64 * kb, n0 = 32 * nb;
    { f32x4 v[8];
#pragma unroll
      for (int i = 0; i < 8; ++i) v[i] = *(const f32x4*)(W + (size_t)(k0 + 8 * i + (lane >> 3)) * N + n0 + 4 * (lane & 7));
#pragma unroll
      for (int i = 0; i < 8; ++i) { LAS float* d = scr + (8 * i + (lane >> 3)) * 33 + 4 * (lane & 7); d[0] = v[i].x; d[1] = v[i].y; d[2] = v[i].z; d[3] = v[i].w; } }
    LDS_WAIT(); asm volatile("" ::: "memory");
    const int c = lane & 7;
#pragma unroll
    for (int j = 0; j < 4; ++j) { const int n = (lane >> 3) + 8 * j; const LAS float* s = scr + (8 * c) * 33 + n;
        v4u o; o.x = pk2(s[0 * 33], s[1 * 33]); o.y = pk2(s[2 * 33], s[3 * 33]); o.z = pk2(s[4 * 33], s[5 * 33]); o.w = pk2(s[6 * 33], s[7 * 33]);
        const int ng = n0 + n; int row = ng;
        if (permute && pg8::chunk_is_rope(ng >> 6)) row = (ng & ~63) + 2 * (ng & 31) + ((ng >> 5) & 1);
        *(GAS v4u*)(WT + (size_t)row * K + k0 + 8 * c) = o; }
    LDS_WAIT(); asm volatile("" ::: "memory");
}

struct Args { const float* in[14]; float* out; unsigned char* ws; int ph_lo, ph_hi; };

#define PHASE_LANE() \
    int tid_ = threadIdx.x; asm volatile("" : "+v"(tid_));        \
    const int lane = tid_ & 63, wave = __builtin_amdgcn_readfirstlane(tid_ >> 6); \
    const int gw = vcu * NWAVES + wave; const long gthr = (long)gw * 64 + lane; (void)gthr; (void)gw; (void)lane;
#define PHASE_PTRS() \
    const __attribute__((address_space(4))) Args* ap_ = (const __attribute__((address_space(4))) Args*)__builtin_amdgcn_kernarg_segment_ptr(); asm volatile("" : "+s"(ap_));
#define wsp_ (ap_->ws)
#define x_in (ap_->in[0])
#define w_in (ap_->in[1])
#define attn_sinks (ap_->in[2])
#define diff_lambda (ap_->in[3])
#define diff_norm_g (ap_->in[4])
#define w_out (ap_->in[5])
#define ln1_g (ap_->in[6])
#define ln1_b (ap_->in[7])
#define peer_wq (ap_->in[8])
#define peer_keys (ap_->in[9])
#define peer_u (ap_->in[10])
#define peer_v (ap_->in[11])
#define ln2_g (ap_->in[12])
#define ln2_b (ap_->in[13])
#define cosT ((float*)(wsp_ + WS_ROPE))
#define sinT ((float*)(wsp_ + WS_ROPE) + T * 32)
#define keysb ((bf16*)(wsp_ + WS_KEYSB))
#define winT ((bf16*)(wsp_ + WS_WINT))
#define woutT ((bf16*)(wsp_ + WS_WOUTT))
#define wqT ((bf16*)(wsp_ + WS_WQT))
#define ub8 ((unsigned char*)(wsp_ + WS_UB))
#define vb8 ((unsigned char*)(wsp_ + WS_VB))
#define xb ((bf16*)(wsp_ + WS_XB))
#define proj ((bf16*)(wsp_ + WS_PROJ))
#define ob ((bf16*)(wsp_ + WS_OB))
#define mixed ((bf16*)(wsp_ + WS_MIXED))
#define x2 ((float*)(wsp_ + WS_X2))
#define scores ((bf16*)(wsp_ + WS_SCORES))
#define zbuf ((float*)(wsp_ + WS_Z))
#define x1b ((bf16*)(wsp_ + WS_X1B))
#define qpeer ((bf16*)(wsp_ + WS_QPEER))
#define eidx ((bf16*)(wsp_ + WS_EIDX))
#define gate ((float*)(wsp_ + WS_GATE))
#define aact ((float*)(wsp_ + WS_AACT))
#define xs8 ((unsigned char*)(wsp_ + WS_XS))
#define eidxT ((bf16*)(wsp_ + WS_EIDX + 2 * MiB))
#define zsl ((bf16*)(wsp_ + WS_ZS))
#define pslab ((bf16*)(wsp_ + WS_PROJ))
#define selb ((bf16*)(wsp_ + WS_SEL))

__global__ void __launch_bounds__(NWAVES * 64, 2) mega_fwd(Args args) {
    extern __shared__ __attribute__((aligned(16))) unsigned char lds[];
    LAS unsigned char* ldsl = (LAS unsigned char*)lds;
    volatile LAS unsigned* MISC = (volatile LAS unsigned*)(ldsl + MISC_OFF);
    const int tid = threadIdx.x;
    const int G = gridDim.x, bx = blockIdx.x, vcu = (G % 8 == 0) ? (bx % 8) * (G / 8) + bx / 8 : bx;
    const int NGW = G * NWAVES;
    const long NGT = (long)NGW * 64;
    gu32* ctl = (gu32*)(args.ws + WS_CTL);
    for (int u = tid; u < (LDS_BYTES - LDSCTL_OFF) / 4; u += NWAVES * 64) ((LAS unsigned*)(ldsl + LDSCTL_OFF))[u] = 0u;
    __syncthreads();
    const int lo = args.ph_lo, hi = args.ph_hi;
    XcdBarrier bar; bar.bar = (unsigned*)(ctl + CW_BAR); bar.x = 0; bar.st = nullptr;
    if (hi - lo > 1) bar = xcd_barrier_post((unsigned*)(ctl + CW_BAR), MISC + 8);

#pragma unroll 1
    for (int ph = lo; ph < hi; ++ph) {
        constexpr int PL = NSUB + ((DUP >= 0) ? 1 : 0);
        const int L = (ph - 1) / PL, idx_ = (ph - 1) % PL, sub = (ph == 0) ? -1 : ((DUP >= 0 && idx_ > DUP) ? idx_ - 1 : idx_);
        if (ph > lo && !(sub == 3 && DUP != 2 && DUP != 3)) { xcd_barrier(bar); for (int xb_ = 0; xb_ < EXTRA_BAR; ++xb_) xcd_barrier(bar); }
        if (ph == 0) {
#if (PHM & 1)
        int tidp_ = threadIdx.x; asm volatile("" : "+v"(tidp_));
        const int lane = tidp_ & 63, wave = __builtin_amdgcn_readfirstlane(tidp_ >> 6);
        const int gw = vcu * NWAVES + wave;
        const long gthr = (long)gw * 64 + lane;
        PHASE_PTRS();
            LAS float* scr = (LAS float*)(ldsl + RING_OFF + wave * 16384);
            constexpr int I_IN = (D / 64) * (NIN / 32), I_SQ = (D / 64) * (D / 32), I_LAYER = I_IN + 2 * I_SQ;
            for (int rp_ = 0; rp_ < ((DUPSUB & 32) ? 2 : 1); ++rp_)
            for (int it = gw; it < I_IN; it += NGW) p0_transpose_item(w_in, D, NIN, winT, scr, it, lane, true);
            (void)I_SQ; (void)I_LAYER;
            for (long i = gthr; i < (long)DEPTH * 64 * D; i += NGT) { const int L = (int)(i / (64 * D)), rr = (int)(i % (64 * D)), n = 5056 + rr / D, k = rr % D;
                const float v = (n < NIN) ? w_in[(size_t)L * D * NIN + (size_t)k * NIN + n] : 0.f; winT[(size_t)L * NINP * D + (size_t)n * D + k] = (bf16)f2bf(v); }
            for (long i = gthr; i < (long)DEPTH * 16 * 128 * 128 / 8; i += NGT) { const f32x4 a = *(const f32x4*)(peer_keys + 8 * i), b = *(const f32x4*)(peer_keys + 8 * i + 4);
                v4u o; o.x = pk2(a.x, a.y); o.y = pk2(a.z, a.w); o.z = pk2(b.x, b.y); o.w = pk2(b.z, b.w); *(GAS v4u*)(keysb + 8 * i) = o; }
            { constexpr long N8 = (long)T * D / 8;
              for (long i0 = gthr; i0 < N8; i0 += 4 * NGT) {
                  f32x4 a[4], b[4];
#pragma unroll
                  for (int u = 0; u < 4; ++u) { long g = i0 + u * NGT; g = g < N8 ? g : N8 - 1; a[u] = *(const f32x4*)(x_in + 8 * g); b[u] = *(const f32x4*)(x_in + 8 * g + 4); }
#pragma unroll
                  for (int u = 0; u < 4; ++u) { const long g = i0 + u * NGT; if (g < N8) { v4u o; o.x = pk2(a[u].x, a[u].y); o.y = pk2(a[u].z, a[u].w); o.z = pk2(b[u].x, b[u].y); o.w = pk2(b[u].z, b[u].w); *(GAS v4u*)(xb + 8 * g) = o; } }
              } }
            for (long i = gthr; i < (long)T * 32; i += NGT) { const int t = (int)(i >> 5), f = (int)(i & 31);
                const float inv = powf(10000.0f, -(float)f / 32.0f); const float ang = (float)t * inv; float sv, cv; sincosf(ang, &sv, &cv); cosT[i] = cv; sinT[i] = sv; }
#endif
            continue;
        }
        {
        PHASE_PTRS();
        if (sub == 0) {
#if (PHM & 2)
            PHASE_LANE();
            pg8::Gemm g{xb, winT + (size_t)L * NINP * D, T, NINP, D}; pg8::StaticOrder S; S.init(T, NINP, G, bx);
            pg8::EpiInProj E{proj, cw::PITCH, cosT, sinT};
            pg8::gemm_phase<pg8::EpiInProj, pg8::StaticOrder, true, true>(ldsl + RING_OFF, g, S, E);
            if (L == 0) {
                pg8::Unit u3_; const int nrounds = (S.nwg + G - 1) / G;
                if (nrounds > 1 && !S.next(nrounds - 1, u3_)) {
                    const int nbusy = S.nwg - (nrounds - 1) * G, nidle = G - nbusy;
                    int tid2_ = threadIdx.x; asm volatile("" : "+v"(tid2_));
                    const int lane2 = tid2_ & 63, wave2 = __builtin_amdgcn_readfirstlane(tid2_ >> 6);
                    constexpr int I_IN = (D / 64) * (NIN / 32), I_SQ = (D / 64) * (D / 32), I_LAYER = I_IN + 2 * I_SQ;
                    LAS float* scr = (LAS float*)(ldsl + RING_OFF + wave2 * 16384);
#pragma unroll 1
                    for (int it = I_IN + (bx - nbusy) * NWAVES + wave2; it < DEPTH * I_LAYER; it += nidle * NWAVES) {
                        const int Lw = it / I_LAYER; int r = it % I_LAYER;
                        if (r < I_IN) { p0_transpose_item(w_in + (size_t)Lw * D * NIN, D, NIN, winT + (size_t)Lw * NINP * D, scr, r, lane2, true); continue; } r -= I_IN;
                        if (r < I_SQ) { p0_transpose_item(w_out + (size_t)Lw * D * D, D, D, woutT + (size_t)Lw * D * D, scr, r, lane2, false); continue; } r -= I_SQ;
                        p0_transpose_item(peer_wq + (size_t)Lw * D * D, D, D, wqT + (size_t)Lw * D * D, scr, r, lane2, false);
                    }
                }
            }
#endif
        } else if (sub == 1) {
#if (PHM & 4)
            PHASE_LANE();
#if (SUBM & 1)
#pragma unroll 1
            for (int pi = vcu; pi < 256; pi += G) {
                const int vh = pi >> 4, s = pi & 15, h = vh >> 2, j = (vh >> 1) & 1, c = vh & 1;
                const attn_body::bf16* Qh = (const attn_body::bf16*)(proj + cw::BQ + h * 128 + j * 64);
                const attn_body::bf16* Kh = (const attn_body::bf16*)(proj + cw::BK_ + h * 128 + j * 64);
                const attn_body::bf16* Vh = (const attn_body::bf16*)(proj + cw::BV + h * 128 + c * 64);
                attn_body::bf16* Oh = (attn_body::bf16*)(ob + vh * 64);
#pragma unroll 1
                for (int ui = 0; ui < 2; ++ui) { attn_body::attn_unit<8>(ui == 0 ? 31 - s : s, Qh, Kh, Vh, Oh, (char*)lds + RING_OFF);
                    if (ui == 0 && pi == vcu) p0_tables_layer(peer_u, peer_v, ub8, vb8, L, (long)gw * 64 + lane, NGT); }
            }
#endif
#if (SUBM & 2)
            for (int rp_ = 0; rp_ < ((DUPSUB & 2) ? 2 : 1); ++rp_)
            for (int it = gw; it < 2048; it += NGW) cw::swa_item(proj, mixed, attn_sinks + L * 8, it & 7, it >> 3, lane, (LAS unsigned char*)(ldsl + RING_OFF + wave * 16384));
#endif
#if (SUBM & 4)
            for (int rp_ = 0; rp_ < ((DUPSUB & 4) ? 2 : 1); ++rp_)
            for (int it = gw; it < 2048; it += NGW) { const int rest = it >> 3; cw::dil_item(proj, mixed, it & 7, rest & 15, rest >> 4, lane, (LAS unsigned char*)(ldsl + RING_OFF + wave * 16384)); }
#endif
#if (SUBM & 8)
            for (int rp_ = 0; rp_ < ((DUPSUB & 8) ? 2 : 1); ++rp_)
            for (int it = gw; it < 8448; it += NGW) { int c = 0; while (c < 31 && it >= 512 * (c + 1) - 8 * (c + 1) * c) ++c; cw::idx_item(proj, scores, 16 * c + (it - (512 * c - 8 * c * (c - 1))), c, (gw * 5 + (gw >> 3)) & 1023, lane, (LAS unsigned char*)(ldsl + RING_OFF + wave * 16384), !((DUPSUB & 256) && rp_ == 1)); }
#endif
#endif
        } else if (sub == 2) {
#if (PHM & 8)
            PHASE_LANE();
            LAS unsigned char* wsl = ldsl + RING_OFF + wave * 16384;
#pragma unroll 1
            for (int i4 = 4 * gw; i4 < 8192; i4 += 4 * NGW) {
#pragma unroll 1
                for (int k = 0; k < 4; ++k) { const int i = i4 >> 2; const int t = (k == 0) ? 8191 - i : (k == 1) ? 4096 + i : (k == 2) ? 4095 - i : i; cw::dsa_select(scores, selb, t, wsl, lane); }
            }
            asm volatile("s_waitcnt vmcnt(0)" ::: "memory");
            const float* lp = diff_lambda + L * 256;
            const float lam_init = 0.8f - 0.6f * expf(-0.3f * (float)L);
            const float lam = expf(cw::wave_sum(lp[lane] * lp[64 + lane])) - expf(cw::wave_sum(lp[128 + lane] * lp[192 + lane])) + lam_init;
            for (int t = gw; t < T; t += NGW) cw::diff_combine_row(ob, mixed, diff_norm_g + L * 128, lam, lam_init, t, lane);
#endif
        } else if (sub == 3) {
#if (PHM & 8)
            PHASE_LANE();
            LAS unsigned char* wsl = ldsl + RING_OFF + wave * 16384; LAS bf16* idx16 = (LAS bf16*)(ldsl + MISC_OFF + 1024 + wave * 512);
#pragma unroll 1
            for (int i4 = 4 * gw; i4 < 8192; i4 += 4 * NGW) {
#pragma unroll 1
                for (int k = 0; k < 4; ++k) { const int i = i4 >> 2; const int t = (k == 0) ? 8191 - i : (k == 1) ? 4096 + i : (k == 2) ? 4095 - i : i; cw::dsa_attend(proj, selb, mixed, t, wsl, idx16, lane); }
            }
#endif
        } else if (sub == 4) {
#if (PHM & 16)
            PHASE_LANE();
            pg8::Gemm g{mixed, woutT + (size_t)L * D * D, T, D, D}; pg8::StaticOrder S; S.init(T, D, G, bx);
            pg8::EpiResid E{(bf16*)zbuf, (L == 0) ? x_in : (const float*)x2, D, ALPHA};
            pg8::gemm_phase<pg8::EpiResid, pg8::StaticOrder, true, true>(ldsl + RING_OFF, g, S, E);
#endif
        } else if (sub == 5) {
#if (PHM & 32)
            PHASE_LANE();
            for (int t = gw; t < T; t += NGW) cw::ln_row<true>((const bf16*)zbuf + (size_t)t * D, 1.0f, (const bf16*)nullptr, t, (float*)nullptr, x1b + (size_t)t * D, xs8, ln1_g + L * D, ln1_b + L * D, lane);
#endif
        } else if (sub == 6) {
#if (PHM & 64)
            PHASE_LANE();
            pg8::Gemm g{x1b, wqT + (size_t)L * D * D, T, D, D}; pg8::StaticOrder S; S.init(T, D, G, bx);
            pg8::EpiBf16<0> E{qpeer, D, nullptr, 0, 0, 1.f};
            pg8::gemm_phase<pg8::EpiBf16<0>, pg8::StaticOrder, true, true>(ldsl + RING_OFF, g, S, E);
#endif
        } else if (sub == 7) {
#if (PHM & 128)
            PHASE_LANE();
            LAS unsigned* cand = (LAS unsigned*)(ldsl + RING_OFF + wave * 12800);
#pragma unroll 1
            for (int it = gw; it < 2048; it += NGW) cw::peer_topk_item(qpeer, keysb + (size_t)L * 16 * 128 * 128, eidx, eidxT, gate, it >> 3, it & 7, cand, lane);
#endif
        } else if (sub == 8) {
#if (PHM & 256)
            PHASE_LANE();
            { const int xg = bx & 7, wig = (bx >> 3) * NWAVES + wave, wpg = (G >> 3) * NWAVES; const unsigned char* ubL = ub8 + (size_t)L * NEXP * D;
#pragma unroll 1
              for (int m = 0; m < 2; ++m) { const int s = xg + 8 * m;
#ifndef NO_DOT
                cw::peer_dot_slice(xs8, ubL, eidxT, pslab, wig, wpg, s, lane);
#endif
              } }
#endif
        } else if (sub == 9) {
#if (PHM & 256)
            PHASE_LANE();
            for (int t = gw; t < T; t += NGW) cw::peer_act_row(pslab, gate, aact, t, lane);
#endif
        } else if (sub == 10) {
#if (PHM & 256)
            PHASE_LANE();
            { const int xg = bx & 7, wig = (bx >> 3) * NWAVES + wave, wpg = (G >> 3) * NWAVES; const unsigned char* vbL = vb8 + (size_t)L * NEXP * D;
#pragma unroll 1
              for (int m = 0; m < 2; ++m) { const int s = xg + 8 * m;
#ifndef NO_AXPY
                cw::peer_axpy_slice(vbL, eidx, aact, zsl, wig, wpg, s, lane);
#endif
              } }
#endif
        } else {
#if (PHM & 256)
            PHASE_LANE();
            { const bool last = (L == DEPTH - 1); float* zout = last ? ap_->out : x2;
              for (int t = gw; t < T; t += NGW) cw::ln_row<true>(x1b + (size_t)t * D, ALPHA, zsl, t, zout + (size_t)t * D, last ? (bf16*)nullptr : xb + (size_t)t * D, (unsigned char*)nullptr, ln2_g + L * D, ln2_b + L * D, lane); }
#endif
        }
        }
    }
}

#undef wsp_
#undef x_in
#undef w_in
#undef attn_sinks
#undef diff_lambda
#undef diff_norm_g
#undef w_out
#undef ln1_g
#undef ln1_b
#undef peer_wq
#undef peer_keys
#undef peer_u
#undef peer_v
#undef ln2_g
#undef ln2_b
#undef cosT
#undef sinT
#undef keysb
#undef winT
#undef woutT
#undef wqT
#undef ub8
#undef vb8
#undef xb
#undef proj
#undef ob
#undef mixed
#undef x2
#undef scores
#undef zbuf
#undef x1b
#undef qpeer
#undef eidx
#undef gate
#undef aact
#undef xs8
#undef eidxT
#undef zsl
#undef pslab
#undef selb

extern "C" void kernel_launch(void* const* d_in, const int* in_sizes, int n_in, void* d_out, int out_size, void* d_ws, size_t ws_size, hipStream_t stream) {
    static int grid = 0;
    if (grid == 0) {
        if (n_in != 14 || out_size != T * D || ws_size < WS_END) { fprintf(stderr, "kernel_launch: unexpected shapes (n_in %d, out %d, ws %zu < %zu); nothing launched\n", n_in, out_size, ws_size, (size_t)WS_END); grid = -1; return; }
        int dev = 0, cus = 0;
        if (hipGetDevice(&dev) != hipSuccess || hipDeviceGetAttribute(&cus, hipDeviceAttributeMultiprocessorCount, dev) != hipSuccess) { grid = -1; return; }
        if (hipFuncSetAttribute((const void*)mega_fwd, hipFuncAttributeMaxDynamicSharedMemorySize, LDS_BYTES) != hipSuccess) { fprintf(stderr, "kernel_launch: hipFuncSetAttribute failed\n"); grid = -1; return; }
        (void)hipGetLastError();
        grid = cus;
    }
    if (grid < 0) return;
    if (hipMemsetAsync((char*)d_ws + WS_CTL, 0, CTL_ZERO_BYTES, stream) != hipSuccess) { fprintf(stderr, "kernel_launch: memset failed\n"); return; }
    Args a{};
    for (int i = 0; i < 14; ++i) a.in[i] = (const float*)d_in[i];
    a.out = (float*)d_out; a.ws = (unsigned char*)d_ws;
#if CHECK
    a.ph_lo = 0; a.ph_hi = 5;
    hipLaunchKernelGGL(mega_fwd, dim3(grid), dim3(NWAVES * 64), LDS_BYTES, stream, a);
    { unsigned char* w8 = (unsigned char*)d_ws; unsigned* res = (unsigned*)(w8 + WS_CTL + 512 * 1024);
      const cw::u16* projp = (const cw::u16*)(w8 + WS_PROJ); const cw::u16* mixp = (const cw::u16*)(w8 + WS_MIXED); const cw::u16* scp = (const cw::u16*)(w8 + WS_SCORES);
      if ((CHECK & 7) == 1) hipLaunchKernelGGL(chk::check_A, dim3(T * 8 / 4), dim3(256), 0, stream, projp, mixp, (const float*)d_in[2], res);
      if ((CHECK & 7) == 2) hipLaunchKernelGGL(chk::check_C, dim3(T * 8 / 4), dim3(256), 0, stream, projp, mixp, res);
      if ((CHECK & 7) == 3) hipLaunchKernelGGL(chk::check_D, dim3(T / 4), dim3(256), 0, stream, projp, scp, mixp, res);
      if ((CHECK & 7) == 4) hipLaunchKernelGGL(chk::check_S, dim3(T / 4), dim3(256), 0, stream, projp, scp, res);
      hipLaunchKernelGGL(chk::check_emit, dim3((out_size + 255) / 256), dim3(256), 0, stream, (const unsigned*)res, (float*)d_out, out_size, (CHECK >= 16) ? (CHECK >> 4) : ((CHECK & 7) - 1) + ((CHECK & 8) ? 8 : 0)); }
#elif MK_ONE_LAUNCH
    a.ph_lo = 0; a.ph_hi = NPH;
    hipLaunchKernelGGL(mega_fwd, dim3(grid), dim3(NWAVES * 64), LDS_BYTES, stream, a);
#else
    for (int ph = 0; ph < NPH; ++ph) { a.ph_lo = ph; a.ph_hi = ph + 1; hipLaunchKernelGGL(mega_fwd, dim3(grid), dim3(NWAVES * 64), LDS_BYTES, stream, a); }
#endif
}
```

```cpp
#include <hip/hip_runtime.h>
#include <hip/hip_bf16.h>
#include <cstdio>
#include <cstdint>
#include <cmath>
namespace pg8 {
#define PG8_LAS __attribute__((address_space(3)))
typedef unsigned short bf16_t;
typedef short bf16x8 __attribute__((ext_vector_type(8)));
typedef float f32x4 __attribute__((ext_vector_type(4)));
typedef unsigned u32x4 __attribute__((ext_vector_type(4)));
constexpr int BM = 256, BK = 64, HALF = 128, HTB = HALF * BK * 2  , STAGE_BYTES = 8 * HTB, NXCD = 8, WGM = 8;

__host__ __device__ __forceinline__ int lds_byte(int r, int c) { const int st = (r >> 4) * 2 + (c >> 5), rr = r & 15, cc = c & 31, ob = rr * 64 + cc * 2; return st * 1024 + (ob ^ (((ob >> 9) & 1) << 5)); }
__host__ __device__ __forceinline__ void stage_rc(int b, int& R, int& C) { const int st = b / 1024, sb = b % 1024, swz = sb ^ (((sb >> 9) & 1) << 5); R = (st >> 1) * 16 + swz / 64; C = (st & 1) * 32 + (swz % 64) / 2; }
__host__ __device__ __forceinline__ int perm32(int rho) { const int n = rho >> 4, i = rho & 15; return 8 * (i >> 2) + 4 * n + (i & 3); }

struct Unit { int pm, pn; };
struct Gemm { const bf16_t* A; const bf16_t* Bt; int M, N, K; };

struct StaticOrder {
    int nM, nN, nwg, G, c;
    __host__ __device__ void init(int M, int N, int G_, int c_) { nM = M / BM; nN = N / BM; nwg = nM * nN; G = G_; c = c_; }
    __host__ __device__ bool next(int i, Unit& u) const {
        const long L = (long)i * G + c; if (L >= nwg) return false;
        int wgid = (int)L; { const int q = nwg / NXCD, r = nwg % NXCD, xcd = wgid % NXCD, off = wgid / NXCD; wgid = (xcd < r ? xcd * (q + 1) : r * (q + 1) + (xcd - r) * q) + off; }
        const int nig = WGM * nN, gid = wgid / nig, fm = gid * WGM, gsz = (nM - fm) < WGM ? (nM - fm) : WGM;
        u.pm = fm + ((wgid % nig) % gsz); u.pn = (wgid % nig) / gsz; return true;
    }
    __device__ __forceinline__ void a_ready(const Unit&) const {}
    __device__ __forceinline__ void done(const Unit&) const {}
};

__device__ __forceinline__ unsigned cvt_pk_bf16(float lo, float hi) { unsigned r; asm volatile("v_cvt_pk_bf16_f32 %0, %1, %2" : "=v"(r) : "v"(lo), "v"(hi)); return r; }
typedef float f32x2 __attribute__((ext_vector_type(2)));
__device__ __forceinline__ f32x2 gelu_pk(f32x2 v) {
    const f32x2 av = __builtin_elementwise_abs(v), d = av * 0.2316418882f + 1.0f;
    f32x2 t; t.x = __builtin_amdgcn_rcpf(d.x); t.y = __builtin_amdgcn_rcpf(d.y);
    f32x2 q = t * 0.5307027145f + (-0.7265760135f); q = q * t + 0.7107068705f; q = q * t + (-0.142248368f); q = q * t + 0.127414796f; q = q * t;
    const f32x2 s = (v * v) * (-0.72134752044f);
    f32x2 e; e.x = __builtin_amdgcn_exp2f(s.x); e.y = __builtin_amdgcn_exp2f(s.y);
    const f32x2 m = v * (q * e), r = v - m;
    f32x2 o; o.x = v.x < 0.f ? m.x : r.x; o.y = v.y < 0.f ? m.y : r.y; return o;
}

template <int ACT  > struct EpiBf16 {
    static constexpr bool PERM = true, AFTER_DRAIN = false; static_assert(ACT == 0 || ACT == 1, "EpiBf16: ACT is 0 (none) or 1 (gelu_pk)");
    bf16_t* O; int ldc; const float* bias; int split_cols; size_t split_stride; float scale0;
    __device__ __forceinline__ void operator()(const f32x4 (&acc)[2][2][4][2], const Unit& u, int wr, int wc, int fr, int fq) const {
        const int row0 = u.pm * BM + wr * 64 + fr; int colt = u.pn * BM; bf16_t* base = O;
        float sc = 1.f; if (split_cols) { const int t = colt / split_cols; base += (size_t)t * split_stride; colt -= t * split_cols; if (t == 0) sc = scale0; }
        const int col0 = colt + wc * 32 + 8 * fq, bcol0 = u.pn * BM + wc * 32 + 8 * fq;
        f32x4 bv[2][2];
#pragma unroll
        for (int bj = 0; bj < 2; ++bj)
#pragma unroll
            for (int n = 0; n < 2; ++n) bv[bj][n] = bias ? *(const f32x4*)(bias + bcol0 + bj * HALF + 4 * n) : (f32x4){0.f, 0.f, 0.f, 0.f};
#pragma unroll
        for (int ai = 0; ai < 2; ++ai)
#pragma unroll
            for (int m = 0; m < 4; ++m) { bf16_t* rowp = base + (size_t)(row0 + ai * HALF + m * 16) * ldc + col0;
#pragma unroll
                for (int bj = 0; bj < 2; ++bj) { f32x4 v0 = acc[ai][bj][m][0] + bv[bj][0], v1 = acc[ai][bj][m][1] + bv[bj][1];
                    if (ACT == 1) { f32x2 a = gelu_pk((f32x2){v0[0], v0[1]}), b = gelu_pk((f32x2){v0[2], v0[3]}), c = gelu_pk((f32x2){v1[0], v1[1]}), d = gelu_pk((f32x2){v1[2], v1[3]});
                        v0 = (f32x4){a.x, a.y, b.x, b.y}; v1 = (f32x4){c.x, c.y, d.x, d.y}; }
                    v0 = v0 * sc; v1 = v1 * sc; u32x4 w; w.x = cvt_pk_bf16(v0[0], v0[1]); w.y = cvt_pk_bf16(v0[2], v0[3]); w.z = cvt_pk_bf16(v1[0], v1[1]); w.w = cvt_pk_bf16(v1[2], v1[3]);
                    *(u32x4*)(rowp + bj * HALF) = w; } }
    }
};

__device__ __forceinline__ bool chunk_is_rope(int c) { return (c < 10) || (c >= 12 && c < 28) || (c >= 36 && c < 52) || (c >= 60 && c < 69) || (c >= 70 && c < 79); }
__device__ __forceinline__ float chunk_scale(int c) {
    const float C2 = 0.125f * 1.4426950408889634f;
    if (c < 8 || (c >= 12 && c < 20) || (c >= 36 && c < 44) || (c >= 60 && c < 68)) return C2;
    if (c >= 70 && c < 78) return 0.125f;
    return 1.0f;
}
struct EpiInProj {
    static constexpr bool PERM = true, AFTER_DRAIN = false;
    bf16_t* O; int ldc; const float* cosT; const float* sinT;
    __device__ __forceinline__ void operator()(const f32x4 (&acc)[2][2][4][2], const Unit& u, int wr, int wc, int fr, int fq) const {
        const int row0 = u.pm * BM + wr * 64 + fr;
        const int colb = u.pn * BM + wc * 32 + 8 * fq;
        const int chunk0 = __builtin_amdgcn_readfirstlane(colb >> 6), chunk1 = chunk0 + 2;
        const bool rope0 = chunk_is_rope(chunk0), rope1 = chunk_is_rope(chunk1); const float sc0 = chunk_scale(chunk0), sc1 = chunk_scale(chunk1);
        const int i0 = (colb & 63) >> 1;
#pragma unroll
        for (int ai = 0; ai < 2; ++ai)
#pragma unroll
            for (int m = 0; m < 4; ++m) {
                const int row = row0 + ai * HALF + m * 16;
                f32x4 c = {1.f, 1.f, 1.f, 1.f}, s = {0.f, 0.f, 0.f, 0.f};
                if (rope0 || rope1) { c = *(const f32x4*)(cosT + (size_t)row * 32 + i0); s = *(const f32x4*)(sinT + (size_t)row * 32 + i0); }
#pragma unroll
                for (int bj = 0; bj < 2; ++bj) {
                    const bool rope = bj ? rope1 : rope0; const float sc = bj ? sc1 : sc0;
                    f32x4 v0 = acc[ai][bj][m][0], v1 = acc[ai][bj][m][1];
                    if (rope) {
                        f32x4 y0, y1;
                        y0[0] = v0[0] * c[0] - v0[1] * s[0]; y0[1] = v0[0] * s[0] + v0[1] * c[0];
                        y0[2] = v0[2] * c[1] - v0[3] * s[1]; y0[3] = v0[2] * s[1] + v0[3] * c[1];
                        y1[0] = v1[0] * c[2] - v1[1] * s[2]; y1[1] = v1[0] * s[2] + v1[1] * c[2];
                        y1[2] = v1[2] * c[3] - v1[3] * s[3]; y1[3] = v1[2] * s[3] + v1[3] * c[3];
                        v0 = y0; v1 = y1;
                    }
                    v0 = v0 * sc; v1 = v1 * sc;
                    u32x4 w; w.x = cvt_pk_bf16(v0[0], v0[1]); w.y = cvt_pk_bf16(v0[2], v0[3]); w.z = cvt_pk_bf16(v1[0], v1[1]); w.w = cvt_pk_bf16(v1[2], v1[3]);
                    *(u32x4*)(O + (size_t)row * ldc + colb + bj * HALF) = w;
                }
            }
    }
};
struct EpiResid {
    static constexpr bool PERM = false, AFTER_DRAIN = false;
    bf16_t* Z; const float* X; int ldc; float alpha;
    __device__ __forceinline__ void operator()(const f32x4 (&acc)[2][2][4][2], const Unit& u, int wr, int wc, int fr, int fq) const {
        const int row0 = u.pm * BM + wr * 64 + fr, col0 = u.pn * BM + wc * 32 + 4 * fq;
#pragma unroll
        for (int ai = 0; ai < 2; ++ai)
#pragma unroll
            for (int m = 0; m < 4; ++m) {
                const size_t off = (size_t)(row0 + ai * HALF + m * 16) * ldc + col0;
#pragma unroll
                for (int bj = 0; bj < 2; ++bj)
#pragma unroll
                    for (int n = 0; n < 2; ++n) { const f32x4 xv = *(const f32x4*)(X + off + bj * HALF + n * 16); const f32x4 zv = xv * alpha + acc[ai][bj][m][n]; typedef unsigned u32x2_ __attribute__((ext_vector_type(2))); *(u32x2_*)(Z + off + bj * HALF + n * 16) = (u32x2_){cvt_pk_bf16(zv[0], zv[1]), cvt_pk_bf16(zv[2], zv[3])}; }
            }
    }
};
template <class Epi, class Sched, bool ALIGN_EPI = false, bool SP2 = false>
__device__ __forceinline__ void gemm_phase(PG8_LAS unsigned char* lds, const Gemm g, const Sched& S, const Epi& E) {
    int tid_ = threadIdx.x; asm volatile("" : "+v"(tid_));
    const int tid = tid_, wid = __builtin_amdgcn_readfirstlane(tid >> 6), lane = tid & 63, wr = wid >> 2, wc = wid & 3, fr = lane & 15, fq = lane >> 4;
    const int K = g.K, nt = K / BK;
    unsigned voffA[2], voffB[2];
#pragma unroll
    for (int i = 0; i < 2; ++i) { int R, C; stage_rc(tid * 16 + i * 8192, R, C); const int Rb = Epi::PERM ? ((R & ~31) + perm32(R & 31)) : R;
        voffA[i] = (unsigned)(R * K + C) * 2u; voffB[i] = (unsigned)(Rb * K + C) * 2u; }
    const size_t kstep = (size_t)(BK * 2);
    const size_t hstep = (size_t)HALF * K * 2;
    const size_t tstep = 2 * hstep;
    const unsigned ldsw = (unsigned)wid * 1024u;
    const int aoff = lds_byte(wr * 64 + fr, fq * 8), boff = lds_byte(wc * 32 + fr, fq * 8);
#define PG8_SA(b, h) (((b) * 2 + (h)) * HTB)
#define PG8_SB(b, h) ((4 + (b) * 2 + (h)) * HTB)
#define PG8_STAGE(bufoff, gbase, voff) do { _Pragma("unroll") for (int _i = 0; _i < 2; ++_i) \
        __builtin_amdgcn_global_load_lds((const unsigned*)((const char*)(gbase) + (voff)[_i]), (PG8_LAS unsigned*)(lds + (bufoff) + ldsw + _i * 8192), 16, 0, 0); } while (0)
#define PG8_LDA(dst, b, h) do { _Pragma("unroll") for (int m = 0; m < 4; ++m) _Pragma("unroll") for (int k = 0; k < 2; ++k) dst[m][k] = *(const PG8_LAS bf16x8*)(lds + PG8_SA(b, h) + aoff + m * 2048 + k * 1024); } while (0)
#define PG8_LDB(dst, b, h) do { _Pragma("unroll") for (int n = 0; n < 2; ++n) _Pragma("unroll") for (int k = 0; k < 2; ++k) dst[n][k] = *(const PG8_LAS bf16x8*)(lds + PG8_SB(b, h) + boff + n * 2048 + k * 1024); } while (0)
#define PG8_MMA(ai, bj, At, Bt) do { __builtin_amdgcn_s_setprio(1); _Pragma("unroll") for (int m = 0; m < 4; ++m) _Pragma("unroll") for (int n = 0; n < 2; ++n) _Pragma("unroll") for (int k = 0; k < 2; ++k) \
        acc[ai][bj][m][n] = __builtin_amdgcn_mfma_f32_16x16x32_bf16(Bt[n][k], At[m][k], acc[ai][bj][m][n], 0, 0, 0); __builtin_amdgcn_s_setprio(0); } while (0)
#define PG8_WAIT_V(n) asm volatile("s_waitcnt vmcnt(" #n ")" ::: "memory")
#define PG8_WAIT_L(n) asm volatile("s_waitcnt lgkmcnt(" #n ")" ::: "memory")
#define PG8_BAR __builtin_amdgcn_s_barrier()
#define PG8_SCHED __builtin_amdgcn_sched_barrier(0)
    Unit cur, nxt; int ui = 0;
    if (!S.next(0, cur)) return;
    f32x4 acc[2][2][4][2];
#pragma unroll
    for (int a = 0; a < 2; ++a)
#pragma unroll
        for (int b = 0; b < 2; ++b)
#pragma unroll
            for (int m = 0; m < 4; ++m)
#pragma unroll
                for (int n = 0; n < 2; ++n) acc[a][b][m][n] = (f32x4){0.f, 0.f, 0.f, 0.f};
    bf16x8 At[4][2], B0[2][2], B1[2][2];
    const char* cA = (const char*)g.A + (size_t)cur.pm * tstep; const char* cB = (const char*)g.Bt + (size_t)cur.pn * tstep;
    S.a_ready(cur);
    if constexpr (SP2) {
        PG8_STAGE(PG8_SB(0, 0), cB, voffB); PG8_STAGE(PG8_SB(0, 1), cB + hstep, voffB); PG8_STAGE(PG8_SA(0, 0), cA, voffA); PG8_STAGE(PG8_SA(0, 1), cA + hstep, voffA);
        if (wr == 1) PG8_BAR;
        PG8_WAIT_V(2); PG8_BAR;
        PG8_STAGE(PG8_SB(1, 0), cB + kstep, voffB); PG8_STAGE(PG8_SA(1, 0), cA + kstep, voffA); PG8_STAGE(PG8_SB(1, 1), cB + hstep + kstep, voffB);
        PG8_WAIT_V(6); PG8_BAR;
    } else {
        PG8_STAGE(PG8_SB(0, 0), cB, voffB); PG8_STAGE(PG8_SA(0, 0), cA, voffA); PG8_STAGE(PG8_SB(0, 1), cB + hstep, voffB); PG8_STAGE(PG8_SA(0, 1), cA + hstep, voffA);
        if (wr == 1) PG8_BAR;
        PG8_WAIT_V(4); PG8_BAR;
        PG8_STAGE(PG8_SB(1, 0), cB + kstep, voffB); PG8_STAGE(PG8_SA(1, 0), cA + kstep, voffA); PG8_STAGE(PG8_SB(1, 1), cB + hstep + kstep, voffB);
        PG8_WAIT_V(6); PG8_BAR;
    }
    for (;;) {
        const bool has_next = S.next(ui + 1, nxt);
        const char* nA = has_next ? (const char*)g.A + (size_t)nxt.pm * tstep : cA; const char* nB = has_next ? (const char*)g.Bt + (size_t)nxt.pn * tstep : cB;
        for (int t = 0; t < nt; t += 2) {
            const bool last = (t == nt - 2);
            const char* a1 = cA + (size_t)(t + 1) * kstep;
            const char* a2 = last ? nA : cA + (size_t)(t + 2) * kstep; const char* b2 = last ? nB : cB + (size_t)(t + 2) * kstep;
            const char* a3 = a2 + kstep; const char* b3 = b2 + kstep;
            if (last && has_next) S.a_ready(nxt);
            if constexpr (SP2) {
            PG8_LDB(B0, 0, 0); PG8_LDB(B1, 0, 1); PG8_SCHED; PG8_LDA(At, 0, 0); PG8_STAGE(PG8_SA(1, 1), a1 + hstep, voffA);
            PG8_WAIT_V(8); PG8_WAIT_L(0); PG8_BAR; PG8_MMA(0, 0, At, B0); PG8_MMA(0, 1, At, B1); PG8_BAR; PG8_SCHED;
            PG8_LDA(At, 0, 1); PG8_STAGE(PG8_SB(0, 0), b2, voffB); PG8_STAGE(PG8_SB(0, 1), b2 + hstep, voffB); PG8_STAGE(PG8_SA(0, 0), a2, voffA);
            PG8_WAIT_V(8); PG8_WAIT_L(0); PG8_BAR; PG8_MMA(1, 0, At, B0); PG8_MMA(1, 1, At, B1); PG8_BAR; PG8_SCHED;
            PG8_LDB(B0, 1, 0); PG8_LDB(B1, 1, 1); PG8_SCHED; PG8_LDA(At, 1, 0); PG8_STAGE(PG8_SA(0, 1), a2 + hstep, voffA);
            PG8_WAIT_V(8); PG8_WAIT_L(0); PG8_BAR; PG8_MMA(0, 0, At, B0); PG8_MMA(0, 1, At, B1); PG8_BAR; PG8_SCHED;
            PG8_LDA(At, 1, 1); PG8_STAGE(PG8_SB(1, 0), b3, voffB); PG8_STAGE(PG8_SB(1, 1), b3 + hstep, voffB); PG8_STAGE(PG8_SA(1, 0), a3, voffA);
            PG8_WAIT_V(8); PG8_WAIT_L(0); PG8_BAR; PG8_MMA(1, 0, At, B0); PG8_MMA(1, 1, At, B1); PG8_BAR; PG8_SCHED;
            } else {
            PG8_LDB(B0, 0, 0); PG8_SCHED; PG8_LDA(At, 0, 0); PG8_STAGE(PG8_SA(1, 1), a1 + hstep, voffA);
            PG8_WAIT_L(8); PG8_BAR; PG8_WAIT_L(0); PG8_MMA(0, 0, At, B0); PG8_BAR; PG8_SCHED;
            PG8_LDB(B1, 0, 1); PG8_STAGE(PG8_SB(0, 0), b2, voffB);
            PG8_BAR; PG8_WAIT_L(0); PG8_MMA(0, 1, At, B1); PG8_BAR;
            PG8_LDA(At, 0, 1); PG8_STAGE(PG8_SA(0, 0), a2, voffA);
            PG8_BAR; PG8_WAIT_L(0); PG8_MMA(1, 0, At, B0); PG8_BAR; PG8_SCHED;
            PG8_STAGE(PG8_SB(0, 1), b2 + hstep, voffB);
            PG8_WAIT_V(6); PG8_BAR; PG8_MMA(1, 1, At, B1); PG8_BAR;
            PG8_LDB(B0, 1, 0); PG8_SCHED; PG8_LDA(At, 1, 0); PG8_STAGE(PG8_SA(0, 1), a2 + hstep, voffA);
            PG8_WAIT_L(8); PG8_BAR; PG8_WAIT_L(0); PG8_MMA(0, 0, At, B0); PG8_BAR; PG8_SCHED;
            PG8_LDB(B1, 1, 1); PG8_STAGE(PG8_SB(1, 0), b3, voffB);
            PG8_BAR; PG8_WAIT_L(0); PG8_MMA(0, 1, At, B1); PG8_BAR;
            PG8_LDA(At, 1, 1); PG8_STAGE(PG8_SA(1, 0), a3, voffA);
            PG8_BAR; PG8_WAIT_L(0); PG8_MMA(1, 0, At, B0); PG8_BAR; PG8_SCHED;
            PG8_STAGE(PG8_SB(1, 1), b3 + hstep, voffB);
            PG8_WAIT_V(6); PG8_BAR; PG8_MMA(1, 1, At, B1); PG8_BAR;
            }
        }
        if constexpr (ALIGN_EPI) { if (wr == 0) PG8_BAR; }
        if constexpr (!Epi::AFTER_DRAIN) { E(acc, cur, wr, wc, fr, fq); S.done(cur); }
        if (!has_next) break;
#pragma unroll
        for (int a = 0; a < 2; ++a)
#pragma unroll
            for (int b = 0; b < 2; ++b)
#pragma unroll
                for (int m = 0; m < 4; ++m)
#pragma unroll
                    for (int n = 0; n < 2; ++n) acc[a][b][m][n] = (f32x4){0.f, 0.f, 0.f, 0.f};
        cur = nxt; cA = nA; cB = nB; ++ui;
        if constexpr (ALIGN_EPI) { if (wr == 1) PG8_BAR; }
    }
    PG8_WAIT_V(0);
    if constexpr (!ALIGN_EPI) { if (wr == 0) PG8_BAR; }
    PG8_BAR;
    if constexpr (Epi::AFTER_DRAIN) { E.fused(acc, cur, wr, wc, fr, fq, lds, wid, lane); S.done(cur); }
#undef PG8_SA
#undef PG8_SB
#undef PG8_STAGE
#undef PG8_LDA
#undef PG8_LDB
#undef PG8_MMA
#undef PG8_WAIT_V
#undef PG8_WAIT_L
#undef PG8_BAR
#undef PG8_SCHED
}
}
namespace attn_body {
using bf16=__hip_bfloat16;
using bf16x8=__attribute__((ext_vector_type(8)))short;
using s16x4=__attribute__((ext_vector_type(4)))short;
using f32x16=__attribute__((ext_vector_type(16)))float;
using u32x4=__attribute__((ext_vector_type(4)))unsigned;
constexpr int SEQ=8192,D=64,DM=5184,ODM=1024;
constexpr int NW=8,QBLK=32,QB=QBLK*NW,KVBLK=64,NQB=SEQ/QB;
constexpr int ATTN_PITCH=DM, ATTN_UNIT_ROWS=QB;
__device__ __forceinline__ int crow(int r,int hi){return (r&3)+8*(r>>2)+4*hi;}
#define SBAR() __builtin_amdgcn_sched_barrier(0)
__device__ __forceinline__ void cmask(f32x16&p0,f32x16&p1,int jb,int qrel,int hi){
  const float NEG=-INFINITY; int kb=64*jb+4*hi;
  #pragma unroll
  for(int r=0;r<16;++r){int kv=kb+(r&3)+8*(r>>2); if(kv>qrel)p0[r]=NEG; if(kv+32>qrel)p1[r]=NEG;}
}

constexpr int NSLOT=3, SLOTB=8192;
constexpr int LDS_K=0, LDS_V=NSLOT*SLOTB, LDS_WS=2*NSLOT*SLOTB, LDS_OST=LDS_WS+NW*64*4, LDS_BYTES=LDS_OST+NW*4096;
constexpr float C2=0.125f*1.4426950408889634f;
__device__ __forceinline__ void glds16(const void*gsrc,unsigned lds_dst){unsigned keep;
  asm volatile("s_mov_b32 %0, m0\n\ts_mov_b32 m0, %2\n\ts_nop 0\n\tglobal_load_lds_dwordx4 %1, off\n\ts_mov_b32 m0, %0":"=&s"(keep):"v"(gsrc),"s"(lds_dst):"memory");}
__device__ __forceinline__ float max3f(float a,float b,float c){float r;asm("v_max3_f32 %0, %1, %2, %3":"=v"(r):"v"(a),"v"(b),"v"(c));return r;}
__device__ __forceinline__ float max2f(float a,float b){float r;asm("v_max_f32_e32 %0, %1, %2":"=v"(r):"v"(a),"v"(b));return r;}
__device__ __forceinline__ float fadd_s(float a,float b){float r;asm("v_add_f32_e32 %0, %1, %2":"=v"(r):"v"(a),"v"(b));return r;}
__device__ __forceinline__ float fsub_s(float a,float b){float r;asm("v_sub_f32_e32 %0, %1, %2":"=v"(r):"v"(a),"v"(b));return r;}
typedef float f32x2_t __attribute__((ext_vector_type(2))); typedef __bf16 bf16x2_t __attribute__((ext_vector_type(2)));
__device__ __forceinline__ unsigned cvtpk_s(float lo,float hi){f32x2_t v={lo,hi};bf16x2_t b=__builtin_convertvector(v,bf16x2_t);return __builtin_bit_cast(unsigned,b);}
#define WAIT_BAR(N) asm volatile("s_waitcnt vmcnt(" #N ") lgkmcnt(0)\n\ts_barrier":::"memory")

__device__ __forceinline__ void qkt(f32x16&p0,f32x16&p1,const char*Kslot,const bf16x8*qr,const f32x16&negm,int r32,int hi){
  const char*kb=Kslot+hi*1024+r32*16;
  #pragma unroll
  for(int d0=0;d0<4;++d0){
    const bf16x8 b0=*reinterpret_cast<const bf16x8*>(kb+d0*2048);
    const bf16x8 b1=*reinterpret_cast<const bf16x8*>(kb+d0*2048+512);
    if(d0==0){p0=__builtin_amdgcn_mfma_f32_32x32x16_bf16(b0,qr[0],negm,0,0,0);p1=__builtin_amdgcn_mfma_f32_32x32x16_bf16(b1,qr[0],negm,0,0,0);}
    else{p0=__builtin_amdgcn_mfma_f32_32x32x16_bf16(b0,qr[d0],p0,0,0,0);p1=__builtin_amdgcn_mfma_f32_32x32x16_bf16(b1,qr[d0],p1,0,0,0);}}
}
typedef __attribute__((address_space(3))) const char* lds_cptr;
typedef short v4i16_t __attribute__((ext_vector_type(4)));
__device__ __forceinline__ void kload8(bf16x8*kf,lds_cptr kp){
  kf[0]=*(const __attribute__((address_space(3))) bf16x8*)(kp);      kf[1]=*(const __attribute__((address_space(3))) bf16x8*)(kp+512);
  kf[2]=*(const __attribute__((address_space(3))) bf16x8*)(kp+2048); kf[3]=*(const __attribute__((address_space(3))) bf16x8*)(kp+2560);
  kf[4]=*(const __attribute__((address_space(3))) bf16x8*)(kp+4096); kf[5]=*(const __attribute__((address_space(3))) bf16x8*)(kp+4608);
  kf[6]=*(const __attribute__((address_space(3))) bf16x8*)(kp+6144); kf[7]=*(const __attribute__((address_space(3))) bf16x8*)(kp+6656);
}
__device__ __forceinline__ void kload2(bf16x8*kf,lds_cptr kp,int j){ kf[2*j]=*(const __attribute__((address_space(3))) bf16x8*)(kp+j*2048); kf[2*j+1]=*(const __attribute__((address_space(3))) bf16x8*)(kp+j*2048+512); }
__device__ __forceinline__ s16x4 vtr(lds_cptr p){ return __builtin_bit_cast(s16x4,__builtin_amdgcn_ds_read_tr16_b64_v4i16((__attribute__((address_space(3))) v4i16_t*)p)); }
__device__ __forceinline__ float rowmax(const f32x16&p0,const f32x16&p1){
  float a=max3f(p0[0],p0[1],p1[0]),b=max3f(p0[2],p0[3],p1[1]);a=max3f(a,p1[2],p1[3]);
  #pragma unroll
  for(int r=4;r<16;r+=4){a=max3f(a,p0[r],p0[r+1]);b=max3f(b,p0[r+2],p0[r+3]);a=max3f(a,p1[r],p1[r+1]);b=max3f(b,p1[r+2],p1[r+3]);}
  const float m=max2f(a,b);
  auto rr=__builtin_amdgcn_permlane32_swap(__float_as_uint(m),__float_as_uint(m),false,false);
  return max2f(__uint_as_float(rr[0]),__uint_as_float(rr[1]));
}
__device__ __forceinline__ void pv(f32x16*o,int vb,bf16x8 pa0,bf16x8 pa1,bf16x8 pa2,bf16x8 pa3){
  #pragma unroll
  for(int d0=0;d0<2;++d0){s16x4 lo[4],hi[4];
    #pragma unroll
    for(int ks=0;ks<4;++ks){
      asm volatile("ds_read_b64_tr_b16 %0,%1 offset:%c2":"=&v"(lo[ks]):"v"(vb),"i"(d0*4096+ks*1024):"memory");
      asm volatile("ds_read_b64_tr_b16 %0,%1 offset:%c2":"=&v"(hi[ks]):"v"(vb),"i"(d0*4096+ks*1024+512):"memory");}
    asm volatile("s_waitcnt lgkmcnt(0)":::"memory");SBAR();
    #define PK(k) (bf16x8){lo[k][0],lo[k][1],lo[k][2],lo[k][3],hi[k][0],hi[k][1],hi[k][2],hi[k][3]}
    o[d0]=__builtin_amdgcn_mfma_f32_32x32x16_bf16(pa0,PK(0),o[d0],0,0,0);
    o[d0]=__builtin_amdgcn_mfma_f32_32x32x16_bf16(pa1,PK(1),o[d0],0,0,0);
    o[d0]=__builtin_amdgcn_mfma_f32_32x32x16_bf16(pa2,PK(2),o[d0],0,0,0);
    o[d0]=__builtin_amdgcn_mfma_f32_32x32x16_bf16(pa3,PK(3),o[d0],0,0,0);
    #undef PK
  }
}

#ifndef ATTN_STORE16
#define ATTN_STORE16(p,v) (*(u32x4*)(p)=(v))
#endif
template<int THRL> __device__ __forceinline__ void attn_unit(int qb,const bf16*Qh,const bf16* Kh,const bf16* Vh,bf16*Oh,char*shm){
  int tid_=threadIdx.x; asm volatile("":"+v"(tid_));
  const int tid=tid_,lane=tid&63,r32=lane&31,hi=lane>>5; const int wid=__builtin_amdgcn_readfirstlane(tid>>6);
  const int q0=qb*QB;
  const bf16*Qw=Qh+(long)(q0+wid*QBLK)*DM;
  const unsigned lds0=(unsigned)(uintptr_t)shm;
  float*wsf=(float*)(shm+LDS_WS)+wid*64;
  const bf16*ksrc=Kh+(long)lane*DM+wid*8;
  const bf16*vsrc=Vh+(long)(16*(wid&3)+(lane>>2))*DM+(wid>>2)*32+(lane&3)*8;
  const unsigned kdst=lds0+LDS_K+wid*1024, vdst=lds0+LDS_V+wid*1024;
  #define DMA_K(t,slot) glds16(ksrc+(long)(t)*KVBLK*DM,(unsigned)__builtin_amdgcn_readfirstlane(kdst+(slot)))
  #define DMA_V(t,slot) glds16(vsrc+(long)(t)*KVBLK*DM,(unsigned)__builtin_amdgcn_readfirstlane(vdst+(slot)))
  const int vb0=(int)(lds0+LDS_V)+((lane>>4)&1)*32+(lane&3)*8+(4*hi+((lane&15)>>2))*64;
  const char*Kbase=shm+LDS_K; bf16x8 kf[8];
  const lds_cptr shm3=(lds_cptr)shm; const lds_cptr kp0=shm3+LDS_K+hi*1024+r32*16; const lds_cptr vp0=shm3+LDS_V+((lane>>4)&1)*32+(lane&3)*8+(4*hi+((lane&15)>>2))*64;
  const int NT=(q0+QB)/KVBLK;
  DMA_K(0,0);DMA_V(0,0);DMA_K(1,SLOTB);
  bf16x8 qr[4];
  #pragma unroll
  for(int d0=0;d0<4;++d0)qr[d0]=*reinterpret_cast<const bf16x8*>(&Qw[(long)r32*DM+d0*16+hi*8]);
  float mhat=0.f,l_reg=0.f;f32x16 o[2];o[0]=f32x16{};o[1]=f32x16{};f32x16 negm=f32x16{};asm volatile("":"+v"(negm));
  const int qrel=wid*QBLK+r32;
  #define CMASK(P0,P1,t) do{int jb_=(t)-(NT-4); if(jb_>=0)cmask(P0,P1,jb_,qrel,hi);}while(0)
  bool resc=false;
  #define START(P0,P1) do{ const float rm=rowmax(P0,P1); resc=false; \
    { const float dl=rm; mhat=fadd_s(mhat,dl); \
      _Pragma("unroll") for(int r=0;r<16;++r){P0[r]=fsub_s(P0[r],dl);P1[r]=fsub_s(P1[r],dl);} \
      _Pragma("unroll") for(int r=0;r<16;++r)negm[r]=-mhat; asm volatile("":"+v"(negm)); } \
    _Pragma("unroll") for(int r=0;r<16;++r)P0[r]=__builtin_amdgcn_exp2f(P0[r]); }while(0)
  #define RESC() do{ if(resc){ asm volatile("s_waitcnt lgkmcnt(0)":::"memory"); \
      _Pragma("unroll") for(int d_=0;d_<2;++d_) _Pragma("unroll") for(int r=0;r<16;++r)o[d_][r]*=wsf[crow(r,hi)]; } }while(0)
  f32x16 pA0,pA1,pB0,pB1;
  int sl_prev=0,sl_cur=0,sl_next=SLOTB;
  #define ROT() do{sl_prev=sl_cur;sl_cur=sl_next;sl_next=(sl_next==(NSLOT-1)*SLOTB)?0:sl_next+SLOTB;}while(0)
  DMA_K(2,2*SLOTB);
  WAIT_BAR(3);
  qkt(pA0,pA1,Kbase,qr,negm,r32,hi);asm volatile("s_nop 15\n\ts_nop 7":"+v"(pA0),"+v"(pA1));CMASK(pA0,pA1,0);
  START(pA0,pA1);
  _Pragma("unroll") for(int r=0;r<16;++r)pA1[r]=__builtin_amdgcn_exp2f(pA1[r]);
  WAIT_BAR(0);
  DMA_K(3,0);DMA_V(1,SLOTB);
  ROT();
  kload8(kf,kp0+sl_cur);
  WAIT_BAR(2);
  s16x4 vlo[8],vhi[8]; u32x4 pw0,pw1,pw2,pw3;
  #define PKW(P,B) cvtpk_s(P[B],P[B+1])
  #define PAF(k) __builtin_bit_cast(bf16x8,pw##k)
  #define VFR(i) (bf16x8){vlo[i][0],vlo[i][1],vlo[i][2],vlo[i][3],vhi[i][0],vhi[i][1],vhi[i][2],vhi[i][3]}
  #define PIN(x) asm volatile("":"+v"(x))
  #define MX3(a,b,c) __builtin_fmaxf(__builtin_fmaxf((a),(b)),(c))
  #define GAPA(MF,A0,A1,A2,A3,W0,W1,PW) do{ MF; sacc+=A0; sacc+=A1; sacc+=A2; sacc+=A3; PIN(sacc); W0; W1; PIN(PW); SBAR(); }while(0)
  #define EX(v) __builtin_amdgcn_exp2f(v)
  #define GAPB(MF,X,B) do{ MF; X[B]=EX(X[B]); X[B+1]=EX(X[B+1]); X[B+2]=EX(X[B+2]); X[B+3]=EX(X[B+3]); PIN(X); SBAR(); }while(0)
  #define VRD(i) do{ vlo[i]=vtr(vp_+(((i)>>2)*4096+((i)&3)*1024)); vhi[i]=vtr(vp_+(((i)>>2)*4096+((i)&3)*1024+512)); }while(0)
  #define KRD(G,j) do{ if(G){ kload2(kf,kp0+sl_next,j); SBAR(); } }while(0)
  #define STEP(C0,C1,P0,P1,t,GK,GV,GL) do{ SBAR(); \
    const lds_cptr vp_=vp0+sl_prev; \
    VRD(0); SBAR(); float sacc=(P0[0]+P0[1]); \
    GAPA(C0=__builtin_amdgcn_mfma_f32_32x32x16_bf16(kf[0],qr[0],negm,0,0,0), P0[2],P0[3],P0[4],P0[5],     pw0[0]=PKW(P0,0), pw0[1]=PKW(P0,2), pw0); \
    VRD(4); SBAR(); GAPA(C1=__builtin_amdgcn_mfma_f32_32x32x16_bf16(kf[1],qr[0],negm,0,0,0), P0[6],P0[7],P0[8],P0[9],     pw0[2]=PKW(P0,4), pw0[3]=PKW(P0,6), pw0); \
    VRD(1); SBAR(); GAPA(C0=__builtin_amdgcn_mfma_f32_32x32x16_bf16(kf[2],qr[1],C0,0,0,0),   P0[10],P0[11],P0[12],P0[13], pw1[0]=PKW(P0,8), pw1[1]=PKW(P0,10), pw1); \
    VRD(5); SBAR(); GAPA(C1=__builtin_amdgcn_mfma_f32_32x32x16_bf16(kf[3],qr[1],C1,0,0,0),   P0[14],P0[15],P1[0],P1[1],   pw1[2]=PKW(P0,12),pw1[3]=PKW(P0,14), pw1); \
    VRD(2); SBAR(); GAPA(C0=__builtin_amdgcn_mfma_f32_32x32x16_bf16(kf[4],qr[2],C0,0,0,0),   P1[2],P1[3],P1[4],P1[5],     pw2[0]=PKW(P1,0), pw2[1]=PKW(P1,2), pw2); \
    VRD(6); SBAR(); GAPA(C1=__builtin_amdgcn_mfma_f32_32x32x16_bf16(kf[5],qr[2],C1,0,0,0),   P1[6],P1[7],P1[8],P1[9],     pw2[2]=PKW(P1,4), pw2[3]=PKW(P1,6), pw2); \
    VRD(3); SBAR(); GAPA(C0=__builtin_amdgcn_mfma_f32_32x32x16_bf16(kf[6],qr[3],C0,0,0,0),   P1[10],P1[11],P1[12],P1[13], pw3[0]=PKW(P1,8), pw3[1]=PKW(P1,10), pw3); \
    VRD(7); SBAR(); GAPA(C1=__builtin_amdgcn_mfma_f32_32x32x16_bf16(kf[7],qr[3],C1,0,0,0),   P1[14],P1[15],0.f,0.f,       pw3[2]=PKW(P1,12),pw3[3]=PKW(P1,14), pw3); \
    l_reg+=sacc; \
    if(GK){DMA_K((t)+3,sl_cur);} if(GV){DMA_V((t)+1,sl_next);} \
    CMASK(C0,C1,t); \
    { float a=MX3(C0[0],C0[1],C1[0]),b=MX3(C0[2],C0[3],C1[1]); a=MX3(a,C1[2],C1[3]); \
      _Pragma("unroll") for(int r=4;r<16;r+=4){a=MX3(a,C0[r],C0[r+1]);b=MX3(b,C0[r+2],C0[r+3]);a=MX3(a,C1[r],C1[r+1]);b=MX3(b,C1[r+2],C1[r+3]);} \
      float rm=__builtin_fmaxf(a,b); { auto rr=__builtin_amdgcn_permlane32_swap(__float_as_uint(rm),__float_as_uint(rm),false,false); rm=__builtin_fmaxf(__uint_as_float(rr[0]),__uint_as_float(rr[1])); } \
      resc=false; \
      if(__builtin_expect(__any(rm>(float)THRL),0)){ const float dl=__builtin_fmaxf(rm,0.f); mhat+=dl; \
        _Pragma("unroll") for(int r=0;r<16;++r){C0[r]-=dl;C1[r]-=dl;} \
        _Pragma("unroll") for(int r=0;r<16;++r)negm[r]=-mhat; asm volatile("":"+v"(negm)); \
        const float f=__builtin_amdgcn_exp2f(-dl); l_reg*=f; if(hi==0)wsf[r32]=f; resc=true; } } \
    SBAR(); \
    GAPB(o[0]=__builtin_amdgcn_mfma_f32_32x32x16_bf16(PAF(0),VFR(0),o[0],0,0,0), C0,0); \
    GAPB(o[1]=__builtin_amdgcn_mfma_f32_32x32x16_bf16(PAF(0),VFR(4),o[1],0,0,0), C0,4); \
    KRD(GL,0); GAPB(o[0]=__builtin_amdgcn_mfma_f32_32x32x16_bf16(PAF(1),VFR(1),o[0],0,0,0), C0,8); \
    KRD(GL,1); GAPB(o[1]=__builtin_amdgcn_mfma_f32_32x32x16_bf16(PAF(1),VFR(5),o[1],0,0,0), C0,12); \
    KRD(GL,2); GAPB(o[0]=__builtin_amdgcn_mfma_f32_32x32x16_bf16(PAF(2),VFR(2),o[0],0,0,0), C1,0); \
    KRD(GL,3); GAPB(o[1]=__builtin_amdgcn_mfma_f32_32x32x16_bf16(PAF(2),VFR(6),o[1],0,0,0), C1,4); \
    GAPB(o[0]=__builtin_amdgcn_mfma_f32_32x32x16_bf16(PAF(3),VFR(3),o[0],0,0,0), C1,8); \
    GAPB(o[1]=__builtin_amdgcn_mfma_f32_32x32x16_bf16(PAF(3),VFR(7),o[1],0,0,0), C1,12); \
    }while(0)
  int t=1;
  #undef CMASK
  #define CMASK(P0,P1,t) do{}while(0)
  for(;t+5<NT;t+=2){
    STEP(pB0,pB1,pA0,pA1,t,true,true,true);     WAIT_BAR(2); RESC(); ROT();
    STEP(pA0,pA1,pB0,pB1,t+1,true,true,true);   WAIT_BAR(2); RESC(); ROT();
  }
  #undef CMASK
  #define CMASK(P0,P1,t) do{int jb_=(t)-(NT-4); if(jb_>=0)cmask(P0,P1,jb_,qrel,hi);}while(0)
  #define ENDW(tt) do{ if((tt)+3<NT){WAIT_BAR(2);} else if((tt)+2<NT){WAIT_BAR(1);} else {WAIT_BAR(0);} }while(0)
  for(;t+1<NT;t+=2){
    STEP(pB0,pB1,pA0,pA1,t,(t+3<NT),(t+1<NT),(t+1<NT));       ENDW(t);   RESC(); ROT();
    STEP(pA0,pA1,pB0,pB1,t+1,(t+4<NT),(t+2<NT),(t+2<NT));     ENDW(t+1); RESC(); ROT();
  }
  STEP(pB0,pB1,pA0,pA1,NT-1,false,false,false); RESC();
  { float sacc=pB0[0]+pB0[1]; _Pragma("unroll") for(int r=2;r<16;++r)sacc+=pB0[r]; _Pragma("unroll") for(int r=0;r<16;++r)sacc+=pB1[r]; l_reg+=sacc;
    pw0=(u32x4){PKW(pB0,0),PKW(pB0,2),PKW(pB0,4),PKW(pB0,6)};pw1=(u32x4){PKW(pB0,8),PKW(pB0,10),PKW(pB0,12),PKW(pB0,14)};pw2=(u32x4){PKW(pB1,0),PKW(pB1,2),PKW(pB1,4),PKW(pB1,6)};pw3=(u32x4){PKW(pB1,8),PKW(pB1,10),PKW(pB1,12),PKW(pB1,14)};
    SBAR(); pv(o,vb0+sl_cur,PAF(0),PAF(1),PAF(2),PAF(3)); }
  #undef PKW
  #undef PAF
  #undef VFR
  #undef PIN
  #undef MX3
  #undef GAPA
  #undef GAPB
  #undef EX
  #undef VRD
  #undef KRD
  #undef STEP
  #undef ENDW
  {auto rr=__builtin_amdgcn_permlane32_swap(__float_as_uint(l_reg),__float_as_uint(l_reg),false,false);l_reg=__uint_as_float(rr[0])+__uint_as_float(rr[1]);}
  if(hi==0)wsf[32+r32]=l_reg;asm volatile("s_waitcnt lgkmcnt(0)":::"memory");
  float rli[16];
  #pragma unroll
  for(int r=0;r<16;++r)rli[r]=__builtin_amdgcn_rcpf(wsf[32+crow(r,hi)]);
  bf16*Ow=Oh+(long)(q0+wid*QBLK)*ODM;
  { bf16*stg=(bf16*)(shm+LDS_OST)+wid*2048;
    #pragma unroll
    for(int r=0;r<16;++r){const int orow=crow(r,hi);
      #pragma unroll
      for(int d0=0;d0<2;++d0)stg[orow*64+d0*32+r32]=__float2bfloat16(o[d0][r]*rli[r]);}
    asm volatile("s_waitcnt lgkmcnt(0)":::"memory");
    #pragma unroll
    for(int i=0;i<4;++i){const int row=i*8+(lane>>3),ch=lane&7; const u32x4 v=*(const u32x4*)(stg+row*64+ch*8); ATTN_STORE16(Ow+(long)row*ODM+ch*8,v);} }
  asm volatile("s_waitcnt lgkmcnt(0)\n\ts_barrier":::"memory");
  #undef DMA_K
  #undef DMA_V
  #undef CMASK
  #undef START
  #undef RESC
  #undef ROT
}
constexpr int ATTN_LDS_BYTES=LDS_BYTES;
#undef SBAR
#undef WAIT_BAR
}
#define GAS __attribute__((address_space(1)))
#define LAS __attribute__((address_space(3)))
typedef unsigned short bf16;
typedef unsigned v4u __attribute__((ext_vector_type(4)));
typedef float f32x4 __attribute__((ext_vector_type(4)));
typedef short bf16x8 __attribute__((ext_vector_type(8)));
typedef GAS unsigned gu32;
typedef GAS unsigned long long gu64;
#define RLX_AGENT __ATOMIC_RELAXED, __HIP_MEMORY_SCOPE_AGENT
#define LDS_WAIT() asm volatile("s_waitcnt lgkmcnt(0)" ::: "memory")
#define VM_WAIT() asm volatile("s_waitcnt vmcnt(0)" ::: "memory")
__device__ __forceinline__ unsigned long long rt() { return __builtin_amdgcn_s_memrealtime(); }
__device__ __forceinline__ unsigned f2bf(float f) { unsigned u = __builtin_bit_cast(unsigned, f); return (u + 0x7fffu + ((u >> 16) & 1u)) >> 16; }
__device__ __forceinline__ unsigned pk2(float lo, float hi) { return f2bf(lo) | (f2bf(hi) << 16); }

#define XB_TMO      128
#define XB_XCNT(j)  (256  + 64 * (j))
#define XB_XSUB(j)  (1280 + 64 * (j))
#define XB_XGEN(j)  (2304 + 64 * (j))
#define XB_TOP      3328
#define XB_TOPGEN   3392
#define XCD_BAR_WORDS 3456
#define XB_SPIN_CAP (1u << 18)

__device__ __forceinline__ unsigned xb_ld(unsigned* p)              { return __hip_atomic_load(p, __ATOMIC_RELAXED, __HIP_MEMORY_SCOPE_AGENT); }
__device__ __forceinline__ unsigned xb_add(unsigned* p, unsigned v) { return __hip_atomic_fetch_add(p, v, __ATOMIC_RELAXED, __HIP_MEMORY_SCOPE_AGENT); }
__device__ __forceinline__ unsigned xb_xcc_id() { return (unsigned)__builtin_amdgcn_s_getreg((3 << 11) | 20) & 0xFu; }
#define XB_SPIN(cond, bar) do { unsigned _sp = 0; while (cond) { __builtin_amdgcn_s_sleep(1); \
    if ((++_sp & 255u) == 0u) { if (xb_ld(&(bar)[XB_TMO])) break; if (_sp > XB_SPIN_CAP) { atomicAdd(&(bar)[XB_TMO], 1u); break; } } } } while (0)

struct XcdBarrier {
    unsigned* bar; unsigned x;
    volatile LAS unsigned* st;
};

__device__ __forceinline__ XcdBarrier xcd_barrier_post(unsigned* bar, volatile LAS unsigned* st) {
    XcdBarrier b; b.bar = bar; b.x = xb_xcc_id(); b.st = st;
    if (threadIdx.x == 0) (void)xb_add(&bar[XB_XCNT(b.x)], 1u);
    return b;
}
__device__ __forceinline__ void xcd_barrier_complete(unsigned* bar, unsigned x, unsigned& nloc, unsigned& nx) {
    const unsigned G = gridDim.x * gridDim.y * gridDim.z;
    unsigned sum, cnt, mine, sp = 0u;
    for (;;) {
        sum = 0u; cnt = 0u; mine = 0u;
#pragma unroll
        for (unsigned j = 0; j < 16; ++j) { const unsigned c = xb_ld(&bar[XB_XCNT(j)]); sum += c; cnt += (c > 0u) ? 1u : 0u; mine = (j == x) ? c : mine; }
        if (sum == G) break;
        __builtin_amdgcn_s_sleep(1);
        if ((++sp & 255u) == 0u) { if (xb_ld(&bar[XB_TMO])) break; if (sp > XB_SPIN_CAP) { atomicAdd(&bar[XB_TMO], 1u); break; } }
    }
    nloc = mine > 0u ? mine : 1u; nx = cnt > 0u ? cnt : 1u;
}

__device__ __forceinline__ void xcd_barrier(const XcdBarrier& b) {
    asm volatile("s_waitcnt vmcnt(0)" ::: "memory");
    __syncthreads();
    if (threadIdx.x == 0) {
        unsigned* bar = b.bar;
        __builtin_amdgcn_s_waitcnt(0);
        unsigned nloc = b.st[0], nx = b.st[1];
        if (nloc == 0u) { xcd_barrier_complete(bar, b.x, nloc, nx); b.st[0] = nloc; b.st[1] = nx; }
        const unsigned old = xb_add(&bar[XB_XSUB(b.x)], 1u);
        const unsigned gen = old / nloc;
        if (old + 1u == (gen + 1u) * nloc) {
            __builtin_amdgcn_fence(__ATOMIC_RELEASE, "agent");
            asm volatile("s_waitcnt vmcnt(0)" ::: "memory");
            const unsigned og = xb_add(&bar[XB_TOP], 1u);
            const unsigned tg = og / nx;
            if (og + 1u == (tg + 1u) * nx) xb_add(&bar[XB_TOPGEN], 1u);
            else XB_SPIN(xb_ld(&bar[XB_TOPGEN]) == tg, bar);
            __builtin_amdgcn_fence(__ATOMIC_ACQUIRE, "agent");
            xb_add(&bar[XB_XGEN(b.x)], 1u);
            asm volatile("s_waitcnt vmcnt(0)" ::: "memory");
        } else {
            XB_SPIN(xb_ld(&bar[XB_XGEN(b.x)]) == gen, bar);
            __builtin_amdgcn_fence(__ATOMIC_ACQUIRE, "agent");
            asm volatile("s_waitcnt vmcnt(0)" ::: "memory");
        }
    }
    __syncthreads();
}

namespace cw {
typedef unsigned short u16;
typedef short bf16x8 __attribute__((ext_vector_type(8)));
typedef float f32x16 __attribute__((ext_vector_type(16)));
typedef float f32x4 __attribute__((ext_vector_type(4)));
typedef unsigned u32x4 __attribute__((ext_vector_type(4)));
typedef unsigned u32x2 __attribute__((ext_vector_type(2)));
typedef __bf16 bf16x2_t __attribute__((ext_vector_type(2)));
#define CW_LAS __attribute__((address_space(3)))
constexpr int SEQ = 8192, DMODEL = 2048, PITCH = 5184;
constexpr int AQ = 0, AK = 512, AV = 640, BQ = 768, BK_ = 1280, BV = 1792, CQ = 2304, CK = 2816, CV = 3328, DQ = 3840, DK = 4352, DV = 4416, IQ = 4480, IK = 4992, IW = 5056;
constexpr float LOG2E = 1.4426950408889634f;
constexpr float NEGINF = -INFINITY;
#ifndef PEER_G1
#define PEER_G1 4
#endif
#ifndef PEER_G2
#define PEER_G2 2
#endif
#ifndef DUPSUB
#define DUPSUB 0
#endif
#ifndef ABL
#define ABL 0
#endif
constexpr float KA = (ABL == 1) ? 0.f : 1.f, KC = (ABL == 2) ? 0.f : 1.f, KD = (ABL == 3) ? 0.f : 1.f, KP = (ABL == 4) ? 0.f : 1.f, KB = (ABL == 5) ? 0.f : 1.f;

__device__ __forceinline__ int crow(int r, int hi) { return (r & 3) + 8 * (r >> 2) + 4 * hi; }
__device__ __forceinline__ float bf2f(unsigned b) { return __uint_as_float(b << 16); }
__device__ __forceinline__ unsigned f2bf(float f) { unsigned u = __float_as_uint(f); return (u + 0x7fffu + ((u >> 16) & 1u)) >> 16; }
__device__ __forceinline__ unsigned pk2(float lo, float hi) { typedef float f2_ __attribute__((ext_vector_type(2))); typedef __bf16 b2_ __attribute__((ext_vector_type(2))); const f2_ v = {lo, hi}; return __builtin_bit_cast(unsigned, __builtin_convertvector(v, b2_)); }
__device__ __forceinline__ float ex2(float x) { return __builtin_amdgcn_exp2f(x); }
__device__ __forceinline__ float pair_max(float v) { auto rr = __builtin_amdgcn_permlane32_swap(__float_as_uint(v), __float_as_uint(v), false, false); return fmaxf(__uint_as_float(rr[0]), __uint_as_float(rr[1])); }
__device__ __forceinline__ float pair_sum(float v) { auto rr = __builtin_amdgcn_permlane32_swap(__float_as_uint(v), __float_as_uint(v), false, false); return __uint_as_float(rr[0]) + __uint_as_float(rr[1]); }
__device__ __forceinline__ float wave_sum(float v) {
#pragma unroll
    for (int o = 1; o < 64; o <<= 1) v += __shfl_xor(v, o);
    return v;
}
__device__ __forceinline__ bf16x8 ld8(const u16* p) { return *(const bf16x8*)p; }
__device__ __forceinline__ unsigned pkh(float lo, float hi) { typedef _Float16 h2 __attribute__((ext_vector_type(2))); const h2 v = {(_Float16)lo, (_Float16)hi}; return __builtin_bit_cast(unsigned, v); }
__device__ __forceinline__ unsigned __builtin_amdgcn_mad_u32_u24_compat(unsigned a, unsigned b, unsigned c) { return __umul24(a, b) + c; }

struct BState { f32x16 o0, o1; float m, l; };
typedef short s16x4 __attribute__((ext_vector_type(4)));
template <bool GATHER = false>
__device__ __forceinline__ void band_accum(BState& st, const bf16x8 (&qf)[4], const u16* Kb, const u16* Vb, int kres, int kdil, int pq, int pstart, int ntiles, int maxd, int lane, CW_LAS unsigned char* bst, CW_LAS const u16* idx16 = nullptr) {
    const int r32 = lane & 31, hi = lane >> 5;
    const int pmax = (SEQ - 1 - kres) / kdil;
    const int lrow = lane >> 3; const unsigned kgo = 8u * (unsigned)((lane & 7) ^ (lrow & 7)), vgo = 8u * (unsigned)(lane & 7);
    CW_LAS const unsigned char* krd = bst + r32 * 128; const int kx = r32 & 7;
    CW_LAS const unsigned char* vrd = bst + 4096 + (4 * hi + ((lane & 15) >> 2)) * 128 + (16 * ((lane >> 4) & 1) + 4 * (lane & 3)) * 2;
#define BA_LOAD(buf, KT) do { const int p0_ = pstart + 32 * (KT); \
        _Pragma("unroll") for (int m_ = 0; m_ < 4; ++m_) { int pk_ = p0_ + 8 * m_ + lrow; size_t ro_; if constexpr (GATHER) ro_ = (size_t)((unsigned)idx16[pk_] & 0x1fffu) * PITCH; else { pk_ = pk_ > pmax ? pmax : pk_; ro_ = (size_t)(kres + kdil * pk_) * PITCH; } \
            __builtin_amdgcn_global_load_lds((const unsigned*)(Kb + ro_ + kgo), (CW_LAS unsigned*)(bst + (buf) * 8192 + m_ * 1024), 16, 0, 0); \
            __builtin_amdgcn_global_load_lds((const unsigned*)(Vb + ro_ + vgo), (CW_LAS unsigned*)(bst + (buf) * 8192 + 4096 + m_ * 1024), 16, 0, 0); } } while (0)
#define BA_READ(kf, vt, buf) do { \
        _Pragma("unroll") for (int d0 = 0; d0 < 4; ++d0) kf[d0] = *(const CW_LAS bf16x8*)(krd + (buf) * 8192 + 16 * ((2 * d0 + hi) ^ kx)); \
        _Pragma("unroll") for (int s_ = 0; s_ < 2; ++s_) _Pragma("unroll") for (int jh_ = 0; jh_ < 2; ++jh_) _Pragma("unroll") for (int b_ = 0; b_ < 2; ++b_) \
            vt[s_][jh_][b_] = __builtin_bit_cast(s16x4, __builtin_amdgcn_ds_read_tr16_b64_v4i16((CW_LAS s16x4*)(vrd + (buf) * 8192 + (16 * s_ + 8 * jh_) * 128 + 64 * b_))); } while (0)
#define BA_QK(s16, kf) do { s16 = (f32x16){0.f, 0.f, 0.f, 0.f, 0.f, 0.f, 0.f, 0.f, 0.f, 0.f, 0.f, 0.f, 0.f, 0.f, 0.f, 0.f}; \
        _Pragma("unroll") for (int d0 = 0; d0 < 4; ++d0) s16 = __builtin_amdgcn_mfma_f32_32x32x16_bf16(kf[d0], qf[d0], s16, 0, 0, 0); __builtin_amdgcn_sched_barrier(0); } while (0)
#define BA_SOFTPV(s16, vt, KT) do { const int p0_ = pstart + 32 * (KT); \
        float rm = NEGINF; \
        { const int mb_ = GATHER ? (maxd - p0_ - 4 * hi) : (pq - p0_ - 4 * hi);     \
        _Pragma("unroll") for (int r = 0; r < 16; ++r) { const int c_ = (r & 3) + 8 * (r >> 2); const bool ok = GATHER ? (c_ < mb_) : ((unsigned)(mb_ - c_) <= (unsigned)maxd); s16[r] = ok ? s16[r] : NEGINF; rm = fmaxf(rm, s16[r]); } } \
        rm = pair_max(rm); \
        const float mn = fmaxf(st.m, rm), mu = (mn == NEGINF) ? 0.f : mn; \
        const float alpha = ex2(st.m - mu); \
        float ps = 0.f; \
        _Pragma("unroll") for (int r = 0; r < 16; ++r) { s16[r] = ex2(s16[r] - mu); ps += s16[r]; } \
        ps = pair_sum(ps); \
        st.l = st.l * alpha + ps; st.m = mn; \
        if (__any(alpha != 1.0f)) { _Pragma("unroll") for (int r = 0; r < 16; ++r) { st.o0[r] *= alpha; st.o1[r] *= alpha; } }     \
        _Pragma("unroll") for (int s_ = 0; s_ < 2; ++s_) { \
            u32x4 pw; pw.x = pk2(s16[8 * s_ + 0], s16[8 * s_ + 1]); pw.y = pk2(s16[8 * s_ + 2], s16[8 * s_ + 3]); pw.z = pk2(s16[8 * s_ + 4], s16[8 * s_ + 5]); pw.w = pk2(s16[8 * s_ + 6], s16[8 * s_ + 7]); \
            const bf16x8 pf = __builtin_bit_cast(bf16x8, pw); \
            st.o0 = __builtin_amdgcn_mfma_f32_32x32x16_bf16(__builtin_shufflevector(vt[s_][0][0], vt[s_][1][0], 0, 1, 2, 3, 4, 5, 6, 7), pf, st.o0, 0, 0, 0); \
            st.o1 = __builtin_amdgcn_mfma_f32_32x32x16_bf16(__builtin_shufflevector(vt[s_][0][1], vt[s_][1][1], 0, 1, 2, 3, 4, 5, 6, 7), pf, st.o1, 0, 0, 0); } \
        __builtin_amdgcn_sched_barrier(0); } while (0)
#define BA_NEXT(kf, vt, s16, buf, KTL) do { asm volatile("s_waitcnt vmcnt(8)" ::: "memory"); BA_READ(kf, vt, buf); asm volatile("s_waitcnt lgkmcnt(0)" ::: "memory"); \
        { const int kn_ = ((KTL) < ntiles) ? (KTL) : ntiles - 1; BA_LOAD(buf, kn_); } BA_QK(s16, kf); } while (0)
    bf16x8 kfA[4], kfB[4]; s16x4 vtA[2][2][2], vtB[2][2][2]; f32x16 sA, sB;
    asm volatile("s_waitcnt lgkmcnt(0)" ::: "memory"); BA_LOAD(0, 0); BA_LOAD(1, (1 < ntiles) ? 1 : ntiles - 1);
    BA_NEXT(kfA, vtA, sA, 0, 2);
#pragma unroll 1
    for (int kt = 0; kt < ntiles; kt += 2) {
        if (kt + 1 < ntiles) BA_NEXT(kfB, vtB, sB, 1, kt + 3);
        BA_SOFTPV(sA, vtA, kt);
        if (kt + 1 < ntiles) {
            if (kt + 2 < ntiles) BA_NEXT(kfA, vtA, sA, 0, kt + 4);
            BA_SOFTPV(sB, vtB, kt + 1);
        }
    }
    asm volatile("s_waitcnt vmcnt(0)" ::: "memory");
#undef BA_LOAD
#undef BA_READ
#undef BA_QK
#undef BA_SOFTPV
#undef BA_NEXT
}
__device__ __forceinline__ void bstate_init(BState& st) {
#pragma unroll
    for (int r = 0; r < 16; ++r) { st.o0[r] = 0.f; st.o1[r] = 0.f; }
    st.m = NEGINF; st.l = 0.f;
}
__device__ __forceinline__ void bstate_store(const BState& st, float f, u16* orow, int hi) {
#pragma unroll
    for (int b = 0; b < 2; ++b)
#pragma unroll
        for (int g = 0; g < 4; ++g) {
            const f32x16& o = b ? st.o1 : st.o0;
            u32x2 w; w.x = pk2(o[4 * g] * f, o[4 * g + 1] * f); w.y = pk2(o[4 * g + 2] * f, o[4 * g + 3] * f);
            *(u32x2*)(orow + 32 * b + 8 * g + 4 * hi) = w;
        }
}
__device__ __forceinline__ void swa_item(const u16* proj, u16* mixed, const float* sinks, int hq, int qt, int lane, CW_LAS unsigned char* bst) {
    const int r32 = lane & 31, hi = lane >> 5, t0 = 32 * qt, kvh = hq >> 2;
    const u16* qrow = proj + (size_t)(t0 + r32) * PITCH + AQ + hq * 64 + 8 * hi;
    bf16x8 qf[4];
#pragma unroll
    for (int d0 = 0; d0 < 4; ++d0) qf[d0] = ld8(qrow + 16 * d0);
    BState st; bstate_init(st);
    int pstart = t0 - 127; pstart = pstart < 0 ? 0 : pstart;
    const int ntiles = (t0 + 31 - pstart) / 32 + 1;
    band_accum(st, qf, proj + AK + kvh * 64, proj + AV + kvh * 64, 0, 1, t0 + r32, pstart, ntiles, 127, lane, bst);
    const float sink2 = sinks[hq] * LOG2E;
    const float mall = fmaxf(st.m, sink2), corr = ex2(st.m - mall), den = st.l * corr + ex2(sink2 - mall);
    bstate_store(st, KA * corr / den, mixed + (size_t)(t0 + r32) * DMODEL + 0 + hq * 64, hi);
}
__device__ __forceinline__ void dil_item(const u16* proj, u16* mixed, int h, int r16, int jb, int lane, CW_LAS unsigned char* bst) {
    const int r32 = lane & 31, hi = lane >> 5;
    const int tq = r16 + 16 * (32 * jb + r32);
    const int tq_lo = r16 + 16 * (32 * jb), tq_hi = tq_lo + 16 * 31;
    const u16* qrow = proj + (size_t)tq * PITCH + CQ + h * 64 + 8 * hi;
    bf16x8 qf[4];
#pragma unroll
    for (int d0 = 0; d0 < 4; ++d0) qf[d0] = ld8(qrow + 16 * d0);
    BState st; bstate_init(st);
    const u16* Kb = proj + CK + h * 64; const u16* Vb = proj + CV + h * 64;
    {
        int ps = tq_lo - 128; ps = ps < 0 ? 0 : ps; const int nt = (tq_hi - ps) / 32 + 1;
        band_accum(st, qf, Kb, Vb, 0, 1, tq, ps, nt, 128, lane, bst);
    }
    {
        const int res = r16 & 3; int ps = (tq_lo >> 2) - 128; ps = ps < 0 ? 0 : ps; const int nt = ((tq_hi >> 2) - ps) / 32 + 1;
        band_accum(st, qf, Kb, Vb, res, 4, tq >> 2, ps, nt, 128, lane, bst);
    }
    {
        int ps = (tq_lo >> 4) - 128; ps = ps < 0 ? 0 : ps; const int nt = ((tq_hi >> 4) - ps) / 32 + 1;
        band_accum(st, qf, Kb, Vb, r16, 16, tq >> 4, ps, nt, 128, lane, bst);
    }
    bstate_store(st, KC * 1.0f / st.l, mixed + (size_t)tq * DMODEL + 1024 + h * 64, hi);
}

__device__ __forceinline__ void idx_item(const u16* proj, u16* scores, int qt, int c, int rot_seed, int lane, CW_LAS unsigned char* kst, bool do_store = true) {
    const int q = lane & 15, kq = lane >> 4, t = 16 * qt + q;
    asm volatile("s_waitcnt lgkmcnt(0)" ::: "memory");
    { const u16* qg = proj + (size_t)(16 * qt) * PITCH + IQ;
#pragma unroll
      for (int r = 0; r < 16; ++r) __builtin_amdgcn_global_load_lds((const unsigned*)(qg + (size_t)r * PITCH + 8 * (lane ^ r)), (CW_LAS unsigned*)(kst + r * 1024), 16, 0, 0); }
    float w[8];
    { const u32x4 wv = *(const u32x4*)(proj + (size_t)t * PITCH + IW);
      const float sc = 0.35355339059327373f;
      w[0] = bf2f(wv.x & 0xffffu) * sc; w[1] = bf2f(wv.x >> 16) * sc; w[2] = bf2f(wv.y & 0xffffu) * sc; w[3] = bf2f(wv.y >> 16) * sc;
      w[4] = bf2f(wv.z & 0xffffu) * sc; w[5] = bf2f(wv.z >> 16) * sc; w[6] = bf2f(wv.w & 0xffffu) * sc; w[7] = bf2f(wv.w >> 16) * sc; }
    asm volatile("s_waitcnt vmcnt(0)" ::: "memory");
    bf16x8 qf[8][2];
#pragma unroll
    for (int h = 0; h < 8; ++h)
#pragma unroll
        for (int s_ = 0; s_ < 2; ++s_) qf[h][s_] = *(const CW_LAS bf16x8*)(kst + q * 1024 + 16 * ((8 * h + 4 * s_ + kq) ^ q));
    asm volatile("s_waitcnt lgkmcnt(0)" ::: "memory");
    const int kt_end = (16 * c + 15 < qt) ? 16 * c + 15 : qt;
    const u16* kgl = proj + (size_t)(lane >> 3) * PITCH + IK + 8 * ((lane & 7) ^ ((lane >> 3) & 7));
    CW_LAS const unsigned char* krd = kst + q * 128;
    const int kp0 = 16 * (kq ^ (q & 7)), kp1 = 16 * ((4 + kq) ^ (q & 7));
#define IDX_STAGE(gb, ktg) do { _Pragma("unroll") for (int u_ = 0; u_ < 4; ++u_) { int kk_ = (ktg) + u_; kk_ = kk_ > kt_end ? kt_end : kk_; const u16* kr_ = kgl + (size_t)(16 * kk_) * PITCH; \
        __builtin_amdgcn_global_load_lds((const unsigned*)kr_, (CW_LAS unsigned*)(kst + (gb) * 8192 + u_ * 2048), 16, 0, 0); \
        __builtin_amdgcn_global_load_lds((const unsigned*)(kr_ + (size_t)8 * PITCH), (CW_LAS unsigned*)(kst + (gb) * 8192 + u_ * 2048 + 1024), 16, 0, 0); } } while (0)
#define IDX_COMP(gb, ktg) do { bf16x8 kf_[4][2];   \
        _Pragma("unroll") for (int u_ = 0; u_ < 4; ++u_) { kf_[u_][0] = *(const CW_LAS bf16x8*)(krd + (gb) * 8192 + u_ * 2048 + kp0); kf_[u_][1] = *(const CW_LAS bf16x8*)(krd + (gb) * 8192 + u_ * 2048 + kp1); } \
        _Pragma("unroll") for (int u_ = 0; u_ < 4; ++u_) { const int kk_ = (ktg) + u_; if (kk_ <= kt_end) { \
        f32x4 s8[8];   \
        _Pragma("unroll") for (int h = 0; h < 8; ++h) { s8[h] = (f32x4){0.f, 0.f, 0.f, 0.f}; s8[h] = __builtin_amdgcn_mfma_f32_16x16x32_bf16(kf_[u_][0], qf[h][0], s8[h], 0, 0, 0); } \
        _Pragma("unroll") for (int h = 0; h < 8; ++h) s8[h] = __builtin_amdgcn_mfma_f32_16x16x32_bf16(kf_[u_][1], qf[h][1], s8[h], 0, 0, 0); \
        f32x4 acc_ = {0.f, 0.f, 0.f, 0.f}; \
        _Pragma("unroll") for (int h = 0; h < 8; ++h) { _Pragma("unroll") for (int r = 0; r < 4; ++r) acc_[r] += w[h] * __builtin_amdgcn_fmed3f(s8[h][r], 0.f, INFINITY); } \
        if (do_store) *(u32x2*)(scores + (size_t)t * SEQ + 16 * kk_ + 4 * kq) = (u32x2){pkh(acc_[0], acc_[1]), pkh(acc_[2], acc_[3])}; else asm volatile("" :: "v"(acc_[0]), "v"(acc_[1]), "v"(acc_[2]), "v"(acc_[3])); } } } while (0)
    const int ng2 = (((kt_end - 16 * c) >> 2) + 2) & ~1, rot = rot_seed % ng2;
#define IDX_KT(gi) (16 * c + 4 * ((gi) + rot >= ng2 ? (gi) + rot - ng2 : (gi) + rot))
    IDX_STAGE(0, IDX_KT(0));
#pragma unroll 1
    for (int gi = 0; gi < ng2; gi += 2) {
        const int kta = IDX_KT(gi), ktb = IDX_KT(gi + 1), ktc = IDX_KT(gi + 2 < ng2 ? gi + 2 : gi);
        asm volatile("s_waitcnt lgkmcnt(0)" ::: "memory"); IDX_STAGE(1, ktb);
        asm volatile("s_waitcnt vmcnt(8)" ::: "memory"); IDX_COMP(0, kta);
        asm volatile("s_waitcnt lgkmcnt(0)" ::: "memory"); IDX_STAGE(0, ktc);
        asm volatile("s_waitcnt vmcnt(8)" ::: "memory"); IDX_COMP(1, ktb);
    }
    asm volatile("s_waitcnt vmcnt(0)" ::: "memory");
#undef IDX_KT
#undef IDX_STAGE
#undef IDX_COMP
}

__device__ __forceinline__ unsigned okey(float x) { unsigned u = __float_as_uint(x); if ((u << 1) == 0u) u = 0u; return (u & 0x80000000u) ? ~u : (u | 0x80000000u); }
template <int NB>
__device__ __forceinline__ int select_bin(CW_LAS unsigned* hist, int& k, int lane) {
    constexpr int PER = NB / 64;
    unsigned tot = 0;
#pragma unroll
    for (int i = 0; i < PER; i += 4) { const u32x4 hv = *(CW_LAS u32x4*)(hist + lane * PER + i); tot += (hv.x + hv.y) + (hv.z + hv.w); }
    unsigned incl = tot;
#pragma unroll
    for (int off = 1; off < 64; off <<= 1) { const unsigned tt = __shfl_down(incl, off); if (lane + off < 64) incl += tt; }
    const unsigned excl = incl - tot;
    const bool mine = (excl < (unsigned)k) && ((unsigned)k <= incl);
    int b = 0, kk = 0;
    if (mine) {
        unsigned cacc = excl;
        for (int i = PER - 1; i >= 0; --i) { const unsigned hc = hist[lane * PER + i]; if (cacc + hc >= (unsigned)k) { b = lane * PER + i; kk = k - (int)cacc; break; } cacc += hc; }
    }
    const unsigned long long mk = __ballot(mine);
    const int src = mk ? __builtin_ctzll(mk) : 0;
    b = __shfl(b, src); kk = __shfl(kk, src);
    k = kk;
    return b;
}
__device__ __forceinline__ unsigned okey16(unsigned h) { if ((h & 0x7fffu) == 0u) h = 0u; return (h & 0x8000u) ? (~h & 0xffffu) : (h | 0x8000u); }
__device__ __forceinline__ unsigned okey16x2(unsigned w) { typedef _Float16 h2_ __attribute__((ext_vector_type(2))); typedef short s2_ __attribute__((ext_vector_type(2)));
    const h2_ h = __builtin_bit_cast(h2_, w) + (h2_){(_Float16)0.0f, (_Float16)0.0f}; const s2_ sg = __builtin_bit_cast(s2_, h) >> 15; return __builtin_bit_cast(unsigned, h) ^ (__builtin_bit_cast(unsigned, sg) | 0x80008000u); }
__device__ __forceinline__ void dsa_select(const u16* scores, u16* sel, int t, CW_LAS unsigned char* ws_lds, int lane_in) {
    int lane = lane_in; asm volatile("" : "+v"(lane));
    CW_LAS unsigned* hist = (CW_LAS unsigned*)ws_lds;
    CW_LAS int* idxl = (CW_LAS int*)(ws_lds + 8192);
    const u16* srow = scores + (size_t)t * SEQ;
    const int n = t + 1;
    if (n <= 256) {
        for (int i = lane; i < 256; i += 64) idxl[i] = (i < n) ? i : 0;
    } else {
        int k = 256; unsigned b1s = 0, b2s = 0;
        const int nq = (n + 511) >> 9;
#define DSA_ELT(vvj, x) (((x) & 1) ? ((vvj)[(x) >> 1] >> 16) : ((vvj)[(x) >> 1] & 0xffffu))
#define DSA_PASS(COND, BIN) do { for (int j0 = 0; j0 < nq; j0 += 8) { u32x4 vv[8]; \
            _Pragma("unroll") for (int jj = 0; jj < 8; ++jj) { const int j = (j0 + jj < nq) ? j0 + jj : nq - 1; vv[jj] = *(const u32x4*)(srow + 512 * j + 8 * lane); } \
            _Pragma("unroll") for (int jj = 0; jj < 8; ++jj) { const unsigned kw_[4] = {okey16x2(vv[jj].x), okey16x2(vv[jj].y), okey16x2(vv[jj].z), okey16x2(vv[jj].w)}; _Pragma("unroll") for (int x = 0; x < 8; ++x) { const int i = 512 * (j0 + jj) + 8 * lane + x; const unsigned u = DSA_ELT(kw_, x); \
                const bool c_ = (j0 + jj < nq) && (i < n) && (COND);   \
                if (c_) __hip_atomic_fetch_add(hist + (BIN), 1u, __ATOMIC_RELAXED, __HIP_MEMORY_SCOPE_WAVEFRONT); } } } } while (0)
        for (int rp_ = 0; rp_ < ((DUPSUB & 16) ? 2 : 1); ++rp_) { k = 256;
        for (int i = lane; i < 256; i += 64) hist[i] = 0u;
        asm volatile("s_waitcnt lgkmcnt(0)" ::: "memory");
        DSA_PASS(true, u >> 8);
        asm volatile("s_waitcnt lgkmcnt(0)" ::: "memory");
        const unsigned b1 = (unsigned)select_bin<256>(hist, k, lane);
        asm volatile("s_waitcnt lgkmcnt(0)" ::: "memory");
        for (int i = lane; i < 256; i += 64) hist[i] = 0u;
        asm volatile("s_waitcnt lgkmcnt(0)" ::: "memory");
        DSA_PASS((u >> 8) == b1, u & 255u);
        asm volatile("s_waitcnt lgkmcnt(0)" ::: "memory");
        const unsigned b2 = (unsigned)select_bin<256>(hist, k, lane);
        asm volatile("s_waitcnt lgkmcnt(0)" ::: "memory");
        b1s = b1; b2s = b2; }
#undef DSA_PASS
        const unsigned T = (b1s << 8) | b2s; const int need_eq = k, cnt_gt = 256 - k;
        int cg = 0, ce = 0;
        const unsigned long long lt_mask = (1ull << lane) - 1ull;
        for (int j0 = 0; j0 < nq; j0 += 4) {
            u32x4 vv[4];
#pragma unroll
            for (int jj = 0; jj < 4; ++jj) { const int j = (j0 + jj < nq) ? j0 + jj : nq - 1; vv[jj] = *(const u32x4*)(srow + 512 * j + 8 * lane); }
#pragma unroll
            for (int jj = 0; jj < 4; ++jj) {
                if (j0 + jj < nq) {
                    bool g[8], e[8]; int pg = 0, pe = 0, tg = 0, te = 0; const unsigned kw_[4] = {okey16x2(vv[jj].x), okey16x2(vv[jj].y), okey16x2(vv[jj].z), okey16x2(vv[jj].w)};
#pragma unroll
                    for (int x = 0; x < 8; ++x) { const int i = 512 * (j0 + jj) + 8 * lane + x; const bool v = i < n; const unsigned u = DSA_ELT(kw_, x); g[x] = v && (u > T); e[x] = v && (u == T);
                        const unsigned long long mg = __ballot(g[x]), me = __ballot(e[x]);
                        pg += __builtin_popcountll(mg & lt_mask); pe += __builtin_popcountll(me & lt_mask); tg += __builtin_popcountll(mg); te += __builtin_popcountll(me); }
                    int og = cg + pg, oe = ce + pe;
#pragma unroll
                    for (int x = 0; x < 8; ++x) { const int i = 512 * (j0 + jj) + 8 * lane + x;
                        const bool wg = g[x] && (og < cnt_gt), we = e[x] && (oe < need_eq);
                        if (wg || we) idxl[wg ? og : cnt_gt + oe] = i;
                        og += g[x] ? 1 : 0; oe += e[x] ? 1 : 0; }
                    cg += tg; ce += te;
                }
            }
        }
#undef DSA_ELT
    }
    asm volatile("s_waitcnt lgkmcnt(0)" ::: "memory");
    { const int a0 = idxl[4 * lane], a1 = idxl[4 * lane + 1], a2 = idxl[4 * lane + 2], a3 = idxl[4 * lane + 3];
      *(u32x2*)(sel + (size_t)t * 256 + 4 * lane) = (u32x2){(unsigned)a0 | ((unsigned)a1 << 16), (unsigned)a2 | ((unsigned)a3 << 16)}; }
    asm volatile("s_waitcnt lgkmcnt(0)" ::: "memory");
}
__device__ __forceinline__ void dsa_attend(const u16* proj, const u16* sel, u16* mixed, int t, CW_LAS unsigned char* bst, CW_LAS u16* idx16, int lane_in) {
    int lane = lane_in; asm volatile("" : "+v"(lane));
    const int nsel = (t + 1 < 256) ? t + 1 : 256, ntiles = (nsel + 31) >> 5;
    asm volatile("s_waitcnt lgkmcnt(0)" ::: "memory");
    *(CW_LAS u32x2*)(idx16 + 4 * lane) = *(const u32x2*)(sel + (size_t)t * 256 + 4 * lane);
    const int r32 = lane & 31, hi = lane >> 5;
    const u16* qrow = proj + (size_t)t * PITCH + DQ + (r32 & 7) * 64 + 8 * hi;
    bf16x8 qf[4];
#pragma unroll
    for (int d0 = 0; d0 < 4; ++d0) qf[d0] = ld8(qrow + 16 * d0);
    asm volatile("s_waitcnt lgkmcnt(0)" ::: "memory");
    BState st; bstate_init(st);
    band_accum<true>(st, qf, proj + DK, proj + DV, 0, 1, 0, 0, ntiles, nsel, lane, bst, idx16);
    if (r32 < 8) bstate_store(st, KD / st.l, mixed + (size_t)t * DMODEL + 1536 + r32 * 64, hi);
}

__device__ __forceinline__ void diff_combine_row(const u16* OB, u16* mixed, const float* sub_g, float lam, float lam_init, int t, int lane) {
    const u16* orow = OB + (size_t)t * 1024;
#pragma unroll
    for (int h = 0; h < 4; ++h) {
        const float a0 = bf2f(orow[(h * 4 + 0) * 64 + lane]), a1 = bf2f(orow[(h * 4 + 1) * 64 + lane]);
        const float b0 = bf2f(orow[(h * 4 + 2) * 64 + lane]), b1 = bf2f(orow[(h * 4 + 3) * 64 + lane]);
        const float d0 = a0 - lam * b0, d1 = a1 - lam * b1;
        const float ms = wave_sum(d0 * d0 + d1 * d1) * (1.0f / 128.0f);
        const float rs = KB * (1.0f / sqrtf(ms + 1e-5f)) * (1.0f - lam_init);
        u16* mrow = mixed + (size_t)t * DMODEL + 512 + h * 128;
        mrow[lane] = (u16)f2bf(d0 * rs * sub_g[lane]); mrow[64 + lane] = (u16)f2bf(d1 * rs * sub_g[64 + lane]);
    }
}

typedef float f32x2 __attribute__((ext_vector_type(2)));
typedef int i32x8 __attribute__((ext_vector_type(8)));
constexpr float X8_SCALE = 8.0f; constexpr size_t XLO_OFF = (size_t)16 << 20;
template <bool INB = false>
__device__ __forceinline__ void ln_row(const void* in_, float alpha, const u16* zs, int t, float* outf, u16* outb, unsigned char* xs8, const float* g, const float* b, int lane) {
    f32x4 v[8]; float s = 0.f;
#pragma unroll
    for (int j = 0; j < 8; ++j) {
        if constexpr (INB) { const u32x2 iw = *(const u32x2*)((const u16*)in_ + 256 * j + 4 * lane); v[j] = (f32x4){bf2f(iw.x & 0xffffu), bf2f(iw.x >> 16), bf2f(iw.y & 0xffffu), bf2f(iw.y >> 16)} * alpha; }
        else v[j] = *(const f32x4*)((const float*)in_ + 256 * j + 4 * lane) * alpha;
        if (zs) { const u32x2 zw = *(const u32x2*)(zs + ((size_t)(2 * j + (lane >> 5)) * SEQ + t) * 128 + ((4 * lane) & 127)); v[j] = v[j] + (f32x4){bf2f(zw.x & 0xffffu), bf2f(zw.x >> 16), bf2f(zw.y & 0xffffu), bf2f(zw.y >> 16)}; }
        s += (v[j].x + v[j].y) + (v[j].z + v[j].w); }
    const float mean = wave_sum(s) * (1.0f / 2048.0f); float s2 = 0.f;
#pragma unroll
    for (int j = 0; j < 8; ++j) { v[j] = v[j] - mean; s2 += (v[j].x * v[j].x + v[j].y * v[j].y) + (v[j].z * v[j].z + v[j].w * v[j].w); }
    const float rstd = 1.0f / sqrtf(wave_sum(s2) * (1.0f / 2048.0f) + 1e-5f);
#pragma unroll
    for (int j = 0; j < 8; ++j) {
        const f32x4 gg = *(const f32x4*)(g + 256 * j + 4 * lane), bb = *(const f32x4*)(b + 256 * j + 4 * lane);
        const f32x4 y = v[j] * rstd * gg + bb;
        if (outf) *(f32x4*)(outf + 256 * j + 4 * lane) = y;
        if (outb) { u32x2 w; w.x = pk2(y.x, y.y); w.y = pk2(y.z, y.w); *(u32x2*)(outb + 256 * j + 4 * lane) = w;
            if (xs8) {
                const f32x4 ys = {__builtin_amdgcn_fmed3f(y.x * X8_SCALE, -448.f, 448.f), __builtin_amdgcn_fmed3f(y.y * X8_SCALE, -448.f, 448.f), __builtin_amdgcn_fmed3f(y.z * X8_SCALE, -448.f, 448.f), __builtin_amdgcn_fmed3f(y.w * X8_SCALE, -448.f, 448.f)};
                int hw = __builtin_amdgcn_cvt_pk_fp8_f32(ys.x, ys.y, 0, false); hw = __builtin_amdgcn_cvt_pk_fp8_f32(ys.z, ys.w, hw, true);
                const f32x2 h0 = __builtin_amdgcn_cvt_pk_f32_fp8(hw, false), h1 = __builtin_amdgcn_cvt_pk_f32_fp8(hw, true);
                int lw = __builtin_amdgcn_cvt_pk_fp8_f32((ys.x - h0.x) * 16.f, (ys.y - h0.y) * 16.f, 0, false); lw = __builtin_amdgcn_cvt_pk_fp8_f32((ys.z - h1.x) * 16.f, (ys.w - h1.y) * 16.f, lw, true);
                unsigned char* xo = xs8 + ((size_t)(2 * j + (lane >> 5)) * SEQ + t) * 128 + ((4 * lane) & 127);
                *(int*)xo = hw; *(int*)(xo + XLO_OFF) = lw; } }
    }
}

__device__ __forceinline__ void ins16(unsigned (&a)[16], unsigned e) {
#pragma unroll
    for (int i = 0; i < 16; ++i) { const unsigned hi_ = a[i] > e ? a[i] : e; e = a[i] > e ? e : a[i]; a[i] = hi_; }
}
__device__ __forceinline__ float key2val(unsigned k) { const unsigned u = (k & 0x80000000u) ? (k ^ 0x80000000u) : ~k; return __uint_as_float(u & ~127u); }
__device__ __forceinline__ void peer_topk_item(const u16* qp, const u16* keysb, u16* eidx, u16* eidxT, float* gate, int tt, int h, CW_LAS unsigned* cand, int lane) {
    const int r32 = lane & 31, hi = lane >> 5, t = 32 * tt + r32;
    unsigned top[2][16];
#pragma unroll
    for (int p = 0; p < 2; ++p) {
        const int hp = h * 2 + p;
        const u16* qrow = qp + (size_t)t * DMODEL + hp * 128 + 8 * hi;
        bf16x8 qb[8];
#pragma unroll
        for (int s = 0; s < 8; ++s) qb[s] = ld8(qrow + 16 * s);
#pragma unroll
        for (int i = 0; i < 16; ++i) top[p][i] = 0u;
#pragma unroll
        for (int nt = 0; nt < 4; ++nt) {
            const u16* krow = keysb + ((size_t)hp * 128 + 32 * nt + r32) * 128 + 8 * hi;
            f32x16 s16 = {0.f, 0.f, 0.f, 0.f, 0.f, 0.f, 0.f, 0.f, 0.f, 0.f, 0.f, 0.f, 0.f, 0.f, 0.f, 0.f};
#pragma unroll
            for (int s = 0; s < 8; ++s) s16 = __builtin_amdgcn_mfma_f32_32x32x16_bf16(ld8(krow + 16 * s), qb[s], s16, 0, 0, 0);
#pragma unroll
            for (int r = 0; r < 16; ++r) { const unsigned n = (unsigned)(32 * nt + crow(r, hi)); const unsigned u = __float_as_uint(s16[r]); const unsigned k = (u & 0x80000000u) ? ~u : (u | 0x80000000u); ins16(top[p], (k & ~127u) | n); }
        }
        unsigned oth[16];
#pragma unroll
        for (int i = 0; i < 16; ++i) oth[i] = __shfl_xor(top[p][i], 32);
#pragma unroll
        for (int i = 0; i < 16; ++i) ins16(top[p], oth[i]);
    }
    float v1[16], v2[16];
#pragma unroll
    for (int i = 0; i < 16; ++i) { v1[i] = key2val(top[0][i]); v2[i] = key2val(top[1][i]); }
    unsigned best[16];
#pragma unroll
    for (int i = 0; i < 16; ++i) best[i] = 0u;
    {
        int cnum = 0;
#pragma unroll
        for (int a = 0; a < 16; ++a)
#pragma unroll
            for (int b = 0; b < 16; ++b) {
                if ((a + 1) * (b + 1) > 16) continue;
                const float ev = v1[a] + v2[b]; const unsigned u = __float_as_uint(ev); const unsigned k = (u & 0x80000000u) ? ~u : (u | 0x80000000u);
                cand[cnum * 64 + lane] = ((top[0][a] & 127u) << 7) | (top[1][b] & 127u);
                ins16(best, (k & ~63u) | (unsigned)cnum);
                ++cnum;
            }
    }
    asm volatile("s_waitcnt lgkmcnt(0)" ::: "memory");
    float cv[16]; unsigned ci[16];
#pragma unroll
    for (int i = 0; i < 16; ++i) { const unsigned k = best[i]; const unsigned u = (k & 0x80000000u) ? (k ^ 0x80000000u) : ~k; cv[i] = __uint_as_float(u & ~63u); ci[i] = cand[(k & 63u) * 64 + lane]; }
    float den = 0.f; const float cmax = cv[0];
#pragma unroll
    for (int i = 0; i < 16; ++i) { cv[i] = ex2((cv[i] - cmax) * LOG2E); den += cv[i]; }
    const float inv = 1.0f / den;
    if (hi == 0) {
        u16* ep = eidx + (size_t)t * 128 + h * 16; float* gp = gate + (size_t)t * 128 + h * 16;
        *(u32x4*)(ep) = (u32x4){ci[0] | (ci[1] << 16), ci[2] | (ci[3] << 16), ci[4] | (ci[5] << 16), ci[6] | (ci[7] << 16)};
        *(u32x4*)(ep + 8) = (u32x4){ci[8] | (ci[9] << 16), ci[10] | (ci[11] << 16), ci[12] | (ci[13] << 16), ci[14] | (ci[15] << 16)};
        { u16* et = eidxT + (size_t)t * 128 + h;
#pragma unroll
          for (int i = 0; i < 16; ++i) et[8 * i] = (u16)ci[i]; }
#pragma unroll
        for (int i = 0; i < 16; i += 4) *(f32x4*)(gp + i) = (f32x4){cv[i] * inv, cv[i + 1] * inv, cv[i + 2] * inv, cv[i + 3] * inv};
    }
    asm volatile("s_waitcnt lgkmcnt(0)" ::: "memory");
}

__device__ __forceinline__ float fdot2(unsigned a, unsigned b, float c) { return __builtin_amdgcn_fdot2_f32_bf16(__builtin_bit_cast(bf16x2_t, a), __builtin_bit_cast(bf16x2_t, b), c, false); }

constexpr float U_SCALE = 512.0f, V_SCALE = 64.0f;
template <int CTRL> __device__ __forceinline__ float dpp_f(float x) { return __builtin_bit_cast(float, __builtin_amdgcn_mov_dpp(__builtin_bit_cast(int, x), CTRL, 0xf, 0xf, true)); }
#define PEER_LOADE(ev, tt) do { const u32x4 w0_ = *(const u32x4*)(eidx + (size_t)(tt) * 128 + 16 * p), w1_ = *(const u32x4*)(eidx + (size_t)(tt) * 128 + 16 * p + 8); \
        ev[0] = w0_.x; ev[1] = w0_.y; ev[2] = w0_.z; ev[3] = w0_.w; ev[4] = w1_.x; ev[5] = w1_.y; ev[6] = w1_.z; ev[7] = w1_.w; } while (0)
#define PEER_EID(ev, g) (((g) & 1) ? (ev[(g) >> 1] >> 16) : (ev[(g) >> 1] & 0xffffu))
#define PEER_ROWS8(rv, ev, col, H) do { _Pragma("unroll") for (int g_ = 0; g_ < 8; ++g_) rv[g_] = *(const u32x4*)((const char*)(col) + (PEER_EID(ev, 8 * (H) + g_) * 128u + loff)); } while (0)
#define FP8_LO(w) __builtin_amdgcn_cvt_pk_f32_fp8((int)(w), false)
#define FP8_HI(w) __builtin_amdgcn_cvt_pk_f32_fp8((int)(w), true)
__device__ __forceinline__ void peer_dot_slice(const unsigned char* xs8, const unsigned char* ub8, const u16* eidxT, u16* ph, int t0, int tstep, int s, int lane) {
    const int j = lane & 15, kg = lane >> 4, rho = 4 * kg + (j >> 2), pi = j & 3;
    const unsigned char* ucol = ub8 + (size_t)s * (16384 * 128); const unsigned loff = 16u * (unsigned)pi;
    const __amdgpu_buffer_rsrc_t xr = __builtin_amdgcn_make_buffer_rsrc((void*)(xs8 + (size_t)s * SEQ * 128), (short)0, 0x2000000, 0x00020000);
    const unsigned xoff = (kg == (j >> 2)) ? 16u * (unsigned)pi : 0x7fff0000u;
    u16* ocol = ph + (size_t)s * SEQ * 128 + 16 * pi + rho;
    const int n = (SEQ - t0 + tstep - 1) / tstep;
    const int SC_ONE = 0x7f7f7f7f, SC_16TH = 0x7b7b7b7b;
    const bool p1 = (pi & 1) != 0, p2 = (pi & 2) != 0;
#define TOK(k) (t0 + ((k) < n ? (k) : n - 1) * tstep)
    u32x4 e0, e1, e2, e3; i32x8 r0[4], r1[4], r2[4], r3[4], xhA, xlA, xhB, xlB;
#define PD_LOADE(ev, tt) ev = *(const u32x4*)(eidxT + (size_t)(tt) * 128 + 8 * rho)
#define PD_EID(ev, p_) (((p_) & 1) ? (ev[(p_) >> 1] >> 16) : (ev[(p_) >> 1] & 0xffffu))
#define PD_ROWS4(rv, ev, H) do { _Pragma("unroll") for (int q_ = 0; q_ < 4; ++q_) { const unsigned o_ = PD_EID(ev, 4 * (H) + q_) * 128u + loff; \
            const u32x4 a_ = *(const u32x4*)(ucol + o_), b_ = *(const u32x4*)(ucol + o_ + 64); rv[q_] = (i32x8){(int)a_.x, (int)a_.y, (int)a_.z, (int)a_.w, (int)b_.x, (int)b_.y, (int)b_.z, (int)b_.w}; } } while (0)
#define PD_LOADX(xh, xl, tt) do { const unsigned o_ = xoff + 128u * (unsigned)(tt); \
            const u32x4 a_ = __builtin_amdgcn_raw_buffer_load_b128(xr, o_, 0, 0), b_ = __builtin_amdgcn_raw_buffer_load_b128(xr, o_ + 64u, 0, 0), \
                        c_ = __builtin_amdgcn_raw_buffer_load_b128(xr, o_, (int)XLO_OFF, 0), d_ = __builtin_amdgcn_raw_buffer_load_b128(xr, o_ + 64u, (int)XLO_OFF, 0); \
            xh = (i32x8){(int)a_.x, (int)a_.y, (int)a_.z, (int)a_.w, (int)b_.x, (int)b_.y, (int)b_.z, (int)b_.w}; xl = (i32x8){(int)c_.x, (int)c_.y, (int)c_.z, (int)c_.w, (int)d_.x, (int)d_.y, (int)d_.z, (int)d_.w}; } while (0)
#define PD_COMP4(rv, xh, xl, kk) do { f32x4 a_[4]; float u_[4]; \
            _Pragma("unroll") for (int q_ = 0; q_ < 4; ++q_) a_[q_] = __builtin_amdgcn_mfma_scale_f32_16x16x128_f8f6f4(xh, rv[q_], (f32x4){0.f, 0.f, 0.f, 0.f}, 0, 0, 0, SC_ONE, 0, SC_ONE); \
            _Pragma("unroll") for (int q_ = 0; q_ < 4; ++q_) a_[q_] = __builtin_amdgcn_mfma_scale_f32_16x16x128_f8f6f4(xl, rv[q_], a_[q_], 0, 0, 0, SC_16TH, 0, SC_ONE); \
            _Pragma("unroll") for (int q_ = 0; q_ < 4; ++q_) { const float lo_ = p1 ? a_[q_][1] : a_[q_][0], hi_ = p1 ? a_[q_][3] : a_[q_][2]; float v_ = p2 ? hi_ : lo_; v_ += dpp_f<0xB1>(v_); v_ += dpp_f<0x4E>(v_); u_[q_] = v_; } \
            { const float lo_ = p1 ? u_[1] : u_[0], hi_ = p1 ? u_[3] : u_[2]; kk = p2 ? hi_ : lo_; } } while (0)
#define PD_ITEM(rA, rB, eS, eN, xh, xl, k) do { const int tt_ = TOK(k); float k0_, k1_; \
        PD_COMP4(rA, xh, xl, k0_); __builtin_amdgcn_sched_barrier(0); PD_ROWS4(rA, eN, 0); __builtin_amdgcn_sched_barrier(0); \
        PD_COMP4(rB, xh, xl, k1_); __builtin_amdgcn_sched_barrier(0); PD_ROWS4(rB, eN, 1); __builtin_amdgcn_sched_barrier(0); \
        PD_LOADX(xh, xl, TOK((k) + 2)); \
        u16* o_ = ocol + (size_t)tt_ * 128; o_[0] = (u16)f2bf(k0_ * (1.0f / (U_SCALE * X8_SCALE))); o_[64] = (u16)f2bf(k1_ * (1.0f / (U_SCALE * X8_SCALE))); \
        PD_LOADE(eS, TOK((k) + 4)); __builtin_amdgcn_sched_barrier(0); } while (0)
    PD_LOADE(e0, TOK(0)); PD_LOADE(e1, TOK(1)); PD_LOADE(e2, TOK(2)); PD_LOADE(e3, TOK(3)); PD_LOADX(xhA, xlA, TOK(0)); PD_LOADX(xhB, xlB, TOK(1)); __builtin_amdgcn_sched_barrier(0);
    PD_ROWS4(r0, e0, 0); __builtin_amdgcn_sched_barrier(0); PD_ROWS4(r1, e0, 1); __builtin_amdgcn_sched_barrier(0); PD_ROWS4(r2, e1, 0); __builtin_amdgcn_sched_barrier(0); PD_ROWS4(r3, e1, 1); __builtin_amdgcn_sched_barrier(0);
#pragma unroll 1
    for (int i = 0; i < n; i += 4) {
        PD_ITEM(r0, r1, e0, e2, xhA, xlA, i);
        PD_ITEM(r2, r3, e1, e3, xhB, xlB, i + 1);
        PD_ITEM(r0, r1, e2, e0, xhA, xlA, i + 2);
        PD_ITEM(r2, r3, e3, e1, xhB, xlB, i + 3);
    }
#undef PD_ITEM
#undef PD_COMP4
#undef PD_LOADX
#undef PD_ROWS4
#undef PD_EID
#undef PD_LOADE
#undef TOK
}
__device__ __forceinline__ void peer_act_row(const u16* ph, const float* gate, float* aw, int t, int lane) {
    float h0 = 0.f, h1 = 0.f;
#pragma unroll 8
    for (int s = 0; s < 16; ++s) { const u16* r = ph + ((size_t)s * SEQ + t) * 128; h0 += bf2f(r[lane]); h1 += bf2f(r[64 + lane]); }
    const float g0 = gate[(size_t)t * 128 + lane], g1 = gate[(size_t)t * 128 + 64 + lane];
    aw[(size_t)t * 128 + lane] = KP * g0 * 0.5f * h0 * (1.0f + erff(h0 * 0.70710678118654752f));
    aw[(size_t)t * 128 + 64 + lane] = KP * g1 * 0.5f * h1 * (1.0f + erff(h1 * 0.70710678118654752f));
}
__device__ __forceinline__ void peer_axpy_slice(const unsigned char* vb8, const u16* eidx, const float* aw, u16* zs, int t0, int tstep, int s, int lane) {
    const int p = lane >> 3, sub = lane & 7;
    const unsigned char* vcol = vb8 + (size_t)s * (16384 * 128); const unsigned loff = 16u * (unsigned)sub;
    const __amdgpu_buffer_rsrc_t zr = __builtin_amdgcn_make_buffer_rsrc((void*)(zs + (size_t)s * SEQ * 128), (short)0, SEQ * 128 * 2, 0x00020000);
    const unsigned zoff = 32u * (unsigned)sub + 4u * (unsigned)p;
    const int n = (SEQ - t0 + tstep - 1) / tstep;
#define TOK(k) (t0 + ((k) < n ? (k) : n - 1) * tstep)
    unsigned e0[8], e1[8], e2[8], e3[8]; u32x4 r0[8], r1[8], r2[8], r3[8]; f32x4 avA[4], avB[4];
#define PA_LOADA(av, tt) do { _Pragma("unroll") for (int q_ = 0; q_ < 4; ++q_) av[q_] = *(const f32x4*)(aw + (size_t)(tt) * 128 + 16 * p + 4 * q_); } while (0)
#define PA_COMP8(vv, av, H) do { _Pragma("unroll") for (int g_ = 0; g_ < 8; ++g_) { const float a1_ = av[2 * (H) + (g_ >> 2)][g_ & 3]; const f32x2 a_ = {a1_, a1_}; \
            _Pragma("unroll") for (int w_ = 0; w_ < 4; ++w_) { acc[2 * w_] = __builtin_elementwise_fma(a_, FP8_LO(vv[g_][w_]), acc[2 * w_]); acc[2 * w_ + 1] = __builtin_elementwise_fma(a_, FP8_HI(vv[g_][w_]), acc[2 * w_ + 1]); } \
            if (g_ & 1) asm volatile("" : "+v"(acc[0]), "+v"(acc[1]), "+v"(acc[2]), "+v"(acc[3]), "+v"(acc[4]), "+v"(acc[5]), "+v"(acc[6]), "+v"(acc[7]));   } } while (0)
#define PA_ITEM(rA, rB, eS, eN, avS, k) do { const int tt_ = TOK(k); f32x2 acc[8]; _Pragma("unroll") for (int i_ = 0; i_ < 8; ++i_) acc[i_] = (f32x2){0.f, 0.f}; \
        PA_COMP8(rA, avS, 0); __builtin_amdgcn_sched_barrier(0); PEER_ROWS8(rA, eN, vcol, 0); __builtin_amdgcn_sched_barrier(0); \
        PA_COMP8(rB, avS, 1); __builtin_amdgcn_sched_barrier(0); PEER_ROWS8(rB, eN, vcol, 1); __builtin_amdgcn_sched_barrier(0); \
        PA_LOADA(avS, TOK((k) + 2)); \
          \
          \
        float w_[8], x_[4]; \
        _Pragma("unroll") for (int i_ = 0; i_ < 8; ++i_) { const auto rr_ = __builtin_amdgcn_permlane32_swap(__float_as_uint(acc[i_ >> 1][i_ & 1]), __float_as_uint(acc[(i_ + 8) >> 1][i_ & 1]), false, false); w_[i_] = __uint_as_float(rr_[0]) + __uint_as_float(rr_[1]); } \
        _Pragma("unroll") for (int i_ = 0; i_ < 4; ++i_) { const auto rr_ = __builtin_amdgcn_permlane16_swap(__float_as_uint(w_[i_]), __float_as_uint(w_[i_ + 4]), false, false); x_[i_] = __uint_as_float(rr_[0]) + __uint_as_float(rr_[1]); } \
        _Pragma("unroll") for (int i_ = 0; i_ < 4; ++i_) x_[i_] += dpp_f<0x128>(x_[i_]); \
        { const bool b3_ = (p & 1) != 0; const float lo_ = b3_ ? x_[2] : x_[0], hi_ = b3_ ? x_[3] : x_[1]; \
          __builtin_amdgcn_raw_buffer_store_b32(pk2(lo_ * (1.0f / V_SCALE), hi_ * (1.0f / V_SCALE)), zr, zoff + 256u * (unsigned)tt_, 0, 0); } \
        PEER_LOADE(eS, TOK((k) + 4)); __builtin_amdgcn_sched_barrier(0); } while (0)
    PEER_LOADE(e0, TOK(0)); PEER_LOADE(e1, TOK(1)); PEER_LOADE(e2, TOK(2)); PEER_LOADE(e3, TOK(3)); PA_LOADA(avA, TOK(0)); PA_LOADA(avB, TOK(1)); __builtin_amdgcn_sched_barrier(0);
    PEER_ROWS8(r0, e0, vcol, 0); __builtin_amdgcn_sched_barrier(0); PEER_ROWS8(r1, e0, vcol, 1); __builtin_amdgcn_sched_barrier(0); PEER_ROWS8(r2, e1, vcol, 0); __builtin_amdgcn_sched_barrier(0); PEER_ROWS8(r3, e1, vcol, 1); __builtin_amdgcn_sched_barrier(0);
#pragma unroll 1
    for (int i = 0; i < n; i += 4) {
        PA_ITEM(r0, r1, e0, e2, avA, i);
        PA_ITEM(r2, r3, e1, e3, avB, i + 1);
        PA_ITEM(r0, r1, e2, e0, avA, i + 2);
        PA_ITEM(r2, r3, e3, e1, avB, i + 3);
    }
#undef PA_ITEM
#undef PA_COMP8
#undef PA_LOADA
#undef TOK
}
#undef PEER_LOADE
#undef PEER_EID
#undef PEER_ROWS8
#undef FP8_LO
#undef FP8_HI
}

constexpr int NWAVES = 8;
constexpr int T = 8192, D = 2048, NIN = 5064, NINP = 5120, NEXP = 16384, DEPTH = 2;
constexpr float LN_EPS = 1e-5f;
constexpr float ALPHA = 1.4142135623730951f;
constexpr size_t MiB = 1u << 20;
constexpr size_t WS_CTL = 0, CTL_ZERO_BYTES = 1 * MiB;
constexpr size_t WS_ROPE = 1 * MiB;
constexpr size_t WS_KEYSB = 3 * MiB;
constexpr size_t WS_WINT = 4 * MiB;
constexpr size_t WS_WOUTT = 44 * MiB;
constexpr size_t WS_WQT = 60 * MiB;
constexpr size_t WS_UB = 76 * MiB;
constexpr size_t WS_VB = 204 * MiB;
constexpr size_t WS_XB = 332 * MiB;
constexpr size_t WS_PROJ = 364 * MiB;
constexpr size_t WS_OB = 450 * MiB;
constexpr size_t WS_MIXED = 466 * MiB;
constexpr size_t WS_X2 = 498 * MiB;
constexpr size_t WS_SCORES = 562 * MiB;
constexpr size_t WS_Z = WS_SCORES;
constexpr size_t WS_X1B = WS_SCORES + 64 * MiB;
constexpr size_t WS_QPEER = WS_SCORES + 96 * MiB;
constexpr size_t WS_EIDX = WS_SCORES + 128 * MiB;
constexpr size_t WS_GATE = WS_SCORES + 132 * MiB;
constexpr size_t WS_AACT = WS_SCORES + 136 * MiB;
constexpr size_t WS_XS = WS_SCORES + 140 * MiB;
constexpr size_t WS_ZS = WS_SCORES + 172 * MiB;
constexpr size_t WS_SEL = 818 * MiB;
constexpr size_t WS_END = 822 * MiB;
constexpr int CW_TMO = 0, CW_CODE = 1, CW_BAR = 4096;
constexpr int RING_OFF = 0, RING_BYTES = 131072;
constexpr int LDSCTL_OFF = RING_BYTES, MISC_OFF = LDSCTL_OFF + 320;
constexpr int LDS_BYTES = 147456;
#ifndef DUP
#define DUP -1
#endif
constexpr int NSUB = 12;
constexpr int NPH = 1 + (NSUB + ((DUP >= 0) ? 1 : 0)) * DEPTH;
#ifndef DUP
#define DUP -1
#endif
#ifndef CHECK
#define CHECK 0
#endif
#ifndef EXTRA_BAR
#define EXTRA_BAR 0
#endif
#ifndef DUPSUB
#define DUPSUB 0
#endif
#ifndef SUBM
#define SUBM 15
#endif
#ifndef PHM
#define PHM 511
#endif
#ifndef MK_ONE_LAUNCH
#define MK_ONE_LAUNCH 1
#endif

__device__ __forceinline__ void p0_tables_layer(const float* pu, const float* pv, unsigned char* u8, unsigned char* v8, int L, long gthr, long NGT) {
    constexpr long N4L = (long)NEXP * D / 4; const long base = (long)L * N4L;
    for (long i0 = gthr; i0 < N4L; i0 += 8 * NGT) {
        f32x4 au[8], av[8];
#pragma unroll
        for (int u = 0; u < 8; ++u) { long g = i0 + u * NGT; g = g < N4L ? g : N4L - 1; au[u] = *(const f32x4*)(pu + 4 * (base + g)); av[u] = *(const f32x4*)(pv + 4 * (base + g)); }
#pragma unroll
        for (int u = 0; u < 8; ++u) { const long g = i0 + u * NGT; if (g < N4L) {
            const int dg4 = (int)(g & 511); const int e = (int)(g >> 9);
            const size_t dst = (size_t)L * NEXP * D + ((size_t)(dg4 >> 5) * NEXP + e) * 128 + (dg4 & 31) * 4;
            { const f32x4 a = au[u] * cw::U_SCALE; int w = __builtin_amdgcn_cvt_pk_fp8_f32(a.x, a.y, 0, false); w = __builtin_amdgcn_cvt_pk_fp8_f32(a.z, a.w, w, true); *(GAS unsigned*)(u8 + dst) = (unsigned)w; }
            { const f32x4 a = av[u] * cw::V_SCALE; int w = __builtin_amdgcn_cvt_pk_fp8_f32(a.x, a.y, 0, false); w = __builtin_amdgcn_cvt_pk_fp8_f32(a.z, a.w, w, true); *(GAS unsigned*)(v8 + dst) = (unsigned)w; } } }
    }
}
__device__ __forceinline__ void p0_transpose_item(const float* W, int K, int N, bf16* WT, LAS float* scr, int item, int lane, bool permute) {
    const int nblk = N / 32, kb = item / nblk, nb = item % nblk, k0 = 64 * kb, n0 = 32 * nb;
    { f32x4 v[8];
#pragma unroll
      for (int i = 0; i < 8; ++i) v[i] = *(const f32x4*)(W + (size_t)(k0 + 8 * i + (lane >> 3)) * N + n0 + 4 * (lane & 7));
#pragma unroll
      for (int i = 0; i < 8; ++i) { LAS float* d = scr + (8 * i + (lane >> 3)) * 33 + 4 * (lane & 7); d[0] = v[i].x; d[1] = v[i].y; d[2] = v[i].z; d[3] = v[i].w; } }
    LDS_WAIT(); asm volatile("" ::: "memory");
    const int c = lane & 7;
#pragma unroll
    for (int j = 0; j < 4; ++j) { const int n = (lane >> 3) + 8 * j; const LAS float* s = scr + (8 * c) * 33 + n;
        v4u o; o.x = pk2(s[0 * 33], s[1 * 33]); o.y = pk2(s[2 * 33], s[3 * 33]); o.z = pk2(s[4 * 33], s[5 * 33]); o.w = pk2(s[6 * 33], s[7 * 33]);
        const int ng = n0 + n; int row = ng;
        if (permute && pg8::chunk_is_rope(ng >> 6)) row = (ng & ~63) + 2 * (ng & 31) + ((ng >> 5) & 1);
        *(GAS v4u*)(WT + (size_t)row * K + k0 + 8 * c) = o; }
    LDS_WAIT(); asm volatile("" ::: "memory");
}

struct Args { const float* in[14]; float* out; unsigned char* ws; int ph_lo, ph_hi; };

#define PHASE_LANE() \
    int tid_ = threadIdx.x; asm volatile("" : "+v"(tid_));        \
    const int lane = tid_ & 63, wave = __builtin_amdgcn_readfirstlane(tid_ >> 6); \
    const int gw = vcu * NWAVES + wave; const long gthr = (long)gw * 64 + lane; (void)gthr; (void)gw; (void)lane;
#define PHASE_PTRS() \
    const __attribute__((address_space(4))) Args* ap_ = (const __attribute__((address_space(4))) Args*)__builtin_amdgcn_kernarg_segment_ptr(); asm volatile("" : "+s"(ap_));
#define wsp_ (ap_->ws)
#define x_in (ap_->in[0])
#define w_in (ap_->in[1])
#define attn_sinks (ap_->in[2])
#define diff_lambda (ap_->in[3])
#define diff_norm_g (ap_->in[4])
#define w_out (ap_->in[5])
#define ln1_g (ap_->in[6])
#define ln1_b (ap_->in[7])
#define peer_wq (ap_->in[8])
#define peer_keys (ap_->in[9])
#define peer_u (ap_->in[10])
#define peer_v (ap_->in[11])
#define ln2_g (ap_->in[12])
#define ln2_b (ap_->in[13])
#define cosT ((float*)(wsp_ + WS_ROPE))
#define sinT ((float*)(wsp_ + WS_ROPE) + T * 32)
#define keysb ((bf16*)(wsp_ + WS_KEYSB))
#define winT ((bf16*)(wsp_ + WS_WINT))
#define woutT ((bf16*)(wsp_ + WS_WOUTT))
#define wqT ((bf16*)(wsp_ + WS_WQT))
#define ub8 ((unsigned char*)(wsp_ + WS_UB))
#define vb8 ((unsigned char*)(wsp_ + WS_VB))
#define xb ((bf16*)(wsp_ + WS_XB))
#define proj ((bf16*)(wsp_ + WS_PROJ))
#define ob ((bf16*)(wsp_ + WS_OB))
#define mixed ((bf16*)(wsp_ + WS_MIXED))
#define x2 ((float*)(wsp_ + WS_X2))
#define scores ((bf16*)(wsp_ + WS_SCORES))
#define zbuf ((float*)(wsp_ + WS_Z))
#define x1b ((bf16*)(wsp_ + WS_X1B))
#define qpeer ((bf16*)(wsp_ + WS_QPEER))
#define eidx ((bf16*)(wsp_ + WS_EIDX))
#define gate ((float*)(wsp_ + WS_GATE))
#define aact ((float*)(wsp_ + WS_AACT))
#define xs8 ((unsigned char*)(wsp_ + WS_XS))
#define eidxT ((bf16*)(wsp_ + WS_EIDX + 2 * MiB))
#define zsl ((bf16*)(wsp_ + WS_ZS))
#define pslab ((bf16*)(wsp_ + WS_PROJ))
#define selb ((bf16*)(wsp_ + WS_SEL))

__global__ void __launch_bounds__(NWAVES * 64, 2) mega_fwd(Args args) {
    extern __shared__ __attribute__((aligned(16))) unsigned char lds[];
    LAS unsigned char* ldsl = (LAS unsigned char*)lds;
    volatile LAS unsigned* MISC = (volatile LAS unsigned*)(ldsl + MISC_OFF);
    const int tid = threadIdx.x;
    const int G = gridDim.x, bx = blockIdx.x, vcu = (G % 8 == 0) ? (bx % 8) * (G / 8) + bx / 8 : bx;
    const int NGW = G * NWAVES;
    const long NGT = (long)NGW * 64;
    gu32* ctl = (gu32*)(args.ws + WS_CTL);
    for (int u = tid; u < (LDS_BYTES - LDSCTL_OFF) / 4; u += NWAVES * 64) ((LAS unsigned*)(ldsl + LDSCTL_OFF))[u] = 0u;
    __syncthreads();
    const int lo = args.ph_lo, hi = args.ph_hi;
    XcdBarrier bar; bar.bar = (unsigned*)(ctl + CW_BAR); bar.x = 0; bar.st = nullptr;
    if (hi - lo > 1) bar = xcd_barrier_post((unsigned*)(ctl + CW_BAR), MISC + 8);

#pragma unroll 1
    for (int ph = lo; ph < hi; ++ph) {
        constexpr int PL = NSUB + ((DUP >= 0) ? 1 : 0);
        const int L = (ph - 1) / PL, idx_ = (ph - 1) % PL, sub = (ph == 0) ? -1 : ((DUP >= 0 && idx_ > DUP) ? idx_ - 1 : idx_);
        if (ph > lo && !(sub == 3 && DUP != 2 && DUP != 3)) { xcd_barrier(bar); for (int xb_ = 0; xb_ < EXTRA_BAR; ++xb_) xcd_barrier(bar); }
        if (ph == 0) {
#if (PHM & 1)
        int tidp_ = threadIdx.x; asm volatile("" : "+v"(tidp_));
        const int lane = tidp_ & 63, wave = __builtin_amdgcn_readfirstlane(tidp_ >> 6);
        const int gw = vcu * NWAVES + wave;
        const long gthr = (long)gw * 64 + lane;
        PHASE_PTRS();
            LAS float* scr = (LAS float*)(ldsl + RING_OFF + wave * 16384);
            constexpr int I_IN = (D / 64) * (NIN / 32), I_SQ = (D / 64) * (D / 32), I_LAYER = I_IN + 2 * I_SQ;
            for (int rp_ = 0; rp_ < ((DUPSUB & 32) ? 2 : 1); ++rp_)
            for (int it = gw; it < I_IN; it += NGW) p0_transpose_item(w_in, D, NIN, winT, scr, it, lane, true);
            (void)I_SQ; (void)I_LAYER;
            for (long i = gthr; i < (long)DEPTH * 64 * D; i += NGT) { const int L = (int)(i / (64 * D)), rr = (int)(i % (64 * D)), n = 5056 + rr / D, k = rr % D;
                const float v = (n < NIN) ? w_in[(size_t)L * D * NIN + (size_t)k * NIN + n] : 0.f; winT[(size_t)L * NINP * D + (size_t)n * D + k] = (bf16)f2bf(v); }
            for (long i = gthr; i < (long)DEPTH * 16 * 128 * 128 / 8; i += NGT) { const f32x4 a = *(const f32x4*)(peer_keys + 8 * i), b = *(const f32x4*)(peer_keys + 8 * i + 4);
                v4u o; o.x = pk2(a.x, a.y); o.y = pk2(a.z, a.w); o.z = pk2(b.x, b.y); o.w = pk2(b.z, b.w); *(GAS v4u*)(keysb + 8 * i) = o; }
            { constexpr long N8 = (long)T * D / 8;
              for (long i0 = gthr; i0 < N8; i0 += 4 * NGT) {
                  f32x4 a[4], b[4];
#pragma unroll
                  for (int u = 0; u < 4; ++u) { long g = i0 + u * NGT; g = g < N8 ? g : N8 - 1; a[u] = *(const f32x4*)(x_in + 8 * g); b[u] = *(const f32x4*)(x_in + 8 * g + 4); }
#pragma unroll
                  for (int u = 0; u < 4; ++u) { const long g = i0 + u * NGT; if (g < N8) { v4u o; o.x = pk2(a[u].x, a[u].y); o.y = pk2(a[u].z, a[u].w); o.z = pk2(b[u].x, b[u].y); o.w = pk2(b[u].z, b[u].w); *(GAS v4u*)(xb + 8 * g) = o; } }
              } }
            for (long i = gthr; i < (long)T * 32; i += NGT) { const int t = (int)(i >> 5), f = (int)(i & 31);
                const float inv = powf(10000.0f, -(float)f / 32.0f); const float ang = (float)t * inv; float sv, cv; sincosf(ang, &sv, &cv); cosT[i] = cv; sinT[i] = sv; }
#endif
            continue;
        }
        {
        PHASE_PTRS();
        if (sub == 0) {
#if (PHM & 2)
            PHASE_LANE();
            pg8::Gemm g{xb, winT + (size_t)L * NINP * D, T, NINP, D}; pg8::StaticOrder S; S.init(T, NINP, G, bx);
            pg8::EpiInProj E{proj, cw::PITCH, cosT, sinT};
            pg8::gemm_phase<pg8::EpiInProj, pg8::StaticOrder, true, true>(ldsl + RING_OFF, g, S, E);
            if (L == 0) {
                pg8::Unit u3_; const int nrounds = (S.nwg + G - 1) / G;
                if (nrounds > 1 && !S.next(nrounds - 1, u3_)) {
                    const int nbusy = S.nwg - (nrounds - 1) * G, nidle = G - nbusy;
                    int tid2_ = threadIdx.x; asm volatile("" : "+v"(tid2_));
                    const int lane2 = tid2_ & 63, wave2 = __builtin_amdgcn_readfirstlane(tid2_ >> 6);
                    constexpr int I_IN = (D / 64) * (NIN / 32), I_SQ = (D / 64) * (D / 32), I_LAYER = I_IN + 2 * I_SQ;
                    LAS float* scr = (LAS float*)(ldsl + RING_OFF + wave2 * 16384);
#pragma unroll 1
                    for (int it = I_IN + (bx - nbusy) * NWAVES + wave2; it < DEPTH * I_LAYER; it += nidle * NWAVES) {
                        const int Lw = it / I_LAYER; int r = it % I_LAYER;
                        if (r < I_IN) { p0_transpose_item(w_in + (size_t)Lw * D * NIN, D, NIN, winT + (size_t)Lw * NINP * D, scr, r, lane2, true); continue; } r -= I_IN;
                        if (r < I_SQ) { p0_transpose_item(w_out + (size_t)Lw * D * D, D, D, woutT + (size_t)Lw * D * D, scr, r, lane2, false); continue; } r -= I_SQ;
                        p0_transpose_item(peer_wq + (size_t)Lw * D * D, D, D, wqT + (size_t)Lw * D * D, scr, r, lane2, false);
                    }
                }
            }
#endif
        } else if (sub == 1) {
#if (PHM & 4)
            PHASE_LANE();
#if (SUBM & 1)
#pragma unroll 1
            for (int pi = vcu; pi < 256; pi += G) {
                const int vh = pi >> 4, s = pi & 15, h = vh >> 2, j = (vh >> 1) & 1, c = vh & 1;
                const attn_body::bf16* Qh = (const attn_body::bf16*)(proj + cw::BQ + h * 128 + j * 64);
                const attn_body::bf16* Kh = (const attn_body::bf16*)(proj + cw::BK_ + h * 128 + j * 64);
                const attn_body::bf16* Vh = (const attn_body::bf16*)(proj + cw::BV + h * 128 + c * 64);
                attn_body::bf16* Oh = (attn_body::bf16*)(ob + vh * 64);
#pragma unroll 1
                for (int ui = 0; ui < 2; ++ui) { attn_body::attn_unit<8>(ui == 0 ? 31 - s : s, Qh, Kh, Vh, Oh, (char*)lds + RING_OFF);
                    if (ui == 0 && pi == vcu) p0_tables_layer(peer_u, peer_v, ub8, vb8, L, (long)gw * 64 + lane, NGT); }
            }
#endif
#if (SUBM & 2)
            for (int rp_ = 0; rp_ < ((DUPSUB & 2) ? 2 : 1); ++rp_)
            for (int it = gw; it < 2048; it += NGW) cw::swa_item(proj, mixed, attn_sinks + L * 8, it & 7, it >> 3, lane, (LAS unsigned char*)(ldsl + RING_OFF + wave * 16384));
#endif
#if (SUBM & 4)
            for (int rp_ = 0; rp_ < ((DUPSUB & 4) ? 2 : 1); ++rp_)
            for (int it = gw; it < 2048; it += NGW) { const int rest = it >> 3; cw::dil_item(proj, mixed, it & 7, rest & 15, rest >> 4, lane, (LAS unsigned char*)(ldsl + RING_OFF + wave * 16384)); }
#endif
#if (SUBM & 8)
            for (int rp_ = 0; rp_ < ((DUPSUB & 8) ? 2 : 1); ++rp_)
            for (int it = gw; it < 8448; it += NGW) { int c = 0; while (c < 31 && it >= 512 * (c + 1) - 8 * (c + 1) * c) ++c; cw::idx_item(proj, scores, 16 * c + (it - (512 * c - 8 * c * (c - 1))), c, (gw * 5 + (gw >> 3)) & 1023, lane, (LAS unsigned char*)(ldsl + RING_OFF + wave * 16384), !((DUPSUB & 256) && rp_ == 1)); }
#endif
#endif
        } else if (sub == 2) {
#if (PHM & 8)
            PHASE_LANE();
            LAS unsigned char* wsl = ldsl + RING_OFF + wave * 16384;
#pragma unroll 1
            for (int i4 = 4 * gw; i4 < 8192; i4 += 4 * NGW) {
#pragma unroll 1
                for (int k = 0; k < 4; ++k) { const int i = i4 >> 2; const int t = (k == 0) ? 8191 - i : (k == 1) ? 4096 + i : (k == 2) ? 4095 - i : i; cw::dsa_select(scores, selb, t, wsl, lane); }
            }
            asm volatile("s_waitcnt vmcnt(0)" ::: "memory");
            const float* lp = diff_lambda + L * 256;
            const float lam_init = 0.8f - 0.6f * expf(-0.3f * (float)L);
            const float lam = expf(cw::wave_sum(lp[lane] * lp[64 + lane])) - expf(cw::wave_sum(lp[128 + lane] * lp[192 + lane])) + lam_init;
            for (int t = gw; t < T; t += NGW) cw::diff_combine_row(ob, mixed, diff_norm_g + L * 128, lam, lam_init, t, lane);
#endif
        } else if (sub == 3) {
#if (PHM & 8)
            PHASE_LANE();
            LAS unsigned char* wsl = ldsl + RING_OFF + wave * 16384; LAS bf16* idx16 = (LAS bf16*)(ldsl + MISC_OFF + 1024 + wave * 512);
#pragma unroll 1
            for (int i4 = 4 * gw; i4 < 8192; i4 += 4 * NGW) {
#pragma unroll 1
                for (int k = 0; k < 4; ++k) { const int i = i4 >> 2; const int t = (k == 0) ? 8191 - i : (k == 1) ? 4096 + i : (k == 2) ? 4095 - i : i; cw::dsa_attend(proj, selb, mixed, t, wsl, idx16, lane); }
            }
#endif
        } else if (sub == 4) {
#if (PHM & 16)
            PHASE_LANE();
            pg8::Gemm g{mixed, woutT + (size_t)L * D * D, T, D, D}; pg8::StaticOrder S; S.init(T, D, G, bx);
            pg8::EpiResid E{(bf16*)zbuf, (L == 0) ? x_in : (const float*)x2, D, ALPHA};
            pg8::gemm_phase<pg8::EpiResid, pg8::StaticOrder, true, true>(ldsl + RING_OFF, g, S, E);
#endif
        } else if (sub == 5) {
#if (PHM & 32)
            PHASE_LANE();
            for (int t = gw; t < T; t += NGW) cw::ln_row<true>((const bf16*)zbuf + (size_t)t * D, 1.0f, (const bf16*)nullptr, t, (float*)nullptr, x1b + (size_t)t * D, xs8, ln1_g + L * D, ln1_b + L * D, lane);
#endif
        } else if (sub == 6) {
#if (PHM & 64)
            PHASE_LANE();
            pg8::Gemm g{x1b, wqT + (size_t)L * D * D, T, D, D}; pg8::StaticOrder S; S.init(T, D, G, bx);
            pg8::EpiBf16<0> E{qpeer, D, nullptr, 0, 0, 1.f};
            pg8::gemm_phase<pg8::EpiBf16<0>, pg8::StaticOrder, true, true>(ldsl + RING_OFF, g, S, E);
#endif
        } else if (sub == 7) {
#if (PHM & 128)
            PHASE_LANE();
            LAS unsigned* cand = (LAS unsigned*)(ldsl + RING_OFF + wave * 12800);
#pragma unroll 1
            for (int it = gw; it < 2048; it += NGW) cw::peer_topk_item(qpeer, keysb + (size_t)L * 16 * 128 * 128, eidx, eidxT, gate, it >> 3, it & 7, cand, lane);
#endif
        } else if (sub == 8) {
#if (PHM & 256)
            PHASE_LANE();
            { const int xg = bx & 7, wig = (bx >> 3) * NWAVES + wave, wpg = (G >> 3) * NWAVES; const unsigned char* ubL = ub8 + (size_t)L * NEXP * D;
#pragma unroll 1
              for (int m = 0; m < 2; ++m) { const int s = xg + 8 * m;
#ifndef NO_DOT
                cw::peer_dot_slice(xs8, ubL, eidxT, pslab, wig, wpg, s, lane);
#endif
              } }
#endif
        } else if (sub == 9) {
#if (PHM & 256)
            PHASE_LANE();
            for (int t = gw; t < T; t += NGW) cw::peer_act_row(pslab, gate, aact, t, lane);
#endif
        } else if (sub == 10) {
#if (PHM & 256)
            PHASE_LANE();
            { const int xg = bx & 7, wig = (bx >> 3) * NWAVES + wave, wpg = (G >> 3) * NWAVES; const unsigned char* vbL = vb8 + (size_t)L * NEXP * D;
#pragma unroll 1
              for (int m = 0; m < 2; ++m) { const int s = xg + 8 * m;
#ifndef NO_AXPY
                cw::peer_axpy_slice(vbL, eidx, aact, zsl, wig, wpg, s, lane);
#endif
              } }
#endif
        } else {
#if (PHM & 256)
            PHASE_LANE();
            { const bool last = (L == DEPTH - 1); float* zout = last ? ap_->out : x2;
              for (int t = gw; t < T; t += NGW) cw::ln_row<true>(x1b + (size_t)t * D, ALPHA, zsl, t, zout + (size_t)t * D, last ? (bf16*)nullptr : xb + (size_t)t * D, (unsigned char*)nullptr, ln2_g + L * D, ln2_b + L * D, lane); }
#endif
        }
        }
    }
}

#undef wsp_
#undef x_in
#undef w_in
#undef attn_sinks
#undef diff_lambda
#undef diff_norm_g
#undef w_out
#undef ln1_g
#undef ln1_b
#undef peer_wq
#undef peer_keys
#undef peer_u
#undef peer_v
#undef ln2_g
#undef ln2_b
#undef cosT
#undef sinT
#undef keysb
#undef winT
#undef woutT
#undef wqT
#undef ub8
#undef vb8
#undef xb
#undef proj
#undef ob
#undef mixed
#undef x2
#undef scores
#undef zbuf
#undef x1b
#undef qpeer
#undef eidx
#undef gate
#undef aact
#undef xs8
#undef eidxT
#undef zsl
#undef pslab
#undef selb

extern "C" void kernel_launch(void* const* d_in, const int* in_sizes, int n_in, void* d_out, int out_size, void* d_ws, size_t ws_size, hipStream_t stream) {
    static int grid = 0;
    if (grid == 0) {
        if (n_in != 14 || out_size != T * D || ws_size < WS_END) { fprintf(stderr, "kernel_launch: unexpected shapes (n_in %d, out %d, ws %zu < %zu); nothing launched\n", n_in, out_size, ws_size, (size_t)WS_END); grid = -1; return; }
        int dev = 0, cus = 0;
        if (hipGetDevice(&dev) != hipSuccess || hipDeviceGetAttribute(&cus, hipDeviceAttributeMultiprocessorCount, dev) != hipSuccess) { grid = -1; return; }
        if (hipFuncSetAttribute((const void*)mega_fwd, hipFuncAttributeMaxDynamicSharedMemorySize, LDS_BYTES) != hipSuccess) { fprintf(stderr, "kernel_launch: hipFuncSetAttribute failed\n"); grid = -1; return; }
        (void)hipGetLastError();
        grid = cus;
    }
    if (grid < 0) return;
    if (hipMemsetAsync((char*)d_ws + WS_CTL, 0, CTL_ZERO_BYTES, stream) != hipSuccess) { fprintf(stderr, "kernel_launch: memset failed\n"); return; }
    Args a{};
    for (int i = 0; i < 14; ++i) a.in[i] = (const float*)d_in[i];
    a.out = (float*)d_out; a.ws = (unsigned char*)d_ws;
#if CHECK
    a.ph_lo = 0; a.ph_hi = 5;
    hipLaunchKernelGGL(mega_fwd, dim3(grid), dim3(NWAVES * 64), LDS_BYTES, stream, a);
    { unsigned char* w8 = (unsigned char*)d_ws; unsigned* res = (unsigned*)(w8 + WS_CTL + 512 * 1024);
      const cw::u16* projp = (const cw::u16*)(w8 + WS_PROJ); const cw::u16* mixp = (const cw::u16*)(w8 + WS_MIXED); const cw::u16* scp = (const cw::u16*)(w8 + WS_SCORES);
      if ((CHECK & 7) == 1) hipLaunchKernelGGL(chk::check_A, dim3(T * 8 / 4), dim3(256), 0, stream, projp, mixp, (const float*)d_in[2], res);
      if ((CHECK & 7) == 2) hipLaunchKernelGGL(chk::check_C, dim3(T * 8 / 4), dim3(256), 0, stream, projp, mixp, res);
      if ((CHECK & 7) == 3) hipLaunchKernelGGL(chk::check_D, dim3(T / 4), dim3(256), 0, stream, projp, scp, mixp, res);
      if ((CHECK & 7) == 4) hipLaunchKernelGGL(chk::check_S, dim3(T / 4), dim3(256), 0, stream, projp, scp, res);
      hipLaunchKernelGGL(chk::check_emit, dim3((out_size + 255) / 256), dim3(256), 0, stream, (const unsigned*)res, (float*)d_out, out_size, (CHECK >= 16) ? (CHECK >> 4) : ((CHECK & 7) - 1) + ((CHECK & 8) ? 8 : 0)); }
#elif MK_ONE_LAUNCH
    a.ph_lo = 0; a.ph_hi = NPH;
    hipLaunchKernelGGL(mega_fwd, dim3(grid), dim3(NWAVES * 64), LDS_BYTES, stream, a);
#else
    for (int ph = 0; ph < NPH; ++ph) { a.ph_lo = ph; a.ph_hi = ph + 1; hipLaunchKernelGGL(mega_fwd, dim3(grid), dim3(NWAVES * 64), LDS_BYTES, stream, a); }
#endif
}
```

```cpp
#include <hip/hip_runtime.h>
#include <hip/hip_bf16.h>
#include <cstdio>
#include <cstdint>
#include <cmath>
namespace pg8 {
#define PG8_LAS __attribute__((address_space(3)))
typedef unsigned short bf16_t;
typedef short bf16x8 __attribute__((ext_vector_type(8)));
typedef float f32x4 __attribute__((ext_vector_type(4)));
typedef unsigned u32x4 __attribute__((ext_vector_type(4)));
constexpr int BM = 256, BK = 64, HALF = 128, HTB = HALF * BK * 2  , STAGE_BYTES = 8 * HTB, NXCD = 8, WGM = 8;

__host__ __device__ __forceinline__ int lds_byte(int r, int c) { const int st = (r >> 4) * 2 + (c >> 5), rr = r & 15, cc = c & 31, ob = rr * 64 + cc * 2; return st * 1024 + (ob ^ (((ob >> 9) & 1) << 5)); }
__host__ __device__ __forceinline__ void stage_rc(int b, int& R, int& C) { const int st = b / 1024, sb = b % 1024, swz = sb ^ (((sb >> 9) & 1) << 5); R = (st >> 1) * 16 + swz / 64; C = (st & 1) * 32 + (swz % 64) / 2; }
__host__ __device__ __forceinline__ int perm32(int rho) { const int n = rho >> 4, i = rho & 15; return 8 * (i >> 2) + 4 * n + (i & 3); }

struct Unit { int pm, pn; };
struct Gemm { const bf16_t* A; const bf16_t* Bt; int M, N, K; };

struct StaticOrder {
    int nM, nN, nwg, G, c;
    __host__ __device__ void init(int M, int N, int G_, int c_) { nM = M / BM; nN = N / BM; nwg = nM * nN; G = G_; c = c_; }
    __host__ __device__ bool next(int i, Unit& u) const {
        const long L = (long)i * G + c; if (L >= nwg) return false;
        int wgid = (int)L; { const int q = nwg / NXCD, r = nwg % NXCD, xcd = wgid % NXCD, off = wgid / NXCD; wgid = (xcd < r ? xcd * (q + 1) : r * (q + 1) + (xcd - r) * q) + off; }
        const int nig = WGM * nN, gid = wgid / nig, fm = gid * WGM, gsz = (nM - fm) < WGM ? (nM - fm) : WGM;
        u.pm = fm + ((wgid % nig) % gsz); u.pn = (wgid % nig) / gsz; return true;
    }
    __device__ __forceinline__ void a_ready(const Unit&) const {}
    __device__ __forceinline__ void done(const Unit&) const {}
};

__device__ __forceinline__ unsigned cvt_pk_bf16(float lo, float hi) { unsigned r; asm volatile("v_cvt_pk_bf16_f32 %0, %1, %2" : "=v"(r) : "v"(lo), "v"(hi)); return r; }
typedef float f32x2 __attribute__((ext_vector_type(2)));
__device__ __forceinline__ f32x2 gelu_pk(f32x2 v) {
    const f32x2 av = __builtin_elementwise_abs(v), d = av * 0.2316418882f + 1.0f;
    f32x2 t; t.x = __builtin_amdgcn_rcpf(d.x); t.y = __builtin_amdgcn_rcpf(d.y);
    f32x2 q = t * 0.5307027145f + (-0.7265760135f); q = q * t + 0.7107068705f; q = q * t + (-0.142248368f); q = q * t + 0.127414796f; q = q * t;
    const f32x2 s = (v * v) * (-0.72134752044f);
    f32x2 e; e.x = __builtin_amdgcn_exp2f(s.x); e.y = __builtin_amdgcn_exp2f(s.y);
    const f32x2 m = v * (q * e), r = v - m;
    f32x2 o; o.x = v.x < 0.f ? m.x : r.x; o.y = v.y < 0.f ? m.y : r.y; return o;
}

template <int ACT  > struct EpiBf16 {
    static constexpr bool PERM = true, AFTER_DRAIN = false; static_assert(ACT == 0 || ACT == 1, "EpiBf16: ACT is 0 (none) or 1 (gelu_pk)");
    bf16_t* O; int ldc; const float* bias; int split_cols; size_t split_stride; float scale0;
    __device__ __forceinline__ void operator()(const f32x4 (&acc)[2][2][4][2], const Unit& u, int wr, int wc, int fr, int fq) const {
        const int row0 = u.pm * BM + wr * 64 + fr; int colt = u.pn * BM; bf16_t* base = O;
        float sc = 1.f; if (split_cols) { const int t = colt / split_cols; base += (size_t)t * split_stride; colt -= t * split_cols; if (t == 0) sc = scale0; }
        const int col0 = colt + wc * 32 + 8 * fq, bcol0 = u.pn * BM + wc * 32 + 8 * fq;
        f32x4 bv[2][2];
#pragma unroll
        for (int bj = 0; bj < 2; ++bj)
#pragma unroll
            for (int n = 0; n < 2; ++n) bv[bj][n] = bias ? *(const f32x4*)(bias + bcol0 + bj * HALF + 4 * n) : (f32x4){0.f, 0.f, 0.f, 0.f};
#pragma unroll
        for (int ai = 0; ai < 2; ++ai)
#pragma unroll
            for (int m = 0; m < 4; ++m) { bf16_t* rowp = base + (size_t)(row0 + ai * HALF + m * 16) * ldc + col0;
#pragma unroll
                for (int bj = 0; bj < 2; ++bj) { f32x4 v0 = acc[ai][bj][m][0] + bv[bj][0], v1 = acc[ai][bj][m][1] + bv[bj][1];
                    if (ACT == 1) { f32x2 a = gelu_pk((f32x2){v0[0], v0[1]}), b = gelu_pk((f32x2){v0[2], v0[3]}), c = gelu_pk((f32x2){v1[0], v1[1]}), d = gelu_pk((f32x2){v1[2], v1[3]});
                        v0 = (f32x4){a.x, a.y, b.x, b.y}; v1 = (f32x4){c.x, c.y, d.x, d.y}; }
                    v0 = v0 * sc; v1 = v1 * sc; u32x4 w; w.x = cvt_pk_bf16(v0[0], v0[1]); w.y = cvt_pk_bf16(v0[2], v0[3]); w.z = cvt_pk_bf16(v1[0], v1[1]); w.w = cvt_pk_bf16(v1[2], v1[3]);
                    *(u32x4*)(rowp + bj * HALF) = w; } }
    }
};

__device__ __forceinline__ bool chunk_is_rope(int c) { return (c < 10) || (c >= 12 && c < 28) || (c >= 36 && c < 52) || (c >= 60 && c < 69) || (c >= 70 && c < 79); }
__device__ __forceinline__ float chunk_scale(int c) {
    const float C2 = 0.125f * 1.4426950408889634f;
    if (c < 8 || (c >= 12 && c < 20) || (c >= 36 && c < 44) || (c >= 60 && c < 68)) return C2;
    if (c >= 70 && c < 78) return 0.125f;
    return 1.0f;
}
struct EpiInProj {
    static constexpr bool PERM = true, AFTER_DRAIN = false;
    bf16_t* O; int ldc; const float* cosT; const float* sinT;
    __device__ __forceinline__ void operator()(const f32x4 (&acc)[2][2][4][2], const Unit& u, int wr, int wc, int fr, int fq) const {
        const int row0 = u.pm * BM + wr * 64 + fr;
        const int colb = u.pn * BM + wc * 32 + 8 * fq;
        const int chunk0 = __builtin_amdgcn_readfirstlane(colb >> 6), chunk1 = chunk0 + 2;
        const bool rope0 = chunk_is_rope(chunk0), rope1 = chunk_is_rope(chunk1); const float sc0 = chunk_scale(chunk0), sc1 = chunk_scale(chunk1);
        const int i0 = (colb & 63) >> 1;
#pragma unroll
        for (int ai = 0; ai < 2; ++ai)
#pragma unroll
            for (int m = 0; m < 4; ++m) {
                const int row = row0 + ai * HALF + m * 16;
                f32x4 c = {1.f, 1.f, 1.f, 1.f}, s = {0.f, 0.f, 0.f, 0.f};
                if (rope0 || rope1) { c = *(const f32x4*)(cosT + (size_t)row * 32 + i0); s = *(const f32x4*)(sinT + (size_t)row * 32 + i0); }
#pragma unroll
                for (int bj = 0; bj < 2; ++bj) {
                    const bool rope = bj ? rope1 : rope0; const float sc = bj ? sc1 : sc0;
                    f32x4 v0 = acc[ai][bj][m][0], v1 = acc[ai][bj][m][1];
                    if (rope) {
                        f32x4 y0, y1;
                        y0[0] = v0[0] * c[0] - v0[1] * s[0]; y0[1] = v0[0] * s[0] + v0[1] * c[0];
                        y0[2] = v0[2] * c[1] - v0[3] * s[1]; y0[3] = v0[2] * s[1] + v0[3] * c[1];
                        y1[0] = v1[0] * c[2] - v1[1] * s[2]; y1[1] = v1[0] * s[2] + v1[1] * c[2];
                        y1[2] = v1[2] * c[3] - v1[3] * s[3]; y1[3] = v1[2] * s[3] + v1[3] * c[3];
                        v0 = y0; v1 = y1;
                    }
                    v0 = v0 * sc; v1 = v1 * sc;
                    u32x4 w; w.x = cvt_pk_bf16(v0[0], v0[1]); w.y = cvt_pk_bf16(v0[2], v0[3]); w.z = cvt_pk_bf16(v1[0], v1[1]); w.w = cvt_pk_bf16(v1[2], v1[3]);
                    *(u32x4*)(O + (size_t)row * ldc + colb + bj * HALF) = w;
                }
            }
    }
};
struct EpiResid {
    static constexpr bool PERM = false, AFTER_DRAIN = false;
    bf16_t* Z; const float* X; int ldc; float alpha;
    __device__ __forceinline__ void operator()(const f32x4 (&acc)[2][2][4][2], const Unit& u, int wr, int wc, int fr, int fq) const {
        const int row0 = u.pm * BM + wr * 64 + fr, col0 = u.pn * BM + wc * 32 + 4 * fq;
#pragma unroll
        for (int ai = 0; ai < 2; ++ai)
#pragma unroll
            for (int m = 0; m < 4; ++m) {
                const size_t off = (size_t)(row0 + ai * HALF + m * 16) * ldc + col0;
#pragma unroll
                for (int bj = 0; bj < 2; ++bj)
#pragma unroll
                    for (int n = 0; n < 2; ++n) { const f32x4 xv = *(const f32x4*)(X + off + bj * HALF + n * 16); const f32x4 zv = xv * alpha + acc[ai][bj][m][n]; typedef unsigned u32x2_ __attribute__((ext_vector_type(2))); *(u32x2_*)(Z + off + bj * HALF + n * 16) = (u32x2_){cvt_pk_bf16(zv[0], zv[1]), cvt_pk_bf16(zv[2], zv[3])}; }
            }
    }
};
template <class Epi, class Sched, bool ALIGN_EPI = false, bool SP2 = false>
__device__ __forceinline__ void gemm_phase(PG8_LAS unsigned char* lds, const Gemm g, const Sched& S, const Epi& E) {
    int tid_ = threadIdx.x; asm volatile("" : "+v"(tid_));
    const int tid = tid_, wid = __builtin_amdgcn_readfirstlane(tid >> 6), lane = tid & 63, wr = wid >> 2, wc = wid & 3, fr = lane & 15, fq = lane >> 4;
    const int K = g.K, nt = K / BK;
    unsigned voffA[2], voffB[2];
#pragma unroll
    for (int i = 0; i < 2; ++i) { int R, C; stage_rc(tid * 16 + i * 8192, R, C); const int Rb = Epi::PERM ? ((R & ~31) + perm32(R & 31)) : R;
        voffA[i] = (unsigned)(R * K + C) * 2u; voffB[i] = (unsigned)(Rb * K + C) * 2u; }
    const size_t kstep = (size_t)(BK * 2);
    const size_t hstep = (size_t)HALF * K * 2;
    const size_t tstep = 2 * hstep;
    const unsigned ldsw = (unsigned)wid * 1024u;
    const int aoff = lds_byte(wr * 64 + fr, fq * 8), boff = lds_byte(wc * 32 + fr, fq * 8);
#define PG8_SA(b, h) (((b) * 2 + (h)) * HTB)
#define PG8_SB(b, h) ((4 + (b) * 2 + (h)) * HTB)
#define PG8_STAGE(bufoff, gbase, voff) do { _Pragma("unroll") for (int _i = 0; _i < 2; ++_i) \
        __builtin_amdgcn_global_load_lds((const unsigned*)((const char*)(gbase) + (voff)[_i]), (PG8_LAS unsigned*)(lds + (bufoff) + ldsw + _i * 8192), 16, 0, 0); } while (0)
#define PG8_LDA(dst, b, h) do { _Pragma("unroll") for (int m = 0; m < 4; ++m) _Pragma("unroll") for (int k = 0; k < 2; ++k) dst[m][k] = *(const PG8_LAS bf16x8*)(lds + PG8_SA(b, h) + aoff + m * 2048 + k * 1024); } while (0)
#define PG8_LDB(dst, b, h) do { _Pragma("unroll") for (int n = 0; n < 2; ++n) _Pragma("unroll") for (int k = 0; k < 2; ++k) dst[n][k] = *(const PG8_LAS bf16x8*)(lds + PG8_SB(b, h) + boff + n * 2048 + k * 1024); } while (0)
#define PG8_MMA(ai, bj, At, Bt) do { __builtin_amdgcn_s_setprio(1); _Pragma("unroll") for (int m = 0; m < 4; ++m) _Pragma("unroll") for (int n = 0; n < 2; ++n) _Pragma("unroll") for (int k = 0; k < 2; ++k) \
        acc[ai][bj][m][n] = __builtin_amdgcn_mfma_f32_16x16x32_bf16(Bt[n][k], At[m][k], acc[ai][bj][m][n], 0, 0, 0); __builtin_amdgcn_s_setprio(0); } while (0)
#define PG8_WAIT_V(n) asm volatile("s_waitcnt vmcnt(" #n ")" ::: "memory")
#define PG8_WAIT_L(n) asm volatile("s_waitcnt lgkmcnt(" #n ")" ::: "memory")
#define PG8_BAR __builtin_amdgcn_s_barrier()
#define PG8_SCHED __builtin_amdgcn_sched_barrier(0)
    Unit cur, nxt; int ui = 0;
    if (!S.next(0, cur)) return;
    f32x4 acc[2][2][4][2];
#pragma unroll
    for (int a = 0; a < 2; ++a)
#pragma unroll
        for (int b = 0; b < 2; ++b)
#pragma unroll
            for (int m = 0; m < 4; ++m)
#pragma unroll
                for (int n = 0; n < 2; ++n) acc[a][b][m][n] = (f32x4){0.f, 0.f, 0.f, 0.f};
    bf16x8 At[4][2], B0[2][2], B1[2][2];
    const char* cA = (const char*)g.A + (size_t)cur.pm * tstep; const char* cB = (const char*)g.Bt + (size_t)cur.pn * tstep;
    S.a_ready(cur);
    if constexpr (SP2) {
        PG8_STAGE(PG8_SB(0, 0), cB, voffB); PG8_STAGE(PG8_SB(0, 1), cB + hstep, voffB); PG8_STAGE(PG8_SA(0, 0), cA, voffA); PG8_STAGE(PG8_SA(0, 1), cA + hstep, voffA);
        if (wr == 1) PG8_BAR;
        PG8_WAIT_V(2); PG8_BAR;
        PG8_STAGE(PG8_SB(1, 0), cB + kstep, voffB); PG8_STAGE(PG8_SA(1, 0), cA + kstep, voffA); PG8_STAGE(PG8_SB(1, 1), cB + hstep + kstep, voffB);
        PG8_WAIT_V(6); PG8_BAR;
    } else {
        PG8_STAGE(PG8_SB(0, 0), cB, voffB); PG8_STAGE(PG8_SA(0, 0), cA, voffA); PG8_STAGE(PG8_SB(0, 1), cB + hstep, voffB); PG8_STAGE(PG8_SA(0, 1), cA + hstep, voffA);
        if (wr == 1) PG8_BAR;
        PG8_WAIT_V(4); PG8_BAR;
        PG8_STAGE(PG8_SB(1, 0), cB + kstep, voffB); PG8_STAGE(PG8_SA(1, 0), cA + kstep, voffA); PG8_STAGE(PG8_SB(1, 1), cB + hstep + kstep, voffB);
        PG8_WAIT_V(6); PG8_BAR;
    }
    for (;;) {
        const bool has_next = S.next(ui + 1, nxt);
        const char* nA = has_next ? (const char*)g.A + (size_t)nxt.pm * tstep : cA; const char* nB = has_next ? (const char*)g.Bt + (size_t)nxt.pn * tstep : cB;
        for (int t = 0; t < nt; t += 2) {
            const bool last = (t == nt - 2);
            const char* a1 = cA + (size_t)(t + 1) * kstep;
            const char* a2 = last ? nA : cA + (size_t)(t + 2) * kstep; const char* b2 = last ? nB : cB + (size_t)(t + 2) * kstep;
            const char* a3 = a2 + kstep; const char* b3 = b2 + kstep;
            if (last && has_next) S.a_ready(nxt);
            if constexpr (SP2) {
            PG8_LDB(B0, 0, 0); PG8_LDB(B1, 0, 1); PG8_SCHED; PG8_LDA(At, 0, 0); PG8_STAGE(PG8_SA(1, 1), a1 + hstep, voffA);
            PG8_WAIT_V(8); PG8_WAIT_L(0); PG8_BAR; PG8_MMA(0, 0, At, B0); PG8_MMA(0, 1, At, B1); PG8_BAR; PG8_SCHED;
            PG8_LDA(At, 0, 1); PG8_STAGE(PG8_SB(0, 0), b2, voffB); PG8_STAGE(PG8_SB(0, 1), b2 + hstep, voffB); PG8_STAGE(PG8_SA(0, 0), a2, voffA);
            PG8_WAIT_V(8); PG8_WAIT_L(0); PG8_BAR; PG8_MMA(1, 0, At, B0); PG8_MMA(1, 1, At, B1); PG8_BAR; PG8_SCHED;
            PG8_LDB(B0, 1, 0); PG8_LDB(B1, 1, 1); PG8_SCHED; PG8_LDA(At, 1, 0); PG8_STAGE(PG8_SA(0, 1), a2 + hstep, voffA);
            PG8_WAIT_V(8); PG8_WAIT_L(0); PG8_BAR; PG8_MMA(0, 0, At, B0); PG8_MMA(0, 1, At, B1); PG8_BAR; PG8_SCHED;
            PG8_LDA(At, 1, 1); PG8_STAGE(PG8_SB(1, 0), b3, voffB); PG8_STAGE(PG8_SB(1, 1), b3 + hstep, voffB); PG8_STAGE(PG8_SA(1, 0), a3, voffA);
            PG8_WAIT_V(8); PG8_WAIT_L(0); PG8_BAR; PG8_MMA(1, 0, At, B0); PG8_MMA(1, 1, At, B1); PG8_BAR; PG8_SCHED;
            } else {
            PG8_LDB(B0, 0, 0); PG8_SCHED; PG8_LDA(At, 0, 0); PG8_STAGE(PG8_SA(1, 1), a1 + hstep, voffA);
            PG8_WAIT_L(8); PG8_BAR; PG8_WAIT_L(0); PG8_MMA(0, 0, At, B0); PG8_BAR; PG8_SCHED;
            PG8_LDB(B1, 0, 1); PG8_STAGE(PG8_SB(0, 0), b2, voffB);
            PG8_BAR; PG8_WAIT_L(0); PG8_MMA(0, 1, At, B1); PG8_BAR;
            PG8_LDA(At, 0, 1); PG8_STAGE(PG8_SA(0, 0), a2, voffA);
            PG8_BAR; PG8_WAIT_L(0); PG8_MMA(1, 0, At, B0); PG8_BAR; PG8_SCHED;
            PG8_STAGE(PG8_SB(0, 1), b2 + hstep, voffB);
            PG8_WAIT_V(6); PG8_BAR; PG8_MMA(1, 1, At, B1); PG8_BAR;
            PG8_LDB(B0, 1, 0); PG8_SCHED; PG8_LDA(At, 1, 0); PG8_STAGE(PG8_SA(0, 1), a2 + hstep, voffA);
            PG8_WAIT_L(8); PG8_BAR; PG8_WAIT_L(0); PG8_MMA(0, 0, At, B0); PG8_BAR; PG8_SCHED;
            PG8_LDB(B1, 1, 1); PG8_STAGE(PG8_SB(1, 0), b3, voffB);
            PG8_BAR; PG8_WAIT_L(0); PG8_MMA(0, 1, At, B1); PG8_BAR;
            PG8_LDA(At, 1, 1); PG8_STAGE(PG8_SA(1, 0), a3, voffA);
            PG8_BAR; PG8_WAIT_L(0); PG8_MMA(1, 0, At, B0); PG8_BAR; PG8_SCHED;
            PG8_STAGE(PG8_SB(1, 1), b3 + hstep, voffB);
            PG8_WAIT_V(6); PG8_BAR; PG8_MMA(1, 1, At, B1); PG8_BAR;
            }
        }
        if constexpr (ALIGN_EPI) { if (wr == 0) PG8_BAR; }
        if constexpr (!Epi::AFTER_DRAIN) { E(acc, cur, wr, wc, fr, fq); S.done(cur); }
        if (!has_next) break;
#pragma unroll
        for (int a = 0; a < 2; ++a)
#pragma unroll
            for (int b = 0; b < 2; ++b)
#pragma unroll
                for (int m = 0; m < 4; ++m)
#pragma unroll
                    for (int n = 0; n < 2; ++n) acc[a][b][m][n] = (f32x4){0.f, 0.f, 0.f, 0.f};
        cur = nxt; cA = nA; cB = nB; ++ui;
        if constexpr (ALIGN_EPI) { if (wr == 1) PG8_BAR; }
    }
    PG8_WAIT_V(0);
    if constexpr (!ALIGN_EPI) { if (wr == 0) PG8_BAR; }
    PG8_BAR;
    if constexpr (Epi::AFTER_DRAIN) { E.fused(acc, cur, wr, wc, fr, fq, lds, wid, lane); S.done(cur); }
#undef PG8_SA
#undef PG8_SB
#undef PG8_STAGE
#undef PG8_LDA
#undef PG8_LDB
#undef PG8_MMA
#undef PG8_WAIT_V
#undef PG8_WAIT_L
#undef PG8_BAR
#undef PG8_SCHED
}
}
namespace attn_body {
using bf16=__hip_bfloat16;
using bf16x8=__attribute__((ext_vector_type(8)))short;
using s16x4=__attribute__((ext_vector_type(4)))short;
using f32x16=__attribute__((ext_vector_type(16)))float;
using u32x4=__attribute__((ext_vector_type(4)))unsigned;
constexpr int SEQ=8192,D=64,DM=5184,ODM=1024;
constexpr int NW=8,QBLK=32,QB=QBLK*NW,KVBLK=64,NQB=SEQ/QB;
constexpr int ATTN_PITCH=DM, ATTN_UNIT_ROWS=QB;
__device__ __forceinline__ int crow(int r,int hi){return (r&3)+8*(r>>2)+4*hi;}
#define SBAR() __builtin_amdgcn_sched_barrier(0)
__device__ __forceinline__ void cmask(f32x16&p0,f32x16&p1,int jb,int qrel,int hi){
  const float NEG=-INFINITY; int kb=64*jb+4*hi;
  #pragma unroll
  for(int r=0;r<16;++r){int kv=kb+(r&3)+8*(r>>2); if(kv>qrel)p0[r]=NEG; if(kv+32>qrel)p1[r]=NEG;}
}

constexpr int NSLOT=3, SLOTB=8192;
constexpr int LDS_K=0, LDS_V=NSLOT*SLOTB, LDS_WS=2*NSLOT*SLOTB, LDS_OST=LDS_WS+NW*64*4, LDS_BYTES=LDS_OST+NW*4096;
constexpr float C2=0.125f*1.4426950408889634f;
__device__ __forceinline__ void glds16(const void*gsrc,unsigned lds_dst){unsigned keep;
  asm volatile("s_mov_b32 %0, m0\n\ts_mov_b32 m0, %2\n\ts_nop 0\n\tglobal_load_lds_dwordx4 %1, off\n\ts_mov_b32 m0, %0":"=&s"(keep):"v"(gsrc),"s"(lds_dst):"memory");}
__device__ __forceinline__ float max3f(float a,float b,float c){float r;asm("v_max3_f32 %0, %1, %2, %3":"=v"(r):"v"(a),"v"(b),"v"(c));return r;}
__device__ __forceinline__ float max2f(float a,float b){float r;asm("v_max_f32_e32 %0, %1, %2":"=v"(r):"v"(a),"v"(b));return r;}
__device__ __forceinline__ float fadd_s(float a,float b){float r;asm("v_add_f32_e32 %0, %1, %2":"=v"(r):"v"(a),"v"(b));return r;}
__device__ __forceinline__ float fsub_s(float a,float b){float r;asm("v_sub_f32_e32 %0, %1, %2":"=v"(r):"v"(a),"v"(b));return r;}
typedef float f32x2_t __attribute__((ext_vector_type(2))); typedef __bf16 bf16x2_t __attribute__((ext_vector_type(2)));
__device__ __forceinline__ unsigned cvtpk_s(float lo,float hi){f32x2_t v={lo,hi};bf16x2_t b=__builtin_convertvector(v,bf16x2_t);return __builtin_bit_cast(unsigned,b);}
#define WAIT_BAR(N) asm volatile("s_waitcnt vmcnt(" #N ") lgkmcnt(0)\n\ts_barrier":::"memory")

__device__ __forceinline__ void qkt(f32x16&p0,f32x16&p1,const char*Kslot,const bf16x8*qr,const f32x16&negm,int r32,int hi){
  const char*kb=Kslot+hi*1024+r32*16;
  #pragma unroll
  for(int d0=0;d0<4;++d0){
    const bf16x8 b0=*reinterpret_cast<const bf16x8*>(kb+d0*2048);
    const bf16x8 b1=*reinterpret_cast<const bf16x8*>(kb+d0*2048+512);
    if(d0==0){p0=__builtin_amdgcn_mfma_f32_32x32x16_bf16(b0,qr[0],negm,0,0,0);p1=__builtin_amdgcn_mfma_f32_32x32x16_bf16(b1,qr[0],negm,0,0,0);}
    else{p0=__builtin_amdgcn_mfma_f32_32x32x16_bf16(b0,qr[d0],p0,0,0,0);p1=__builtin_amdgcn_mfma_f32_32x32x16_bf16(b1,qr[d0],p1,0,0,0);}}
}
typedef __attribute__((address_space(3))) const char* lds_cptr;
typedef short v4i16_t __attribute__((ext_vector_type(4)));
__device__ __forceinline__ void kload8(bf16x8*kf,lds_cptr kp){
  kf[0]=*(const __attribute__((address_space(3))) bf16x8*)(kp);      kf[1]=*(const __attribute__((address_space(3))) bf16x8*)(kp+512);
  kf[2]=*(const __attribute__((address_space(3))) bf16x8*)(kp+2048); kf[3]=*(const __attribute__((address_space(3))) bf16x8*)(kp+2560);
  kf[4]=*(const __attribute__((address_space(3))) bf16x8*)(kp+4096); kf[5]=*(const __attribute__((address_space(3))) bf16x8*)(kp+4608);
  kf[6]=*(const __attribute__((address_space(3))) bf16x8*)(kp+6144); kf[7]=*(const __attribute__((address_space(3))) bf16x8*)(kp+6656);
}
__device__ __forceinline__ void kload2(bf16x8*kf,lds_cptr kp,int j){ kf[2*j]=*(const __attribute__((address_space(3))) bf16x8*)(kp+j*2048); kf[2*j+1]=*(const __attribute__((address_space(3))) bf16x8*)(kp+j*2048+512); }
__device__ __forceinline__ s16x4 vtr(lds_cptr p){ return __builtin_bit_cast(s16x4,__builtin_amdgcn_ds_read_tr16_b64_v4i16((__attribute__((address_space(3))) v4i16_t*)p)); }
__device__ __forceinline__ float rowmax(const f32x16&p0,const f32x16&p1){
  float a=max3f(p0[0],p0[1],p1[0]),b=max3f(p0[2],p0[3],p1[1]);a=max3f(a,p1[2],p1[3]);
  #pragma unroll
  for(int r=4;r<16;r+=4){a=max3f(a,p0[r],p0[r+1]);b=max3f(b,p0[r+2],p0[r+3]);a=max3f(a,p1[r],p1[r+1]);b=max3f(b,p1[r+2],p1[r+3]);}
  const float m=max2f(a,b);
  auto rr=__builtin_amdgcn_permlane32_swap(__float_as_uint(m),__float_as_uint(m),false,false);
  return max2f(__uint_as_float(rr[0]),__uint_as_float(rr[1]));
}
__device__ __forceinline__ void pv(f32x16*o,int vb,bf16x8 pa0,bf16x8 pa1,bf16x8 pa2,bf16x8 pa3){
  #pragma unroll
  for(int d0=0;d0<2;++d0){s16x4 lo[4],hi[4];
    #pragma unroll
    for(int ks=0;ks<4;++ks){
      asm volatile("ds_read_b64_tr_b16 %0,%1 offset:%c2":"=&v"(lo[ks]):"v"(vb),"i"(d0*4096+ks*1024):"memory");
      asm volatile("ds_read_b64_tr_b16 %0,%1 offset:%c2":"=&v"(hi[ks]):"v"(vb),"i"(d0*4096+ks*1024+512):"memory");}
    asm volatile("s_waitcnt lgkmcnt(0)":::"memory");SBAR();
    #define PK(k) (bf16x8){lo[k][0],lo[k][1],lo[k][2],lo[k][3],hi[k][0],hi[k][1],hi[k][2],hi[k][3]}
    o[d0]=__builtin_amdgcn_mfma_f32_32x32x16_bf16(pa0,PK(0),o[d0],0,0,0);
    o[d0]=__builtin_amdgcn_mfma_f32_32x32x16_bf16(pa1,PK(1),o[d0],0,0,0);
    o[d0]=__builtin_amdgcn_mfma_f32_32x32x16_bf16(pa2,PK(2),o[d0],0,0,0);
    o[d0]=__builtin_amdgcn_mfma_f32_32x32x16_bf16(pa3,PK(3),o[d0],0,0,0);
    #undef PK
  }
}

#ifndef ATTN_STORE16
#define ATTN_STORE16(p,v) (*(u32x4*)(p)=(v))
#endif
template<int THRL> __device__ __forceinline__ void attn_unit(int qb,const bf16*Qh,const bf16* Kh,const bf16* Vh,bf16*Oh,char*shm){
  int tid_=threadIdx.x; asm volatile("":"+v"(tid_));
  const int tid=tid_,lane=tid&63,r32=lane&31,hi=lane>>5; const int wid=__builtin_amdgcn_readfirstlane(tid>>6);
  const int q0=qb*QB;
  const bf16*Qw=Qh+(long)(q0+wid*QBLK)*DM;
  const unsigned lds0=(unsigned)(uintptr_t)shm;
  float*wsf=(float*)(shm+LDS_WS)+wid*64;
  const bf16*ksrc=Kh+(long)lane*DM+wid*8;
  const bf16*vsrc=Vh+(long)(16*(wid&3)+(lane>>2))*DM+(wid>>2)*32+(lane&3)*8;
  const unsigned kdst=lds0+LDS_K+wid*1024, vdst=lds0+LDS_V+wid*1024;
  #define DMA_K(t,slot) glds16(ksrc+(long)(t)*KVBLK*DM,(unsigned)__builtin_amdgcn_readfirstlane(kdst+(slot)))
  #define DMA_V(t,slot) glds16(vsrc+(long)(t)*KVBLK*DM,(unsigned)__builtin_amdgcn_readfirstlane(vdst+(slot)))
  const int vb0=(int)(lds0+LDS_V)+((lane>>4)&1)*32+(lane&3)*8+(4*hi+((lane&15)>>2))*64;
  const char*Kbase=shm+LDS_K; bf16x8 kf[8];
  const lds_cptr shm3=(lds_cptr)shm; const lds_cptr kp0=shm3+LDS_K+hi*1024+r32*16; const lds_cptr vp0=shm3+LDS_V+((lane>>4)&1)*32+(lane&3)*8+(4*hi+((lane&15)>>2))*64;
  const int NT=(q0+QB)/KVBLK;
  DMA_K(0,0);DMA_V(0,0);DMA_K(1,SLOTB);
  bf16x8 qr[4];
  #pragma unroll
  for(int d0=0;d0<4;++d0)qr[d0]=*reinterpret_cast<const bf16x8*>(&Qw[(long)r32*DM+d0*16+hi*8]);
  float mhat=0.f,l_reg=0.f;f32x16 o[2];o[0]=f32x16{};o[1]=f32x16{};f32x16 negm=f32x16{};asm volatile("":"+v"(negm));
  const int qrel=wid*QBLK+r32;
  #define CMASK(P0,P1,t) do{int jb_=(t)-(NT-4); if(jb_>=0)cmask(P0,P1,jb_,qrel,hi);}while(0)
  bool resc=false;
  #define START(P0,P1) do{ const float rm=rowmax(P0,P1); resc=false; \
    { const float dl=rm; mhat=fadd_s(mhat,dl); \
      _Pragma("unroll") for(int r=0;r<16;++r){P0[r]=fsub_s(P0[r],dl);P1[r]=fsub_s(P1[r],dl);} \
      _Pragma("unroll") for(int r=0;r<16;++r)negm[r]=-mhat; asm volatile("":"+v"(negm)); } \
    _Pragma("unroll") for(int r=0;r<16;++r)P0[r]=__builtin_amdgcn_exp2f(P0[r]); }while(0)
  #define RESC() do{ if(resc){ asm volatile("s_waitcnt lgkmcnt(0)":::"memory"); \
      _Pragma("unroll") for(int d_=0;d_<2;++d_) _Pragma("unroll") for(int r=0;r<16;++r)o[d_][r]*=wsf[crow(r,hi)]; } }while(0)
  f32x16 pA0,pA1,pB0,pB1;
  int sl_prev=0,sl_cur=0,sl_next=SLOTB;
  #define ROT() do{sl_prev=sl_cur;sl_cur=sl_next;sl_next=(sl_next==(NSLOT-1)*SLOTB)?0:sl_next+SLOTB;}while(0)
  DMA_K(2,2*SLOTB);
  WAIT_BAR(3);
  qkt(pA0,pA1,Kbase,qr,negm,r32,hi);asm volatile("s_nop 15\n\ts_nop 7":"+v"(pA0),"+v"(pA1));CMASK(pA0,pA1,0);
  START(pA0,pA1);
  _Pragma("unroll") for(int r=0;r<16;++r)pA1[r]=__builtin_amdgcn_exp2f(pA1[r]);
  WAIT_BAR(0);
  DMA_K(3,0);DMA_V(1,SLOTB);
  ROT();
  kload8(kf,kp0+sl_cur);
  WAIT_BAR(2);
  s16x4 vlo[8],vhi[8]; u32x4 pw0,pw1,pw2,pw3;
  #define PKW(P,B) cvtpk_s(P[B],P[B+1])
  #define PAF(k) __builtin_bit_cast(bf16x8,pw##k)
  #define VFR(i) (bf16x8){vlo[i][0],vlo[i][1],vlo[i][2],vlo[i][3],vhi[i][0],vhi[i][1],vhi[i][2],vhi[i][3]}
  #define PIN(x) asm volatile("":"+v"(x))
  #define MX3(a,b,c) __builtin_fmaxf(__builtin_fmaxf((a),(b)),(c))
  #define GAPA(MF,A0,A1,A2,A3,W0,W1,PW) do{ MF; sacc+=A0; sacc+=A1; sacc+=A2; sacc+=A3; PIN(sacc); W0; W1; PIN(PW); SBAR(); }while(0)
  #define EX(v) __builtin_amdgcn_exp2f(v)
  #define GAPB(MF,X,B) do{ MF; X[B]=EX(X[B]); X[B+1]=EX(X[B+1]); X[B+2]=EX(X[B+2]); X[B+3]=EX(X[B+3]); PIN(X); SBAR(); }while(0)
  #define VRD(i) do{ vlo[i]=vtr(vp_+(((i)>>2)*4096+((i)&3)*1024)); vhi[i]=vtr(vp_+(((i)>>2)*4096+((i)&3)*1024+512)); }while(0)
  #define KRD(G,j) do{ if(G){ kload2(kf,kp0+sl_next,j); SBAR(); } }while(0)
  #define STEP(C0,C1,P0,P1,t,GK,GV,GL) do{ SBAR(); \
    const lds_cptr vp_=vp0+sl_prev; \
    VRD(0); SBAR(); float sacc=(P0[0]+P0[1]); \
    GAPA(C0=__builtin_amdgcn_mfma_f32_32x32x16_bf16(kf[0],qr[0],negm,0,0,0), P0[2],P0[3],P0[4],P0[5],     pw0[0]=PKW(P0,0), pw0[1]=PKW(P0,2), pw0); \
    VRD(4); SBAR(); GAPA(C1=__builtin_amdgcn_mfma_f32_32x32x16_bf16(kf[1],qr[0],negm,0,0,0), P0[6],P0[7],P0[8],P0[9],     pw0[2]=PKW(P0,4), pw0[3]=PKW(P0,6), pw0); \
    VRD(1); SBAR(); GAPA(C0=__builtin_amdgcn_mfma_f32_32x32x16_bf16(kf[2],qr[1],C0,0,0,0),   P0[10],P0[11],P0[12],P0[13], pw1[0]=PKW(P0,8), pw1[1]=PKW(P0,10), pw1); \
    VRD(5); SBAR(); GAPA(C1=__builtin_amdgcn_mfma_f32_32x32x16_bf16(kf[3],qr[1],C1,0,0,0),   P0[14],P0[15],P1[0],P1[1],   pw1[2]=PKW(P0,12),pw1[3]=PKW(P0,14), pw1); \
    VRD(2); SBAR(); GAPA(C0=__builtin_amdgcn_mfma_f32_32x32x16_bf16(kf[4],qr[2],C0,0,0,0),   P1[2],P1[3],P1[4],P1[5],     pw2[0]=PKW(P1,0), pw2[1]=PKW(P1,2), pw2); \
    VRD(6); SBAR(); GAPA(C1=__builtin_amdgcn_mfma_f32_32x32x16_bf16(kf[5],qr[2],C1,0,0,0),   P1[6],P1[7],P1[8],P1[9],     pw2[2]=PKW(P1,4), pw2[3]=PKW(P1,6), pw2); \
    VRD(3); SBAR(); GAPA(C0=__builtin_amdgcn_mfma_f32_32x32x16_bf16(kf[6],qr[3],C0,0,0,0),   P1[10],P1[11],P1[12],P1[13], pw3[0]=PKW(P1,8), pw3[1]=PKW(P1,10), pw3); \
    VRD(7); SBAR(); GAPA(C1=__builtin_amdgcn_mfma_f32_32x32x16_bf16(kf[7],qr[3],C1,0,0,0),   P1[14],P1[15],0.f,0.f,       pw3[2]=PKW(P1,12),pw3[3]=PKW(P1,14), pw3); \
    l_reg+=sacc; \
    if(GK){DMA_K((t)+3,sl_cur);} if(GV){DMA_V((t)+1,sl_next);} \
    CMASK(C0,C1,t); \
    { float a=MX3(C0[0],C0[1],C1[0]),b=MX3(C0[2],C0[3],C1[1]); a=MX3(a,C1[2],C1[3]); \
      _Pragma("unroll") for(int r=4;r<16;r+=4){a=MX3(a,C0[r],C0[r+1]);b=MX3(b,C0[r+2],C0[r+3]);a=MX3(a,C1[r],C1[r+1]);b=MX3(b,C1[r+2],C1[r+3]);} \
      float rm=__builtin_fmaxf(a,b); { auto rr=__builtin_amdgcn_permlane32_swap(__float_as_uint(rm),__float_as_uint(rm),false,false); rm=__builtin_fmaxf(__uint_as_float(rr[0]),__uint_as_float(rr[1])); } \
      resc=false; \
      if(__builtin_expect(__any(rm>(float)THRL),0)){ const float dl=__builtin_fmaxf(rm,0.f); mhat+=dl; \
        _Pragma("unroll") for(int r=0;r<16;++r){C0[r]-=dl;C1[r]-=dl;} \
        _Pragma("unroll") for(int r=0;r<16;++r)negm[r]=-mhat; asm volatile("":"+v"(negm)); \
        const float f=__builtin_amdgcn_exp2f(-dl); l_reg*=f; if(hi==0)wsf[r32]=f; resc=true; } } \
    SBAR(); \
    GAPB(o[0]=__builtin_amdgcn_mfma_f32_32x32x16_bf16(PAF(0),VFR(0),o[0],0,0,0), C0,0); \
    GAPB(o[1]=__builtin_amdgcn_mfma_f32_32x32x16_bf16(PAF(0),VFR(4),o[1],0,0,0), C0,4); \
    KRD(GL,0); GAPB(o[0]=__builtin_amdgcn_mfma_f32_32x32x16_bf16(PAF(1),VFR(1),o[0],0,0,0), C0,8); \
    KRD(GL,1); GAPB(o[1]=__builtin_amdgcn_mfma_f32_32x32x16_bf16(PAF(1),VFR(5),o[1],0,0,0), C0,12); \
    KRD(GL,2); GAPB(o[0]=__builtin_amdgcn_mfma_f32_32x32x16_bf16(PAF(2),VFR(2),o[0],0,0,0), C1,0); \
    KRD(GL,3); GAPB(o[1]=__builtin_amdgcn_mfma_f32_32x32x16_bf16(PAF(2),VFR(6),o[1],0,0,0), C1,4); \
    GAPB(o[0]=__builtin_amdgcn_mfma_f32_32x32x16_bf16(PAF(3),VFR(3),o[0],0,0,0), C1,8); \
    GAPB(o[1]=__builtin_amdgcn_mfma_f32_32x32x16_bf16(PAF(3),VFR(7),o[1],0,0,0), C1,12); \
    }while(0)
  int t=1;
  #undef CMASK
  #define CMASK(P0,P1,t) do{}while(0)
  for(;t+5<NT;t+=2){
    STEP(pB0,pB1,pA0,pA1,t,true,true,true);     WAIT_BAR(2); RESC(); ROT();
    STEP(pA0,pA1,pB0,pB1,t+1,true,true,true);   WAIT_BAR(2); RESC(); ROT();
  }
  #undef CMASK
  #define CMASK(P0,P1,t) do{int jb_=(t)-(NT-4); if(jb_>=0)cmask(P0,P1,jb_,qrel,hi);}while(0)
  #define ENDW(tt) do{ if((tt)+3<NT){WAIT_BAR(2);} else if((tt)+2<NT){WAIT_BAR(1);} else {WAIT_BAR(0);} }while(0)
  for(;t+1<NT;t+=2){
    STEP(pB0,pB1,pA0,pA1,t,(t+3<NT),(t+1<NT),(t+1<NT));       ENDW(t);   RESC(); ROT();
    STEP(pA0,pA1,pB0,pB1,t+1,(t+4<NT),(t+2<NT),(t+2<NT));     ENDW(t+1); RESC(); ROT();
  }
  STEP(pB0,pB1,pA0,pA1,NT-1,false,false,false); RESC();
  { float sacc=pB0[0]+pB0[1]; _Pragma("unroll") for(int r=2;r<16;++r)sacc+=pB0[r]; _Pragma("unroll") for(int r=0;r<16;++r)sacc+=pB1[r]; l_reg+=sacc;
    pw0=(u32x4){PKW(pB0,0),PKW(pB0,2),PKW(pB0,4),PKW(pB0,6)};pw1=(u32x4){PKW(pB0,8),PKW(pB0,10),PKW(pB0,12),PKW(pB0,14)};pw2=(u32x4){PKW(pB1,0),PKW(pB1,2),PKW(pB1,4),PKW(pB1,6)};pw3=(u32x4){PKW(pB1,8),PKW(pB1,10),PKW(pB1,12),PKW(pB1,14)};
    SBAR(); pv(o,vb0+sl_cur,PAF(0),PAF(1),PAF(2),PAF(3)); }
  #undef PKW
  #undef PAF
  #undef VFR
  #undef PIN
  #undef MX3
  #undef GAPA
  #undef GAPB
  #undef EX
  #undef VRD
  #undef KRD
  #undef STEP
  #undef ENDW
  {auto rr=__builtin_amdgcn_permlane32_swap(__float_as_uint(l_reg),__float_as_uint(l_reg),false,false);l_reg=__uint_as_float(rr[0])+__uint_as_float(rr[1]);}
  if(hi==0)wsf[32+r32]=l_reg;asm volatile("s_waitcnt lgkmcnt(0)":::"memory");
  float rli[16];
  #pragma unroll
  for(int r=0;r<16;++r)rli[r]=__builtin_amdgcn_rcpf(wsf[32+crow(r,hi)]);
  bf16*Ow=Oh+(long)(q0+wid*QBLK)*ODM;
  { bf16*stg=(bf16*)(shm+LDS_OST)+wid*2048;
    #pragma unroll
    for(int r=0;r<16;++r){const int orow=crow(r,hi);
      #pragma unroll
      for(int d0=0;d0<2;++d0)stg[orow*64+d0*32+r32]=__float2bfloat16(o[d0][r]*rli[r]);}
    asm volatile("s_waitcnt lgkmcnt(0)":::"memory");
    #pragma unroll
    for(int i=0;i<4;++i){const int row=i*8+(lane>>3),ch=lane&7; const u32x4 v=*(const u32x4*)(stg+row*64+ch*8); ATTN_STORE16(Ow+(long)row*ODM+ch*8,v);} }
  asm volatile("s_waitcnt lgkmcnt(0)\n\ts_barrier":::"memory");
  #undef DMA_K
  #undef DMA_V
  #undef CMASK
  #undef START
  #undef RESC
  #undef ROT
}
constexpr int ATTN_LDS_BYTES=LDS_BYTES;
#undef SBAR
#undef WAIT_BAR
}
#define GAS __attribute__((address_space(1)))
#define LAS __attribute__((address_space(3)))
typedef unsigned short bf16;
typedef unsigned v4u __attribute__((ext_vector_type(4)));
typedef float f32x4 __attribute__((ext_vector_type(4)));
typedef short bf16x8 __attribute__((ext_vector_type(8)));
typedef GAS unsigned gu32;
typedef GAS unsigned long long gu64;
#define RLX_AGENT __ATOMIC_RELAXED, __HIP_MEMORY_SCOPE_AGENT
#define LDS_WAIT() asm volatile("s_waitcnt lgkmcnt(0)" ::: "memory")
#define VM_WAIT() asm volatile("s_waitcnt vmcnt(0)" ::: "memory")
__device__ __forceinline__ unsigned long long rt() { return __builtin_amdgcn_s_memrealtime(); }
__device__ __forceinline__ unsigned f2bf(float f) { unsigned u = __builtin_bit_cast(unsigned, f); return (u + 0x7fffu + ((u >> 16) & 1u)) >> 16; }
__device__ __forceinline__ unsigned pk2(float lo, float hi) { return f2bf(lo) | (f2bf(hi) << 16); }

#define XB_TMO      128
#define XB_XCNT(j)  (256  + 64 * (j))
#define XB_XSUB(j)  (1280 + 64 * (j))
#define XB_XGEN(j)  (2304 + 64 * (j))
#define XB_TOP      3328
#define XB_TOPGEN   3392
#define XCD_BAR_WORDS 3456
#define XB_SPIN_CAP (1u << 18)

__device__ __forceinline__ unsigned xb_ld(unsigned* p)              { return __hip_atomic_load(p, __ATOMIC_RELAXED, __HIP_MEMORY_SCOPE_AGENT); }
__device__ __forceinline__ unsigned xb_add(unsigned* p, unsigned v) { return __hip_atomic_fetch_add(p, v, __ATOMIC_RELAXED, __HIP_MEMORY_SCOPE_AGENT); }
__device__ __forceinline__ unsigned xb_xcc_id() { return (unsigned)__builtin_amdgcn_s_getreg((3 << 11) | 20) & 0xFu; }
#define XB_SPIN(cond, bar) do { unsigned _sp = 0; while (cond) { __builtin_amdgcn_s_sleep(1); \
    if ((++_sp & 255u) == 0u) { if (xb_ld(&(bar)[XB_TMO])) break; if (_sp > XB_SPIN_CAP) { atomicAdd(&(bar)[XB_TMO], 1u); break; } } } } while (0)

struct XcdBarrier {
    unsigned* bar; unsigned x;
    volatile LAS unsigned* st;
};

__device__ __forceinline__ XcdBarrier xcd_barrier_post(unsigned* bar, volatile LAS unsigned* st) {
    XcdBarrier b; b.bar = bar; b.x = xb_xcc_id(); b.st = st;
    if (threadIdx.x == 0) (void)xb_add(&bar[XB_XCNT(b.x)], 1u);
    return b;
}
__device__ __forceinline__ void xcd_barrier_complete(unsigned* bar, unsigned x, unsigned& nloc, unsigned& nx) {
    const unsigned G = gridDim.x * gridDim.y * gridDim.z;
    unsigned sum, cnt, mine, sp = 0u;
    for (;;) {
        sum = 0u; cnt = 0u; mine = 0u;
#pragma unroll
        for (unsigned j = 0; j < 16; ++j) { const unsigned c = xb_ld(&bar[XB_XCNT(j)]); sum += c; cnt += (c > 0u) ? 1u : 0u; mine = (j == x) ? c : mine; }
        if (sum == G) break;
        __builtin_amdgcn_s_sleep(1);
        if ((++sp & 255u) == 0u) { if (xb_ld(&bar[XB_TMO])) break; if (sp > XB_SPIN_CAP) { atomicAdd(&bar[XB_TMO], 1u); break; } }
    }
    nloc = mine > 0u ? mine : 1u; nx = cnt > 0u ? cnt : 1u;
}

__device__ __forceinline__ void xcd_barrier(const XcdBarrier& b) {
    asm volatile("s_waitcnt vmcnt(0)" ::: "memory");
    __syncthreads();
    if (threadIdx.x == 0) {
        unsigned* bar = b.bar;
        __builtin_amdgcn_s_waitcnt(0);
        unsigned nloc = b.st[0], nx = b.st[1];
        if (nloc == 0u) { xcd_barrier_complete(bar, b.x, nloc, nx); b.st[0] = nloc; b.st[1] = nx; }
        const unsigned old = xb_add(&bar[XB_XSUB(b.x)], 1u);
        const unsigned gen = old / nloc;
        if (old + 1u == (gen + 1u) * nloc) {
            __builtin_amdgcn_fence(__ATOMIC_RELEASE, "agent");
            asm volatile("s_waitcnt vmcnt(0)" ::: "memory");
            const unsigned og = xb_add(&bar[XB_TOP], 1u);
            const unsigned tg = og / nx;
            if (og + 1u == (tg + 1u) * nx) xb_add(&bar[XB_TOPGEN], 1u);
            else XB_SPIN(xb_ld(&bar[XB_TOPGEN]) == tg, bar);
            __builtin_amdgcn_fence(__ATOMIC_ACQUIRE, "agent");
            xb_add(&bar[XB_XGEN(b.x)], 1u);
            asm volatile("s_waitcnt vmcnt(0)" ::: "memory");
        } else {
            XB_SPIN(xb_ld(&bar[XB_XGEN(b.x)]) == gen, bar);
            __builtin_amdgcn_fence(__ATOMIC_ACQUIRE, "agent");
            asm volatile("s_waitcnt vmcnt(0)" ::: "memory");
        }
    }
    __syncthreads();
}

namespace cw {
typedef unsigned short u16;
typedef short bf16x8 __attribute__((ext_vector_type(8)));
typedef float f32x16 __attribute__((ext_vector_type(16)));
typedef float f32x4 __attribute__((ext_vector_type(4)));
typedef unsigned u32x4 __attribute__((ext_vector_type(4)));
typedef unsigned u32x2 __attribute__((ext_vector_type(2)));
typedef __bf16 bf16x2_t __attribute__((ext_vector_type(2)));
#define CW_LAS __attribute__((address_space(3)))
constexpr int SEQ = 8192, DMODEL = 2048, PITCH = 5184;
constexpr int AQ = 0, AK = 512, AV = 640, BQ = 768, BK_ = 1280, BV = 1792, CQ = 2304, CK = 2816, CV = 3328, DQ = 3840, DK = 4352, DV = 4416, IQ = 4480, IK = 4992, IW = 5056;
constexpr float LOG2E = 1.4426950408889634f;
constexpr float NEGINF = -INFINITY;
#ifndef PEER_G1
#define PEER_G1 4
#endif
#ifndef PEER_G2
#define PEER_G2 2
#endif
#ifndef DUPSUB
#define DUPSUB 0
#endif
#ifndef ABL
#define ABL 0
#endif
constexpr float KA = (ABL == 1) ? 0.f : 1.f, KC = (ABL == 2) ? 0.f : 1.f, KD = (ABL == 3) ? 0.f : 1.f, KP = (ABL == 4) ? 0.f : 1.f, KB = (ABL == 5) ? 0.f : 1.f;

__device__ __forceinline__ int crow(int r, int hi) { return (r & 3) + 8 * (r >> 2) + 4 * hi; }
__device__ __forceinline__ float bf2f(unsigned b) { return __uint_as_float(b << 16); }
__device__ __forceinline__ unsigned f2bf(float f) { unsigned u = __float_as_uint(f); return (u + 0x7fffu + ((u >> 16) & 1u)) >> 16; }
__device__ __forceinline__ unsigned pk2(float lo, float hi) { typedef float f2_ __attribute__((ext_vector_type(2))); typedef __bf16 b2_ __attribute__((ext_vector_type(2))); const f2_ v = {lo, hi}; return __builtin_bit_cast(unsigned, __builtin_convertvector(v, b2_)); }
__device__ __forceinline__ float ex2(float x) { return __builtin_amdgcn_exp2f(x); }
__device__ __forceinline__ float pair_max(float v) { auto rr = __builtin_amdgcn_permlane32_swap(__float_as_uint(v), __float_as_uint(v), false, false); return fmaxf(__uint_as_float(rr[0]), __uint_as_float(rr[1])); }
__device__ __forceinline__ float pair_sum(float v) { auto rr = __builtin_amdgcn_permlane32_swap(__float_as_uint(v), __float_as_uint(v), false, false); return __uint_as_float(rr[0]) + __uint_as_float(rr[1]); }
__device__ __forceinline__ float wave_sum(float v) {
    v += __builtin_bit_cast(float, __builtin_amdgcn_mov_dpp(__builtin_bit_cast(int, v), 0xB1, 0xf, 0xf, true));
    v += __builtin_bit_cast(float, __builtin_amdgcn_mov_dpp(__builtin_bit_cast(int, v), 0x4E, 0xf, 0xf, true));
    v += __builtin_bit_cast(float, __builtin_amdgcn_mov_dpp(__builtin_bit_cast(int, v), 0x141, 0xf, 0xf, true));
    v += __builtin_bit_cast(float, __builtin_amdgcn_mov_dpp(__builtin_bit_cast(int, v), 0x140, 0xf, 0xf, true));
    { const auto rr = __builtin_amdgcn_permlane16_swap(__float_as_uint(v), __float_as_uint(v), false, false); v = __uint_as_float(rr[0]) + __uint_as_float(rr[1]); }
    { const auto rr = __builtin_amdgcn_permlane32_swap(__float_as_uint(v), __float_as_uint(v), false, false); v = __uint_as_float(rr[0]) + __uint_as_float(rr[1]); }
    return v;
}
__device__ __forceinline__ bf16x8 ld8(const u16* p) { return *(const bf16x8*)p; }
__device__ __forceinline__ unsigned pkh(float lo, float hi) { typedef _Float16 h2 __attribute__((ext_vector_type(2))); const h2 v = {(_Float16)lo, (_Float16)hi}; return __builtin_bit_cast(unsigned, v); }
__device__ __forceinline__ unsigned __builtin_amdgcn_mad_u32_u24_compat(unsigned a, unsigned b, unsigned c) { return __umul24(a, b) + c; }

struct BState { f32x16 o0, o1; float m, l; };
typedef short s16x4 __attribute__((ext_vector_type(4)));
template <bool GATHER = false>
__device__ __forceinline__ void band_accum(BState& st, const bf16x8 (&qf)[4], const u16* Kb, const u16* Vb, int kres, int kdil, int pq, int pstart, int ntiles, int maxd, int lane, CW_LAS unsigned char* bst, CW_LAS const u16* idx16 = nullptr) {
    const int r32 = lane & 31, hi = lane >> 5;
    const int pmax = (SEQ - 1 - kres) / kdil;
    const int lrow = lane >> 3; const unsigned kgo = 8u * (unsigned)((lane & 7) ^ (lrow & 7)), vgo = 8u * (unsigned)(lane & 7);
    CW_LAS const unsigned char* krd = bst + r32 * 128; const int kx = r32 & 7;
    CW_LAS const unsigned char* vrd = bst + 4096 + (4 * hi + ((lane & 15) >> 2)) * 128 + (16 * ((lane >> 4) & 1) + 4 * (lane & 3)) * 2;
#define BA_LOAD(buf, KT) do { const int p0_ = pstart + 32 * (KT); \
        _Pragma("unroll") for (int m_ = 0; m_ < 4; ++m_) { int pk_ = p0_ + 8 * m_ + lrow; size_t ro_; if constexpr (GATHER) ro_ = (size_t)((unsigned)idx16[pk_] & 0x1fffu) * PITCH; else { pk_ = pk_ > pmax ? pmax : pk_; ro_ = (size_t)(kres + kdil * pk_) * PITCH; } \
            __builtin_amdgcn_global_load_lds((const unsigned*)(Kb + ro_ + kgo), (CW_LAS unsigned*)(bst + (buf) * 8192 + m_ * 1024), 16, 0, 0); \
            __builtin_amdgcn_global_load_lds((const unsigned*)(Vb + ro_ + vgo), (CW_LAS unsigned*)(bst + (buf) * 8192 + 4096 + m_ * 1024), 16, 0, 0); } } while (0)
#define BA_READ(kf, vt, buf) do { \
        _Pragma("unroll") for (int d0 = 0; d0 < 4; ++d0) kf[d0] = *(const CW_LAS bf16x8*)(krd + (buf) * 8192 + 16 * ((2 * d0 + hi) ^ kx)); \
        _Pragma("unroll") for (int s_ = 0; s_ < 2; ++s_) _Pragma("unroll") for (int jh_ = 0; jh_ < 2; ++jh_) _Pragma("unroll") for (int b_ = 0; b_ < 2; ++b_) \
            vt[s_][jh_][b_] = __builtin_bit_cast(s16x4, __builtin_amdgcn_ds_read_tr16_b64_v4i16((CW_LAS s16x4*)(vrd + (buf) * 8192 + (16 * s_ + 8 * jh_) * 128 + 64 * b_))); } while (0)
#define BA_QK(s16, kf) do { s16 = (f32x16){0.f, 0.f, 0.f, 0.f, 0.f, 0.f, 0.f, 0.f, 0.f, 0.f, 0.f, 0.f, 0.f, 0.f, 0.f, 0.f}; \
        _Pragma("unroll") for (int d0 = 0; d0 < 4; ++d0) s16 = __builtin_amdgcn_mfma_f32_32x32x16_bf16(kf[d0], qf[d0], s16, 0, 0, 0); __builtin_amdgcn_sched_barrier(0); } while (0)
#define BA_SOFTPV(s16, vt, KT) do { const int p0_ = pstart + 32 * (KT); \
        float rm = NEGINF; \
        { const int mb_ = GATHER ? (maxd - p0_ - 4 * hi) : (pq - p0_ - 4 * hi);     \
          \
        if (!__all(GATHER ? (mb_ > 27) : ((unsigned)(mb_ - 27) <= (unsigned)(maxd - 27)))) { \
        _Pragma("unroll") for (int r = 0; r < 16; ++r) { const int c_ = (r & 3) + 8 * (r >> 2); const bool ok = GATHER ? (c_ < mb_) : ((unsigned)(mb_ - c_) <= (unsigned)maxd); s16[r] = ok ? s16[r] : NEGINF; } } \
        _Pragma("unroll") for (int r = 0; r < 16; r += 2) rm = __builtin_fmaxf(__builtin_fmaxf(rm, s16[r]), s16[r + 1]); }     \
        rm = pair_max(rm); \
          \
          \
        if (__any(rm > st.m + 8.0f)) { const float mn = fmaxf(st.m, rm), mu = (mn == NEGINF) ? 0.f : mn; const float alpha = ex2(st.m - mu); \
            _Pragma("unroll") for (int r = 0; r < 16; ++r) { st.o0[r] *= alpha; st.o1[r] *= alpha; } st.l *= alpha; st.m = mn; } \
        const float mu2_ = (st.m == NEGINF) ? 0.f : st.m; \
        float ps = 0.f; \
        _Pragma("unroll") for (int r = 0; r < 16; ++r) { s16[r] = ex2(s16[r] - mu2_); ps += s16[r]; } \
        ps = pair_sum(ps); \
        st.l += ps; \
        _Pragma("unroll") for (int s_ = 0; s_ < 2; ++s_) { \
            u32x4 pw; pw.x = pk2(s16[8 * s_ + 0], s16[8 * s_ + 1]); pw.y = pk2(s16[8 * s_ + 2], s16[8 * s_ + 3]); pw.z = pk2(s16[8 * s_ + 4], s16[8 * s_ + 5]); pw.w = pk2(s16[8 * s_ + 6], s16[8 * s_ + 7]); \
            const bf16x8 pf = __builtin_bit_cast(bf16x8, pw); \
            st.o0 = __builtin_amdgcn_mfma_f32_32x32x16_bf16(__builtin_shufflevector(vt[s_][0][0], vt[s_][1][0], 0, 1, 2, 3, 4, 5, 6, 7), pf, st.o0, 0, 0, 0); \
            st.o1 = __builtin_amdgcn_mfma_f32_32x32x16_bf16(__builtin_shufflevector(vt[s_][0][1], vt[s_][1][1], 0, 1, 2, 3, 4, 5, 6, 7), pf, st.o1, 0, 0, 0); } \
        __builtin_amdgcn_sched_barrier(0); } while (0)
#define BA_NEXT(kf, vt, s16, buf, KTL) do { asm volatile("s_waitcnt vmcnt(8)" ::: "memory"); BA_READ(kf, vt, buf); asm volatile("s_waitcnt lgkmcnt(0)" ::: "memory"); \
        { const int kn_ = ((KTL) < ntiles) ? (KTL) : ntiles - 1; BA_LOAD(buf, kn_); } BA_QK(s16, kf); } while (0)
    bf16x8 kfA[4], kfB[4]; s16x4 vtA[2][2][2], vtB[2][2][2]; f32x16 sA, sB;
    asm volatile("s_waitcnt lgkmcnt(0)" ::: "memory"); BA_LOAD(0, 0); BA_LOAD(1, (1 < ntiles) ? 1 : ntiles - 1);
    BA_NEXT(kfA, vtA, sA, 0, 2);
#pragma unroll 1
    for (int kt = 0; kt < ntiles; kt += 2) {
        if (kt + 1 < ntiles) BA_NEXT(kfB, vtB, sB, 1, kt + 3);
        BA_SOFTPV(sA, vtA, kt);
        if (kt + 1 < ntiles) {
            if (kt + 2 < ntiles) BA_NEXT(kfA, vtA, sA, 0, kt + 4);
            BA_SOFTPV(sB, vtB, kt + 1);
        }
    }
    asm volatile("s_waitcnt vmcnt(0)" ::: "memory");
#undef BA_LOAD
#undef BA_READ
#undef BA_QK
#undef BA_SOFTPV
#undef BA_NEXT
}
__device__ __forceinline__ void bstate_init(BState& st) {
#pragma unroll
    for (int r = 0; r < 16; ++r) { st.o0[r] = 0.f; st.o1[r] = 0.f; }
    st.m = NEGINF; st.l = 0.f;
}
__device__ __forceinline__ void bstate_store(const BState& st, float f, u16* orow, int hi) {
#pragma unroll
    for (int b = 0; b < 2; ++b)
#pragma unroll
        for (int g = 0; g < 4; ++g) {
            const f32x16& o = b ? st.o1 : st.o0;
            u32x2 w; w.x = pk2(o[4 * g] * f, o[4 * g + 1] * f); w.y = pk2(o[4 * g + 2] * f, o[4 * g + 3] * f);
            *(u32x2*)(orow + 32 * b + 8 * g + 4 * hi) = w;
        }
}
__device__ __forceinline__ void swa_item(const u16* proj, u16* mixed, const float* sinks, int hq, int qt, int lane, CW_LAS unsigned char* bst) {
    const int r32 = lane & 31, hi = lane >> 5, t0 = 32 * qt, kvh = hq >> 2;
    const u16* qrow = proj + (size_t)(t0 + r32) * PITCH + AQ + hq * 64 + 8 * hi;
    bf16x8 qf[4];
#pragma unroll
    for (int d0 = 0; d0 < 4; ++d0) qf[d0] = ld8(qrow + 16 * d0);
    BState st; bstate_init(st);
    int pstart = t0 - 127; pstart = pstart < 0 ? 0 : pstart;
    const int ntiles = (t0 + 31 - pstart) / 32 + 1;
    band_accum(st, qf, proj + AK + kvh * 64, proj + AV + kvh * 64, 0, 1, t0 + r32, pstart, ntiles, 127, lane, bst);
    const float sink2 = sinks[hq] * LOG2E;
    const float mall = fmaxf(st.m, sink2), corr = ex2(st.m - mall), den = st.l * corr + ex2(sink2 - mall);
    bstate_store(st, KA * corr / den, mixed + (size_t)(t0 + r32) * DMODEL + 0 + hq * 64, hi);
}
__device__ __forceinline__ void dil_item(const u16* proj, u16* mixed, int h, int r16, int jb, int lane, CW_LAS unsigned char* bst) {
    const int r32 = lane & 31, hi = lane >> 5;
    const int tq = r16 + 16 * (32 * jb + r32);
    const int tq_lo = r16 + 16 * (32 * jb), tq_hi = tq_lo + 16 * 31;
    const u16* qrow = proj + (size_t)tq * PITCH + CQ + h * 64 + 8 * hi;
    bf16x8 qf[4];
#pragma unroll
    for (int d0 = 0; d0 < 4; ++d0) qf[d0] = ld8(qrow + 16 * d0);
    BState st; bstate_init(st);
    const u16* Kb = proj + CK + h * 64; const u16* Vb = proj + CV + h * 64;
    {
        int ps = tq_lo - 128; ps = ps < 0 ? 0 : ps; const int nt = (tq_hi - ps) / 32 + 1;
        band_accum(st, qf, Kb, Vb, 0, 1, tq, ps, nt, 128, lane, bst);
    }
    {
        const int res = r16 & 3; int ps = (tq_lo >> 2) - 128; ps = ps < 0 ? 0 : ps; const int nt = ((tq_hi >> 2) - ps) / 32 + 1;
        band_accum(st, qf, Kb, Vb, res, 4, tq >> 2, ps, nt, 128, lane, bst);
    }
    {
        int ps = (tq_lo >> 4) - 128; ps = ps < 0 ? 0 : ps; const int nt = ((tq_hi >> 4) - ps) / 32 + 1;
        band_accum(st, qf, Kb, Vb, r16, 16, tq >> 4, ps, nt, 128, lane, bst);
    }
    bstate_store(st, KC * 1.0f / st.l, mixed + (size_t)tq * DMODEL + 1024 + h * 64, hi);
}

__device__ __forceinline__ void idx_item(const u16* proj, u16* scores, int qt, int c, int rot_seed, int lane, CW_LAS unsigned char* kst, bool do_store = true) {
    const int q = lane & 15, kq = lane >> 4, t = 16 * qt + q;
    asm volatile("s_waitcnt lgkmcnt(0)" ::: "memory");
    { const u16* qg = proj + (size_t)(16 * qt) * PITCH + IQ;
#pragma unroll
      for (int r = 0; r < 16; ++r) __builtin_amdgcn_global_load_lds((const unsigned*)(qg + (size_t)r * PITCH + 8 * (lane ^ r)), (CW_LAS unsigned*)(kst + r * 1024), 16, 0, 0); }
    float w[8];
    { const u32x4 wv = *(const u32x4*)(proj + (size_t)t * PITCH + IW);
      const float sc = 0.35355339059327373f;
      w[0] = bf2f(wv.x & 0xffffu) * sc; w[1] = bf2f(wv.x >> 16) * sc; w[2] = bf2f(wv.y & 0xffffu) * sc; w[3] = bf2f(wv.y >> 16) * sc;
      w[4] = bf2f(wv.z & 0xffffu) * sc; w[5] = bf2f(wv.z >> 16) * sc; w[6] = bf2f(wv.w & 0xffffu) * sc; w[7] = bf2f(wv.w >> 16) * sc; }
    asm volatile("s_waitcnt vmcnt(0)" ::: "memory");
    bf16x8 qf[8][2];
#pragma unroll
    for (int h = 0; h < 8; ++h)
#pragma unroll
        for (int s_ = 0; s_ < 2; ++s_) qf[h][s_] = *(const CW_LAS bf16x8*)(kst + q * 1024 + 16 * ((8 * h + 4 * s_ + kq) ^ q));
    asm volatile("s_waitcnt lgkmcnt(0)" ::: "memory");
    const int kt_end = (16 * c + 15 < qt) ? 16 * c + 15 : qt;
    const u16* kgl = proj + (size_t)(lane >> 3) * PITCH + IK + 8 * ((lane & 7) ^ ((lane >> 3) & 7));
    CW_LAS const unsigned char* krd = kst + q * 128;
    const int kp0 = 16 * (kq ^ (q & 7)), kp1 = 16 * ((4 + kq) ^ (q & 7));
#define IDX_STAGE(gb, ktg) do { _Pragma("unroll") for (int u_ = 0; u_ < 4; ++u_) { int kk_ = (ktg) + u_; kk_ = kk_ > kt_end ? kt_end : kk_; const u16* kr_ = kgl + (size_t)(16 * kk_) * PITCH; \
        __builtin_amdgcn_global_load_lds((const unsigned*)kr_, (CW_LAS unsigned*)(kst + (gb) * 8192 + u_ * 2048), 16, 0, 0); \
        __builtin_amdgcn_global_load_lds((const unsigned*)(kr_ + (size_t)8 * PITCH), (CW_LAS unsigned*)(kst + (gb) * 8192 + u_ * 2048 + 1024), 16, 0, 0); } } while (0)
#define IDX_TILE(u_, acc_) do { f32x4 s8[8];   \
        _Pragma("unroll") for (int h = 0; h < 8; ++h) { s8[h] = (f32x4){0.f, 0.f, 0.f, 0.f}; s8[h] = __builtin_amdgcn_mfma_f32_16x16x32_bf16(kf_[u_][0], qf[h][0], s8[h], 0, 0, 0); } \
        _Pragma("unroll") for (int h = 0; h < 8; ++h) s8[h] = __builtin_amdgcn_mfma_f32_16x16x32_bf16(kf_[u_][1], qf[h][1], s8[h], 0, 0, 0); \
        acc_ = (f32x4){0.f, 0.f, 0.f, 0.f}; \
        _Pragma("unroll") for (int h = 0; h < 8; ++h) { _Pragma("unroll") for (int r = 0; r < 4; ++r) acc_[r] += w[h] * __builtin_amdgcn_fmed3f(s8[h][r], 0.f, INFINITY); } } while (0)
#define IDX_COMP(gb, ktg) do { bf16x8 kf_[4][2];   \
        _Pragma("unroll") for (int u_ = 0; u_ < 4; ++u_) { kf_[u_][0] = *(const CW_LAS bf16x8*)(krd + (gb) * 8192 + u_ * 2048 + kp0); kf_[u_][1] = *(const CW_LAS bf16x8*)(krd + (gb) * 8192 + u_ * 2048 + kp1); } \
        _Pragma("unroll") for (int up_ = 0; up_ < 2; ++up_) { const int kka_ = (ktg) + 2 * up_; if (kka_ <= kt_end) { \
            f32x4 aa_; IDX_TILE(2 * up_, aa_); \
            if (kka_ + 1 <= kt_end) { f32x4 ab_; IDX_TILE(2 * up_ + 1, ab_); \
                if (do_store) { const auto r0_ = __builtin_amdgcn_permlane16_swap(pkh(aa_[0], aa_[1]), pkh(ab_[0], ab_[1]), false, false); const auto r1_ = __builtin_amdgcn_permlane16_swap(pkh(aa_[2], aa_[3]), pkh(ab_[2], ab_[3]), false, false); \
                    *(u32x4*)(scores + (size_t)t * SEQ + 16 * (kka_ + (kq & 1)) + 4 * (kq & ~1)) = (u32x4){r0_[0], r1_[0], r0_[1], r1_[1]}; } \
                else asm volatile("" :: "v"(aa_[0]), "v"(aa_[1]), "v"(aa_[2]), "v"(aa_[3]), "v"(ab_[0]), "v"(ab_[1]), "v"(ab_[2]), "v"(ab_[3])); } \
            else { if (do_store) *(u32x2*)(scores + (size_t)t * SEQ + 16 * kka_ + 4 * kq) = (u32x2){pkh(aa_[0], aa_[1]), pkh(aa_[2], aa_[3])}; else asm volatile("" :: "v"(aa_[0]), "v"(aa_[1]), "v"(aa_[2]), "v"(aa_[3])); } } } } while (0)
#define IDX_COMP_FULL(gb, ktg) do { bf16x8 kf_[4][2]; \
        _Pragma("unroll") for (int u_ = 0; u_ < 4; ++u_) { kf_[u_][0] = *(const CW_LAS bf16x8*)(krd + (gb) * 8192 + u_ * 2048 + kp0); kf_[u_][1] = *(const CW_LAS bf16x8*)(krd + (gb) * 8192 + u_ * 2048 + kp1); } \
        _Pragma("unroll") for (int up_ = 0; up_ < 2; ++up_) { const int kka_ = (ktg) + 2 * up_; \
            f32x4 aa_, ab_; IDX_TILE(2 * up_, aa_); IDX_TILE(2 * up_ + 1, ab_); \
            if (do_store) { const auto r0_ = __builtin_amdgcn_permlane16_swap(pkh(aa_[0], aa_[1]), pkh(ab_[0], ab_[1]), false, false); const auto r1_ = __builtin_amdgcn_permlane16_swap(pkh(aa_[2], aa_[3]), pkh(ab_[2], ab_[3]), false, false); \
                *(u32x4*)(scores + (size_t)t * SEQ + 16 * (kka_ + (kq & 1)) + 4 * (kq & ~1)) = (u32x4){r0_[0], r1_[0], r0_[1], r1_[1]}; } \
            else asm volatile("" :: "v"(aa_[0]), "v"(aa_[1]), "v"(aa_[2]), "v"(aa_[3]), "v"(ab_[0]), "v"(ab_[1]), "v"(ab_[2]), "v"(ab_[3])); } } while (0)
    const int ng2 = (((kt_end - 16 * c) >> 2) + 2) & ~1, rot = rot_seed % ng2;
#define IDX_KT(gi) (16 * c + 4 * ((gi) + rot >= ng2 ? (gi) + rot - ng2 : (gi) + rot))
    IDX_STAGE(0, IDX_KT(0));
#pragma unroll 1
    for (int gi = 0; gi < ng2; gi += 2) {
        const int kta = IDX_KT(gi), ktb = IDX_KT(gi + 1), ktc = IDX_KT(gi + 2 < ng2 ? gi + 2 : gi);
        asm volatile("s_waitcnt lgkmcnt(0)" ::: "memory"); IDX_STAGE(1, ktb);
        asm volatile("s_waitcnt vmcnt(8)" ::: "memory"); if (kta + 3 <= kt_end) IDX_COMP_FULL(0, kta); else IDX_COMP(0, kta);
        asm volatile("s_waitcnt lgkmcnt(0)" ::: "memory"); IDX_STAGE(0, ktc);
        asm volatile("s_waitcnt vmcnt(8)" ::: "memory"); if (ktb + 3 <= kt_end) IDX_COMP_FULL(1, ktb); else IDX_COMP(1, ktb);
    }
    asm volatile("s_waitcnt vmcnt(0)" ::: "memory");
#undef IDX_KT
#undef IDX_STAGE
#undef IDX_COMP
#undef IDX_COMP_FULL
#undef IDX_TILE
}

__device__ __forceinline__ unsigned okey(float x) { unsigned u = __float_as_uint(x); if ((u << 1) == 0u) u = 0u; return (u & 0x80000000u) ? ~u : (u | 0x80000000u); }
template <int NB>
__device__ __forceinline__ int select_bin(CW_LAS unsigned* hist, int& k, int lane) {
    constexpr int PER = NB / 64;
    unsigned tot = 0;
#pragma unroll
    for (int i = 0; i < PER; i += 4) { const u32x4 hv = *(CW_LAS u32x4*)(hist + lane * PER + i); tot += (hv.x + hv.y) + (hv.z + hv.w); }
    unsigned incl = tot;
#pragma unroll
    for (int off = 1; off < 64; off <<= 1) { const unsigned tt = __shfl_down(incl, off); if (lane + off < 64) incl += tt; }
    const unsigned excl = incl - tot;
    const bool mine = (excl < (unsigned)k) && ((unsigned)k <= incl);
    int b = 0, kk = 0;
    if (mine) {
        unsigned cacc = excl;
        for (int i = PER - 1; i >= 0; --i) { const unsigned hc = hist[lane * PER + i]; if (cacc + hc >= (unsigned)k) { b = lane * PER + i; kk = k - (int)cacc; break; } cacc += hc; }
    }
    const unsigned long long mk = __ballot(mine);
    const int src = mk ? __builtin_ctzll(mk) : 0;
    b = __shfl(b, src); kk = __shfl(kk, src);
    k = kk;
    return b;
}
__device__ __forceinline__ unsigned okey16(unsigned h) { if ((h & 0x7fffu) == 0u) h = 0u; return (h & 0x8000u) ? (~h & 0xffffu) : (h | 0x8000u); }
__device__ __forceinline__ unsigned okey16x2(unsigned w) { typedef _Float16 h2_ __attribute__((ext_vector_type(2))); typedef short s2_ __attribute__((ext_vector_type(2)));
    const h2_ h = __builtin_bit_cast(h2_, w) + (h2_){(_Float16)0.0f, (_Float16)0.0f}; const s2_ sg = __builtin_bit_cast(s2_, h) >> 15; return __builtin_bit_cast(unsigned, h) ^ (__builtin_bit_cast(unsigned, sg) | 0x80008000u); }
__device__ __forceinline__ void dsa_select(const u16* scores, u16* sel, int t, CW_LAS unsigned char* ws_lds, int lane_in) {
    int lane = lane_in; asm volatile("" : "+v"(lane));
    CW_LAS unsigned* hist = (CW_LAS unsigned*)ws_lds;
    CW_LAS int* idxl = (CW_LAS int*)(ws_lds + 8192);
    const u16* srow = scores + (size_t)t * SEQ;
    const int n = t + 1;
    if (n <= 256) {
        for (int i = lane; i < 256; i += 64) idxl[i] = (i < n) ? i : 0;
    } else {
        int k = 256; unsigned b1s = 0, b2s = 0;
        const int nq = (n + 511) >> 9;
#define DSA_ELT(vvj, x) (((x) & 1) ? ((vvj)[(x) >> 1] >> 16) : ((vvj)[(x) >> 1] & 0xffffu))
#define DSA_PASS(COND, BIN) do { for (int j0 = 0; j0 < nq; j0 += 8) { u32x4 vv[8]; \
            _Pragma("unroll") for (int jj = 0; jj < 8; ++jj) { const int j = (j0 + jj < nq) ? j0 + jj : nq - 1; vv[jj] = *(const u32x4*)(srow + 512 * j + 8 * lane); } \
            _Pragma("unroll") for (int jj = 0; jj < 8; ++jj) { const unsigned kw_[4] = {okey16x2(vv[jj].x), okey16x2(vv[jj].y), okey16x2(vv[jj].z), okey16x2(vv[jj].w)}; _Pragma("unroll") for (int x = 0; x < 8; ++x) { const int i = 512 * (j0 + jj) + 8 * lane + x; const unsigned u = DSA_ELT(kw_, x); \
                const bool c_ = (j0 + jj < nq) && (i < n) && (COND);   \
                if (c_) __hip_atomic_fetch_add(hist + (BIN), 1u, __ATOMIC_RELAXED, __HIP_MEMORY_SCOPE_WAVEFRONT); } } } } while (0)
#define DSA_PASS1() do { for (int j0 = 0; j0 < nq; j0 += 8) { u32x4 vv[8]; \
            _Pragma("unroll") for (int jj = 0; jj < 8; ++jj) { const int j = (j0 + jj < nq) ? j0 + jj : nq - 1; vv[jj] = *(const u32x4*)(srow + 512 * j + 8 * lane); } \
            _Pragma("unroll") for (int jj = 0; jj < 8; ++jj) { if (j0 + jj < nq) { const unsigned kw_[4] = {okey16x2(vv[jj].x), okey16x2(vv[jj].y), okey16x2(vv[jj].z), okey16x2(vv[jj].w)}; _Pragma("unroll") for (int x = 0; x < 8; ++x) { const int i = 512 * (j0 + jj) + 8 * lane + x; const unsigned u = DSA_ELT(kw_, x); \
                const unsigned slot_ = (i < n) ? (u >> 8) : 256u + (unsigned)lane; \
                __hip_atomic_fetch_add(hist + slot_, 1u, __ATOMIC_RELAXED, __HIP_MEMORY_SCOPE_WAVEFRONT); } } } } } while (0)
        for (int rp_ = 0; rp_ < ((DUPSUB & 16) ? 2 : 1); ++rp_) { k = 256;
        for (int i = lane; i < 256; i += 64) hist[i] = 0u;
        asm volatile("s_waitcnt lgkmcnt(0)" ::: "memory");
        DSA_PASS1();
        asm volatile("s_waitcnt lgkmcnt(0)" ::: "memory");
        const unsigned b1 = (unsigned)select_bin<256>(hist, k, lane);
        asm volatile("s_waitcnt lgkmcnt(0)" ::: "memory");
        for (int i = lane; i < 256; i += 64) hist[i] = 0u;
        asm volatile("s_waitcnt lgkmcnt(0)" ::: "memory");
        DSA_PASS((u >> 8) == b1, u & 255u);
        asm volatile("s_waitcnt lgkmcnt(0)" ::: "memory");
        const unsigned b2 = (unsigned)select_bin<256>(hist, k, lane);
        asm volatile("s_waitcnt lgkmcnt(0)" ::: "memory");
        b1s = b1; b2s = b2; }
#undef DSA_PASS
#undef DSA_PASS1
        const unsigned T = (b1s << 8) | b2s; const int need_eq = k, cnt_gt = 256 - k;
        int cg = 0, ce = 0;
        const unsigned long long lt_mask = (1ull << lane) - 1ull;
        for (int j0 = 0; j0 < nq; j0 += 4) {
            u32x4 vv[4];
#pragma unroll
            for (int jj = 0; jj < 4; ++jj) { const int j = (j0 + jj < nq) ? j0 + jj : nq - 1; vv[jj] = *(const u32x4*)(srow + 512 * j + 8 * lane); }
#pragma unroll
            for (int jj = 0; jj < 4; ++jj) {
                if (j0 + jj < nq) {
                    bool g[8], e[8]; int pg = 0, pe = 0, tg = 0, te = 0; const unsigned kw_[4] = {okey16x2(vv[jj].x), okey16x2(vv[jj].y), okey16x2(vv[jj].z), okey16x2(vv[jj].w)};
#pragma unroll
                    for (int x = 0; x < 8; ++x) { const int i = 512 * (j0 + jj) + 8 * lane + x; const bool v = i < n; const unsigned u = DSA_ELT(kw_, x); g[x] = v && (u > T); e[x] = v && (u == T);
                        const unsigned long long mg = __ballot(g[x]), me = __ballot(e[x]);
                        pg += __builtin_popcountll(mg & lt_mask); pe += __builtin_popcountll(me & lt_mask); tg += __builtin_popcountll(mg); te += __builtin_popcountll(me); }
                    int og = cg + pg, oe = ce + pe;
#pragma unroll
                    for (int x = 0; x < 8; ++x) { const int i = 512 * (j0 + jj) + 8 * lane + x;
                        const bool wg = g[x] && (og < cnt_gt), we = e[x] && (oe < need_eq);
                        if (wg || we) idxl[wg ? og : cnt_gt + oe] = i;
                        og += g[x] ? 1 : 0; oe += e[x] ? 1 : 0; }
                    cg += tg; ce += te;
                }
            }
        }
#undef DSA_ELT
    }
    asm volatile("s_waitcnt lgkmcnt(0)" ::: "memory");
    { const int a0 = idxl[4 * lane], a1 = idxl[4 * lane + 1], a2 = idxl[4 * lane + 2], a3 = idxl[4 * lane + 3];
      *(u32x2*)(sel + (size_t)t * 256 + 4 * lane) = (u32x2){(unsigned)a0 | ((unsigned)a1 << 16), (unsigned)a2 | ((unsigned)a3 << 16)}; }
    asm volatile("s_waitcnt lgkmcnt(0)" ::: "memory");
}
__device__ __forceinline__ void dsa_attend(const u16* proj, const u16* sel, u16* mixed, int t, CW_LAS unsigned char* bst, CW_LAS u16* idx16, int lane_in) {
    int lane = lane_in; asm volatile("" : "+v"(lane));
    const int nsel = (t + 1 < 256) ? t + 1 : 256, ntiles = (nsel + 31) >> 5;
    asm volatile("s_waitcnt lgkmcnt(0)" ::: "memory");
    *(CW_LAS u32x2*)(idx16 + 4 * lane) = *(const u32x2*)(sel + (size_t)t * 256 + 4 * lane);
    const int r32 = lane & 31, hi = lane >> 5;
    const u16* qrow = proj + (size_t)t * PITCH + DQ + (r32 & 7) * 64 + 8 * hi;
    bf16x8 qf[4];
#pragma unroll
    for (int d0 = 0; d0 < 4; ++d0) qf[d0] = ld8(qrow + 16 * d0);
    asm volatile("s_waitcnt lgkmcnt(0)" ::: "memory");
    BState st; bstate_init(st);
    band_accum<true>(st, qf, proj + DK, proj + DV, 0, 1, 0, 0, ntiles, nsel, lane, bst, idx16);
    if (r32 < 8) bstate_store(st, KD / st.l, mixed + (size_t)t * DMODEL + 1536 + r32 * 64, hi);
}

__device__ __forceinline__ void diff_combine_row(const u16* OB, u16* mixed, const float* sub_g, float lam, float lam_init, int t, int lane) {
    const u16* orow = OB + (size_t)t * 1024;
#pragma unroll
    for (int h = 0; h < 4; ++h) {
        const float a0 = bf2f(orow[(h * 4 + 0) * 64 + lane]), a1 = bf2f(orow[(h * 4 + 1) * 64 + lane]);
        const float b0 = bf2f(orow[(h * 4 + 2) * 64 + lane]), b1 = bf2f(orow[(h * 4 + 3) * 64 + lane]);
        const float d0 = a0 - lam * b0, d1 = a1 - lam * b1;
        const float ms = wave_sum(d0 * d0 + d1 * d1) * (1.0f / 128.0f);
        const float rs = KB * (1.0f / sqrtf(ms + 1e-5f)) * (1.0f - lam_init);
        u16* mrow = mixed + (size_t)t * DMODEL + 512 + h * 128;
        mrow[lane] = (u16)f2bf(d0 * rs * sub_g[lane]); mrow[64 + lane] = (u16)f2bf(d1 * rs * sub_g[64 + lane]);
    }
}

typedef float f32x2 __attribute__((ext_vector_type(2)));
typedef int i32x8 __attribute__((ext_vector_type(8)));
constexpr float X8_SCALE = 8.0f; constexpr size_t XLO_OFF = (size_t)16 << 20;
template <bool INB = false>
__device__ __forceinline__ void ln_row(const void* in_, float alpha, const u16* zs, int t, float* outf, u16* outb, unsigned char* xs8, const float* g, const float* b, int lane) {
    f32x4 v[8]; float s = 0.f;
#pragma unroll
    for (int j = 0; j < 8; ++j) {
        if constexpr (INB) { const u32x2 iw = *(const u32x2*)((const u16*)in_ + 256 * j + 4 * lane); v[j] = (f32x4){bf2f(iw.x & 0xffffu), bf2f(iw.x >> 16), bf2f(iw.y & 0xffffu), bf2f(iw.y >> 16)} * alpha; }
        else v[j] = *(const f32x4*)((const float*)in_ + 256 * j + 4 * lane) * alpha;
        if (zs) { const u32x2 zw = *(const u32x2*)(zs + ((size_t)(2 * j + (lane >> 5)) * SEQ + t) * 128 + ((4 * lane) & 127)); v[j] = v[j] + (f32x4){bf2f(zw.x & 0xffffu), bf2f(zw.x >> 16), bf2f(zw.y & 0xffffu), bf2f(zw.y >> 16)}; }
        s += (v[j].x + v[j].y) + (v[j].z + v[j].w); }
    const float mean = wave_sum(s) * (1.0f / 2048.0f); float s2 = 0.f;
#pragma unroll
    for (int j = 0; j < 8; ++j) { v[j] = v[j] - mean; s2 += (v[j].x * v[j].x + v[j].y * v[j].y) + (v[j].z * v[j].z + v[j].w * v[j].w); }
    const float rstd = 1.0f / sqrtf(wave_sum(s2) * (1.0f / 2048.0f) + 1e-5f);
#pragma unroll
    for (int j = 0; j < 8; ++j) {
        const f32x4 gg = *(const f32x4*)(g + 256 * j + 4 * lane), bb = *(const f32x4*)(b + 256 * j + 4 * lane);
        const f32x4 y = v[j] * rstd * gg + bb;
        if (outf) *(f32x4*)(outf + 256 * j + 4 * lane) = y;
        if (outb) { u32x2 w; w.x = pk2(y.x, y.y); w.y = pk2(y.z, y.w); *(u32x2*)(outb + 256 * j + 4 * lane) = w;
            if (xs8) {
                const f32x4 ys = {__builtin_amdgcn_fmed3f(y.x * X8_SCALE, -448.f, 448.f), __builtin_amdgcn_fmed3f(y.y * X8_SCALE, -448.f, 448.f), __builtin_amdgcn_fmed3f(y.z * X8_SCALE, -448.f, 448.f), __builtin_amdgcn_fmed3f(y.w * X8_SCALE, -448.f, 448.f)};
                int hw = __builtin_amdgcn_cvt_pk_fp8_f32(ys.x, ys.y, 0, false); hw = __builtin_amdgcn_cvt_pk_fp8_f32(ys.z, ys.w, hw, true);
                const f32x2 h0 = __builtin_amdgcn_cvt_pk_f32_fp8(hw, false), h1 = __builtin_amdgcn_cvt_pk_f32_fp8(hw, true);
                int lw = __builtin_amdgcn_cvt_pk_fp8_f32((ys.x - h0.x) * 16.f, (ys.y - h0.y) * 16.f, 0, false); lw = __builtin_amdgcn_cvt_pk_fp8_f32((ys.z - h1.x) * 16.f, (ys.w - h1.y) * 16.f, lw, true);
                unsigned char* xo = xs8 + ((size_t)(2 * j + (lane >> 5)) * SEQ + t) * 128 + ((4 * lane) & 127);
                *(int*)xo = hw; *(int*)(xo + XLO_OFF) = lw; } }
    }
}

__device__ __forceinline__ void ins16(unsigned (&a)[16], unsigned e) {
#pragma unroll
    for (int i = 0; i < 16; ++i) { const unsigned hi_ = a[i] > e ? a[i] : e; e = a[i] > e ? e : a[i]; a[i] = hi_; }
}
#define CW_CE_DESC(x, y) do { const unsigned hi__ = (x) > (y) ? (x) : (y), lo__ = (x) > (y) ? (y) : (x); (x) = hi__; (y) = lo__; } while (0)
__device__ __forceinline__ void sort16_desc(unsigned (&a)[16]) {
#pragma unroll
    for (int k = 2; k <= 16; k <<= 1)
#pragma unroll
        for (int j = k >> 1; j > 0; j >>= 1)
#pragma unroll
            for (int i = 0; i < 16; ++i) { const int l = i ^ j; if (l > i) { if ((i & k) == 0) CW_CE_DESC(a[i], a[l]); else CW_CE_DESC(a[l], a[i]); } }
}
__device__ __forceinline__ void merge16_desc(unsigned (&top)[16], const unsigned (&b)[16]) {
#pragma unroll
    for (int i = 0; i < 16; ++i) top[i] = top[i] > b[15 - i] ? top[i] : b[15 - i];
#pragma unroll
    for (int j = 8; j > 0; j >>= 1)
#pragma unroll
        for (int i = 0; i < 16; ++i) { const int l = i ^ j; if (l > i) CW_CE_DESC(top[i], top[l]); }
}
__device__ __forceinline__ float key2val(unsigned k) { const unsigned u = (k & 0x80000000u) ? (k ^ 0x80000000u) : ~k; return __uint_as_float(u & ~127u); }
__device__ __forceinline__ void peer_topk_item(const u16* qp, const u16* keysb, u16* eidx, u16* eidxT, float* gate, int tt, int h, CW_LAS unsigned* cand, int lane) {
    const int r32 = lane & 31, hi = lane >> 5, t = 32 * tt + r32;
    unsigned top[2][16];
#pragma unroll
    for (int p = 0; p < 2; ++p) {
        const int hp = h * 2 + p;
        const u16* qrow = qp + (size_t)t * DMODEL + hp * 128 + 8 * hi;
        bf16x8 qb[8];
#pragma unroll
        for (int s = 0; s < 8; ++s) qb[s] = ld8(qrow + 16 * s);
#pragma unroll
        for (int nt = 0; nt < 4; ++nt) {
            const u16* krow = keysb + ((size_t)hp * 128 + 32 * nt + r32) * 128 + 8 * hi;
            f32x16 s16 = {0.f, 0.f, 0.f, 0.f, 0.f, 0.f, 0.f, 0.f, 0.f, 0.f, 0.f, 0.f, 0.f, 0.f, 0.f, 0.f};
#pragma unroll
            for (int s = 0; s < 8; ++s) s16 = __builtin_amdgcn_mfma_f32_32x32x16_bf16(ld8(krow + 16 * s), qb[s], s16, 0, 0, 0);
            unsigned bat[16];
#pragma unroll
            for (int r = 0; r < 16; ++r) { const unsigned n = (unsigned)(32 * nt + crow(r, hi)); const unsigned u = __float_as_uint(s16[r]); const unsigned k = (u & 0x80000000u) ? ~u : (u | 0x80000000u); bat[r] = (k & ~127u) | n; }
            sort16_desc(bat);
            if (nt == 0) {
#pragma unroll
                for (int i = 0; i < 16; ++i) top[p][i] = bat[i]; }
            else merge16_desc(top[p], bat);
        }
        unsigned oth[16];
#pragma unroll
        for (int i = 0; i < 16; ++i) { const auto rr_ = __builtin_amdgcn_permlane32_swap(top[p][i], top[p][i], false, false); oth[i] = hi ? rr_[0] : rr_[1]; }
        merge16_desc(top[p], oth);
    }
    float v1[16], v2[16];
#pragma unroll
    for (int i = 0; i < 16; ++i) { v1[i] = key2val(top[0][i]); v2[i] = key2val(top[1][i]); }
    unsigned best[16];
    {
        unsigned ck[3][16]; unsigned ct[2] = {0u, 0u};
        int cnum = 0;
#pragma unroll
        for (int a = 0; a < 16; ++a)
#pragma unroll
            for (int b = 0; b < 16; ++b) {
                if ((a + 1) * (b + 1) > 16) continue;
                const float ev = v1[a] + v2[b]; const unsigned u = __float_as_uint(ev); const unsigned k = (u & 0x80000000u) ? ~u : (u | 0x80000000u);
                cand[cnum * 64 + lane] = ((top[0][a] & 127u) << 7) | (top[1][b] & 127u);
                const unsigned key = (k & ~63u) | (unsigned)cnum;
                if (cnum < 48) ck[cnum >> 4][cnum & 15] = key; else ct[cnum - 48] = key;
                ++cnum;
            }
        sort16_desc(ck[0]); sort16_desc(ck[1]); sort16_desc(ck[2]);
#pragma unroll
        for (int i = 0; i < 16; ++i) best[i] = ck[0][i];
        merge16_desc(best, ck[1]); merge16_desc(best, ck[2]);
        ins16(best, ct[0]); ins16(best, ct[1]);
    }
    asm volatile("s_waitcnt lgkmcnt(0)" ::: "memory");
    float cv[16]; unsigned ci[16];
#pragma unroll
    for (int i = 0; i < 16; ++i) { const unsigned k = best[i]; const unsigned u = (k & 0x80000000u) ? (k ^ 0x80000000u) : ~k; cv[i] = __uint_as_float(u & ~63u); ci[i] = cand[(k & 63u) * 64 + lane]; }
    float den = 0.f; const float cmax = cv[0];
#pragma unroll
    for (int i = 0; i < 16; ++i) { cv[i] = ex2((cv[i] - cmax) * LOG2E); den += cv[i]; }
    const float inv = 1.0f / den;
    if (hi == 0) {
        u16* ep = eidx + (size_t)t * 128 + h * 16; float* gp = gate + (size_t)t * 128 + h * 16;
        *(u32x4*)(ep) = (u32x4){ci[0] | (ci[1] << 16), ci[2] | (ci[3] << 16), ci[4] | (ci[5] << 16), ci[6] | (ci[7] << 16)};
        *(u32x4*)(ep + 8) = (u32x4){ci[8] | (ci[9] << 16), ci[10] | (ci[11] << 16), ci[12] | (ci[13] << 16), ci[14] | (ci[15] << 16)};
        { u16* et = eidxT + (size_t)t * 128 + h;
#pragma unroll
          for (int i = 0; i < 16; ++i) et[8 * i] = (u16)ci[i]; }
#pragma unroll
        for (int i = 0; i < 16; i += 4) *(f32x4*)(gp + i) = (f32x4){cv[i] * inv, cv[i + 1] * inv, cv[i + 2] * inv, cv[i + 3] * inv};
    }
    asm volatile("s_waitcnt lgkmcnt(0)" ::: "memory");
}

__device__ __forceinline__ float fdot2(unsigned a, unsigned b, float c) { return __builtin_amdgcn_fdot2_f32_bf16(__builtin_bit_cast(bf16x2_t, a), __builtin_bit_cast(bf16x2_t, b), c, false); }

constexpr float U_SCALE = 512.0f, V_SCALE = 64.0f;
template <int CTRL> __device__ __forceinline__ float dpp_f(float x) { return __builtin_bit_cast(float, __builtin_amdgcn_mov_dpp(__builtin_bit_cast(int, x), CTRL, 0xf, 0xf, true)); }
#define PEER_LOADE(ev, tt) do { const u32x4 w0_ = *(const u32x4*)(eidx + (size_t)(tt) * 128 + 16 * p), w1_ = *(const u32x4*)(eidx + (size_t)(tt) * 128 + 16 * p + 8); \
        ev[0] = w0_.x; ev[1] = w0_.y; ev[2] = w0_.z; ev[3] = w0_.w; ev[4] = w1_.x; ev[5] = w1_.y; ev[6] = w1_.z; ev[7] = w1_.w; } while (0)
#define PEER_EID(ev, g) (((g) & 1) ? (ev[(g) >> 1] >> 16) : (ev[(g) >> 1] & 0xffffu))
#define PEER_ROWS8(rv, ev, col, H) do { _Pragma("unroll") for (int g_ = 0; g_ < 8; ++g_) rv[g_] = *(const u32x4*)((const char*)(col) + (PEER_EID(ev, 8 * (H) + g_) * 128u + loff)); } while (0)
#define FP8_LO(w) __builtin_amdgcn_cvt_pk_f32_fp8((int)(w), false)
#define FP8_HI(w) __builtin_amdgcn_cvt_pk_f32_fp8((int)(w), true)
__device__ __forceinline__ void peer_dot_slice(const unsigned char* xs8, const unsigned char* ub8, const u16* eidxT, u16* ph, int t0, int tstep, int s, int lane) {
    const int j = lane & 15, kg = lane >> 4, rho = 4 * kg + (j >> 2), pi = j & 3;
    const unsigned char* ucol = ub8 + (size_t)s * (16384 * 128); const unsigned loff = 16u * (unsigned)pi;
    const __amdgpu_buffer_rsrc_t xr = __builtin_amdgcn_make_buffer_rsrc((void*)(xs8 + (size_t)s * SEQ * 128), (short)0, 0x2000000, 0x00020000);
    const unsigned xoff = (kg == (j >> 2)) ? 16u * (unsigned)pi : 0x7fff0000u;
    u16* ocol = ph + (size_t)s * SEQ * 128 + 16 * pi + rho;
    const int n = (SEQ - t0 + tstep - 1) / tstep;
    const int SC_ONE = 0x7f7f7f7f, SC_16TH = 0x7b7b7b7b;
    const bool p1 = (pi & 1) != 0, p2 = (pi & 2) != 0;
#define TOK(k) (t0 + ((k) < n ? (k) : n - 1) * tstep)
    u32x4 e0, e1, e2, e3; i32x8 r0[4], r1[4], r2[4], r3[4], xhA, xlA, xhB, xlB;
#define PD_LOADE(ev, tt) ev = *(const u32x4*)(eidxT + (size_t)(tt) * 128 + 8 * rho)
#define PD_EID(ev, p_) (((p_) & 1) ? (ev[(p_) >> 1] >> 16) : (ev[(p_) >> 1] & 0xffffu))
#define PD_ROWS4(rv, ev, H) do { _Pragma("unroll") for (int q_ = 0; q_ < 4; ++q_) { const unsigned o_ = PD_EID(ev, 4 * (H) + q_) * 128u + loff; \
            const u32x4 a_ = *(const u32x4*)(ucol + o_), b_ = *(const u32x4*)(ucol + o_ + 64); rv[q_] = (i32x8){(int)a_.x, (int)a_.y, (int)a_.z, (int)a_.w, (int)b_.x, (int)b_.y, (int)b_.z, (int)b_.w}; } } while (0)
#define PD_LOADX(xh, xl, tt) do { const unsigned o_ = xoff + 128u * (unsigned)(tt); \
            const u32x4 a_ = __builtin_amdgcn_raw_buffer_load_b128(xr, o_, 0, 0), b_ = __builtin_amdgcn_raw_buffer_load_b128(xr, o_ + 64u, 0, 0), \
                        c_ = __builtin_amdgcn_raw_buffer_load_b128(xr, o_, (int)XLO_OFF, 0), d_ = __builtin_amdgcn_raw_buffer_load_b128(xr, o_ + 64u, (int)XLO_OFF, 0); \
            xh = (i32x8){(int)a_.x, (int)a_.y, (int)a_.z, (int)a_.w, (int)b_.x, (int)b_.y, (int)b_.z, (int)b_.w}; xl = (i32x8){(int)c_.x, (int)c_.y, (int)c_.z, (int)c_.w, (int)d_.x, (int)d_.y, (int)d_.z, (int)d_.w}; } while (0)
#define PD_COMP4(rv, xh, xl, kk) do { f32x4 a_[4]; float u_[4]; \
            _Pragma("unroll") for (int q_ = 0; q_ < 4; ++q_) a_[q_] = __builtin_amdgcn_mfma_scale_f32_16x16x128_f8f6f4(xh, rv[q_], (f32x4){0.f, 0.f, 0.f, 0.f}, 0, 0, 0, SC_ONE, 0, SC_ONE); \
            _Pragma("unroll") for (int q_ = 0; q_ < 4; ++q_) a_[q_] = __builtin_amdgcn_mfma_scale_f32_16x16x128_f8f6f4(xl, rv[q_], a_[q_], 0, 0, 0, SC_16TH, 0, SC_ONE); \
            _Pragma("unroll") for (int q_ = 0; q_ < 4; ++q_) { const float lo_ = p1 ? a_[q_][1] : a_[q_][0], hi_ = p1 ? a_[q_][3] : a_[q_][2]; float v_ = p2 ? hi_ : lo_; v_ += dpp_f<0xB1>(v_); v_ += dpp_f<0x4E>(v_); u_[q_] = v_; } \
            { const float lo_ = p1 ? u_[1] : u_[0], hi_ = p1 ? u_[3] : u_[2]; kk = p2 ? hi_ : lo_; } } while (0)
#define PD_ITEM(rA, rB, eS, eN, xh, xl, k) do { const int tt_ = TOK(k); float k0_, k1_; \
        PD_COMP4(rA, xh, xl, k0_); __builtin_amdgcn_sched_barrier(0); PD_ROWS4(rA, eN, 0); __builtin_amdgcn_sched_barrier(0); \
        PD_COMP4(rB, xh, xl, k1_); __builtin_amdgcn_sched_barrier(0); PD_ROWS4(rB, eN, 1); __builtin_amdgcn_sched_barrier(0); \
        PD_LOADX(xh, xl, TOK((k) + 2)); \
        u16* o_ = ocol + (size_t)tt_ * 128; o_[0] = (u16)f2bf(k0_ * (1.0f / (U_SCALE * X8_SCALE))); o_[64] = (u16)f2bf(k1_ * (1.0f / (U_SCALE * X8_SCALE))); \
        PD_LOADE(eS, TOK((k) + 4)); __builtin_amdgcn_sched_barrier(0); } while (0)
    PD_LOADE(e0, TOK(0)); PD_LOADE(e1, TOK(1)); PD_LOADE(e2, TOK(2)); PD_LOADE(e3, TOK(3)); PD_LOADX(xhA, xlA, TOK(0)); PD_LOADX(xhB, xlB, TOK(1)); __builtin_amdgcn_sched_barrier(0);
    PD_ROWS4(r0, e0, 0); __builtin_amdgcn_sched_barrier(0); PD_ROWS4(r1, e0, 1); __builtin_amdgcn_sched_barrier(0); PD_ROWS4(r2, e1, 0); __builtin_amdgcn_sched_barrier(0); PD_ROWS4(r3, e1, 1); __builtin_amdgcn_sched_barrier(0);
#pragma unroll 1
    for (int i = 0; i < n; i += 4) {
        PD_ITEM(r0, r1, e0, e2, xhA, xlA, i);
        PD_ITEM(r2, r3, e1, e3, xhB, xlB, i + 1);
        PD_ITEM(r0, r1, e2, e0, xhA, xlA, i + 2);
        PD_ITEM(r2, r3, e3, e1, xhB, xlB, i + 3);
    }
#undef PD_ITEM
#undef PD_COMP4
#undef PD_LOADX
#undef PD_ROWS4
#undef PD_EID
#undef PD_LOADE
#undef TOK
}
__device__ __forceinline__ void peer_act_row(const u16* ph, const float* gate, float* aw, int t, int lane) {
    float h0 = 0.f, h1 = 0.f;
#pragma unroll
    for (int s = 0; s < 16; ++s) { const unsigned w = *(const unsigned*)(ph + ((size_t)s * SEQ + t) * 128 + 2 * lane); h0 += bf2f(w & 0xffffu); h1 += bf2f(w >> 16); }
    const f32x2 g = *(const f32x2*)(gate + (size_t)t * 128 + 2 * lane);
    *(f32x2*)(aw + (size_t)t * 128 + 2 * lane) = (f32x2){KP * g.x * 0.5f * h0 * (1.0f + erff(h0 * 0.70710678118654752f)), KP * g.y * 0.5f * h1 * (1.0f + erff(h1 * 0.70710678118654752f))};
}
__device__ __forceinline__ void peer_axpy_slice(const unsigned char* vb8, const u16* eidx, const float* aw, u16* zs, int t0, int tstep, int s, int lane) {
    const int p = lane >> 3, sub = lane & 7;
    const unsigned char* vcol = vb8 + (size_t)s * (16384 * 128); const unsigned loff = 16u * (unsigned)sub;
    const __amdgpu_buffer_rsrc_t zr = __builtin_amdgcn_make_buffer_rsrc((void*)(zs + (size_t)s * SEQ * 128), (short)0, SEQ * 128 * 2, 0x00020000);
    const unsigned zoff = 32u * (unsigned)sub + 4u * (unsigned)p;
    const int n = (SEQ - t0 + tstep - 1) / tstep;
#define TOK(k) (t0 + ((k) < n ? (k) : n - 1) * tstep)
    unsigned e0[8], e1[8], e2[8], e3[8]; u32x4 r0[8], r1[8], r2[8], r3[8]; f32x4 avA[4], avB[4];
#define PA_LOADA(av, tt) do { _Pragma("unroll") for (int q_ = 0; q_ < 4; ++q_) av[q_] = *(const f32x4*)(aw + (size_t)(tt) * 128 + 16 * p + 4 * q_); } while (0)
#define PA_COMP8(vv, av, H) do { _Pragma("unroll") for (int g_ = 0; g_ < 8; ++g_) { const float a1_ = av[2 * (H) + (g_ >> 2)][g_ & 3]; const f32x2 a_ = {a1_, a1_}; \
            _Pragma("unroll") for (int w_ = 0; w_ < 4; ++w_) { acc[2 * w_] = __builtin_elementwise_fma(a_, FP8_LO(vv[g_][w_]), acc[2 * w_]); acc[2 * w_ + 1] = __builtin_elementwise_fma(a_, FP8_HI(vv[g_][w_]), acc[2 * w_ + 1]); } \
            if (g_ & 1) asm volatile("" : "+v"(acc[0]), "+v"(acc[1]), "+v"(acc[2]), "+v"(acc[3]), "+v"(acc[4]), "+v"(acc[5]), "+v"(acc[6]), "+v"(acc[7]));   } } while (0)
#define PA_ITEM(rA, rB, eS, eN, avS, k) do { const int tt_ = TOK(k); f32x2 acc[8]; _Pragma("unroll") for (int i_ = 0; i_ < 8; ++i_) acc[i_] = (f32x2){0.f, 0.f}; \
        PA_COMP8(rA, avS, 0); __builtin_amdgcn_sched_barrier(0); PEER_ROWS8(rA, eN, vcol, 0); __builtin_amdgcn_sched_barrier(0); \
        PA_COMP8(rB, avS, 1); __builtin_amdgcn_sched_barrier(0); PEER_ROWS8(rB, eN, vcol, 1); __builtin_amdgcn_sched_barrier(0); \
        PA_LOADA(avS, TOK((k) + 2)); \
          \
          \
        float w_[8], x_[4]; \
        _Pragma("unroll") for (int i_ = 0; i_ < 8; ++i_) { const auto rr_ = __builtin_amdgcn_permlane32_swap(__float_as_uint(acc[i_ >> 1][i_ & 1]), __float_as_uint(acc[(i_ + 8) >> 1][i_ & 1]), false, false); w_[i_] = __uint_as_float(rr_[0]) + __uint_as_float(rr_[1]); } \
        _Pragma("unroll") for (int i_ = 0; i_ < 4; ++i_) { const auto rr_ = __builtin_amdgcn_permlane16_swap(__float_as_uint(w_[i_]), __float_as_uint(w_[i_ + 4]), false, false); x_[i_] = __uint_as_float(rr_[0]) + __uint_as_float(rr_[1]); } \
        _Pragma("unroll") for (int i_ = 0; i_ < 4; ++i_) x_[i_] += dpp_f<0x128>(x_[i_]); \
        { const bool b3_ = (p & 1) != 0; const float lo_ = b3_ ? x_[2] : x_[0], hi_ = b3_ ? x_[3] : x_[1]; \
          __builtin_amdgcn_raw_buffer_store_b32(pk2(lo_ * (1.0f / V_SCALE), hi_ * (1.0f / V_SCALE)), zr, zoff + 256u * (unsigned)tt_, 0, 0); } \
        PEER_LOADE(eS, TOK((k) + 4)); __builtin_amdgcn_sched_barrier(0); } while (0)
    PEER_LOADE(e0, TOK(0)); PEER_LOADE(e1, TOK(1)); PEER_LOADE(e2, TOK(2)); PEER_LOADE(e3, TOK(3)); PA_LOADA(avA, TOK(0)); PA_LOADA(avB, TOK(1)); __builtin_amdgcn_sched_barrier(0);
    PEER_ROWS8(r0, e0, vcol, 0); __builtin_amdgcn_sched_barrier(0); PEER_ROWS8(r1, e0, vcol, 1); __builtin_amdgcn_sched_barrier(0); PEER_ROWS8(r2, e1, vcol, 0); __builtin_amdgcn_sched_barrier(0); PEER_ROWS8(r3, e1, vcol, 1); __builtin_amdgcn_sched_barrier(0);
#pragma unroll 1
    for (int i = 0; i < n; i += 4) {
        PA_ITEM(r0, r1, e0, e2, avA, i);
        PA_ITEM(r2, r3, e1, e3, avB, i + 1);
        PA_ITEM(r0, r1, e2, e0, avA, i + 2);
        PA_ITEM(r2, r3, e3, e1, avB, i + 3);
    }
#undef PA_ITEM
#undef PA_COMP8
#undef PA_LOADA
#undef TOK
}
#undef PEER_LOADE
#undef PEER_EID
#undef PEER_ROWS8
#undef FP8_LO
#undef FP8_HI
}

constexpr int NWAVES = 8;
constexpr int T = 8192, D = 2048, NIN = 5064, NINP = 5120, NEXP = 16384, DEPTH = 2;
constexpr float LN_EPS = 1e-5f;
constexpr float ALPHA = 1.4142135623730951f;
constexpr size_t MiB = 1u << 20;
constexpr size_t WS_CTL = 0, CTL_ZERO_BYTES = 1 * MiB;
constexpr size_t WS_ROPE = 1 * MiB;
constexpr size_t WS_KEYSB = 3 * MiB;
constexpr size_t WS_WINT = 4 * MiB;
constexpr size_t WS_WOUTT = 44 * MiB;
constexpr size_t WS_WQT = 60 * MiB;
constexpr size_t WS_UB = 76 * MiB;
constexpr size_t WS_VB = 204 * MiB;
constexpr size_t WS_XB = 332 * MiB;
constexpr size_t WS_PROJ = 364 * MiB;
constexpr size_t WS_OB = 450 * MiB;
constexpr size_t WS_MIXED = 466 * MiB;
constexpr size_t WS_X2 = 498 * MiB;
constexpr size_t WS_SCORES = 562 * MiB;
constexpr size_t WS_Z = WS_SCORES;
constexpr size_t WS_X1B = WS_SCORES + 64 * MiB;
constexpr size_t WS_QPEER = WS_SCORES + 96 * MiB;
constexpr size_t WS_EIDX = WS_SCORES + 128 * MiB;
constexpr size_t WS_GATE = WS_SCORES + 132 * MiB;
constexpr size_t WS_AACT = WS_SCORES + 136 * MiB;
constexpr size_t WS_XS = WS_SCORES + 140 * MiB;
constexpr size_t WS_ZS = WS_SCORES + 172 * MiB;
constexpr size_t WS_SEL = 818 * MiB;
constexpr size_t WS_END = 822 * MiB;
constexpr int CW_TMO = 0, CW_CODE = 1, CW_BAR = 4096;
constexpr int RING_OFF = 0, RING_BYTES = 131072;
constexpr int LDSCTL_OFF = RING_BYTES, MISC_OFF = LDSCTL_OFF + 320;
constexpr int LDS_BYTES = 147456;
#ifndef DUP
#define DUP -1
#endif
constexpr int NSUB = 12;
constexpr int NPH = 1 + (NSUB + ((DUP >= 0) ? 1 : 0)) * DEPTH;
#ifndef DUP
#define DUP -1
#endif
#ifndef CHECK
#define CHECK 0
#endif
#ifndef EXTRA_BAR
#define EXTRA_BAR 0
#endif
#ifndef DUPSUB
#define DUPSUB 0
#endif
#ifndef SUBM
#define SUBM 15
#endif
#ifndef PHM
#define PHM 511
#endif
#ifndef MK_ONE_LAUNCH
#define MK_ONE_LAUNCH 1
#endif

__device__ __forceinline__ void p0_tables_layer(const float* pu, const float* pv, unsigned char* u8, unsigned char* v8, int L, long gthr, long NGT) {
    constexpr long N4L = (long)NEXP * D / 4; const long base = (long)L * N4L;
    for (long i0 = gthr; i0 < N4L; i0 += 8 * NGT) {
        f32x4 au[8], av[8];
#pragma unroll
        for (int u = 0; u < 8; ++u) { long g = i0 + u * NGT; g = g < N4L ? g : N4L - 1; au[u] = *(const f32x4*)(pu + 4 * (base + g)); av[u] = *(const f32x4*)(pv + 4 * (base + g)); }
#pragma unroll
        for (int u = 0; u < 8; ++u) { const long g = i0 + u * NGT; if (g < N4L) {
            const int dg4 = (int)(g & 511); const int e = (int)(g >> 9);
            const size_t dst = (size_t)L * NEXP * D + ((size_t)(dg4 >> 5) * NEXP + e) * 128 + (dg4 & 31) * 4;
            { const f32x4 a = au[u] * cw::U_SCALE; int w = __builtin_amdgcn_cvt_pk_fp8_f32(a.x, a.y, 0, false); w = __builtin_amdgcn_cvt_pk_fp8_f32(a.z, a.w, w, true); *(GAS unsigned*)(u8 + dst) = (unsigned)w; }
            { const f32x4 a = av[u] * cw::V_SCALE; int w = __builtin_amdgcn_cvt_pk_fp8_f32(a.x, a.y, 0, false); w = __builtin_amdgcn_cvt_pk_fp8_f32(a.z, a.w, w, true); *(GAS unsigned*)(v8 + dst) = (unsigned)w; } } }
    }
}
__device__ __forceinline__ void p0_transpose_item(const float* W, int K, int N, bf16* WT, LAS float* scr, int item, int lane, bool permute) {
    const int nblk = N / 32, kb = item / nblk, nb = item % nblk, k0 = 64 * kb, n0 = 32 * nb;
    { f32x4 v[8];
#pragma unroll
      for (int i = 0; i < 8; ++i) v[i] = *(const f32x4*)(W + (size_t)(k0 + 8 * i + (lane >> 3)) * N + n0 + 4 * (lane & 7));
#pragma unroll
      for (int i = 0; i < 8; ++i) { LAS float* d = scr + (8 * i + (lane >> 3)) * 33 + 4 * (lane & 7); d[0] = v[i].x; d[1] = v[i].y; d[2] = v[i].z; d[3] = v[i].w; } }
    LDS_WAIT(); asm volatile("" ::: "memory");
    const int c = lane & 7;
#pragma unroll
    for (int j = 0; j < 4; ++j) { const int n = (lane >> 3) + 8 * j; const LAS float* s = scr + (8 * c) * 33 + n;
        v4u o; o.x = pk2(s[0 * 33], s[1 * 33]); o.y = pk2(s[2 * 33], s[3 * 33]); o.z = pk2(s[4 * 33], s[5 * 33]); o.w = pk2(s[6 * 33], s[7 * 33]);
        const int ng = n0 + n; int row = ng;
        if (permute && pg8::chunk_is_rope(ng >> 6)) row = (ng & ~63) + 2 * (ng & 31) + ((ng >> 5) & 1);
        *(GAS v4u*)(WT + (size_t)row * K + k0 + 8 * c) = o; }
    LDS_WAIT(); asm volatile("" ::: "memory");
}

struct Args { const float* in[14]; float* out; unsigned char* ws; int ph_lo, ph_hi; };

#define PHASE_LANE() \
    int tid_ = threadIdx.x; asm volatile("" : "+v"(tid_));        \
    const int lane = tid_ & 63, wave = __builtin_amdgcn_readfirstlane(tid_ >> 6); \
    const int gw = vcu * NWAVES + wave; const long gthr = (long)gw * 64 + lane; (void)gthr; (void)gw; (void)lane;
#define PHASE_PTRS() \
    const __attribute__((address_space(4))) Args* ap_ = (const __attribute__((address_space(4))) Args*)__builtin_amdgcn_kernarg_segment_ptr(); asm volatile("" : "+s"(ap_));
#define wsp_ (ap_->ws)
#define x_in (ap_->in[0])
#define w_in (ap_->in[1])
#define attn_sinks (ap_->in[2])
#define diff_lambda (ap_->in[3])
#define diff_norm_g (ap_->in[4])
#define w_out (ap_->in[5])
#define ln1_g (ap_->in[6])
#define ln1_b (ap_->in[7])
#define peer_wq (ap_->in[8])
#define peer_keys (ap_->in[9])
#define peer_u (ap_->in[10])
#define peer_v (ap_->in[11])
#define ln2_g (ap_->in[12])
#define ln2_b (ap_->in[13])
#define cosT ((float*)(wsp_ + WS_ROPE))
#define sinT ((float*)(wsp_ + WS_ROPE) + T * 32)
#define keysb ((bf16*)(wsp_ + WS_KEYSB))
#define winT ((bf16*)(wsp_ + WS_WINT))
#define woutT ((bf16*)(wsp_ + WS_WOUTT))
#define wqT ((bf16*)(wsp_ + WS_WQT))
#define ub8 ((unsigned char*)(wsp_ + WS_UB))
#define vb8 ((unsigned char*)(wsp_ + WS_VB))
#define xb ((bf16*)(wsp_ + WS_XB))
#define proj ((bf16*)(wsp_ + WS_PROJ))
#define ob ((bf16*)(wsp_ + WS_OB))
#define mixed ((bf16*)(wsp_ + WS_MIXED))
#define x2 ((float*)(wsp_ + WS_X2))
#define scores ((bf16*)(wsp_ + WS_SCORES))
#define zbuf ((float*)(wsp_ + WS_Z))
#define x1b ((bf16*)(wsp_ + WS_X1B))
#define qpeer ((bf16*)(wsp_ + WS_QPEER))
#define eidx ((bf16*)(wsp_ + WS_EIDX))
#define gate ((float*)(wsp_ + WS_GATE))
#define aact ((float*)(wsp_ + WS_AACT))
#define xs8 ((unsigned char*)(wsp_ + WS_XS))
#define eidxT ((bf16*)(wsp_ + WS_EIDX + 2 * MiB))
#define zsl ((bf16*)(wsp_ + WS_ZS))
#define pslab ((bf16*)(wsp_ + WS_PROJ))
#define selb ((bf16*)(wsp_ + WS_SEL))

__global__ void __launch_bounds__(NWAVES * 64, 2) mega_fwd(Args args) {
    extern __shared__ __attribute__((aligned(16))) unsigned char lds[];
    LAS unsigned char* ldsl = (LAS unsigned char*)lds;
    volatile LAS unsigned* MISC = (volatile LAS unsigned*)(ldsl + MISC_OFF);
    const int tid = threadIdx.x;
    const int G = gridDim.x, bx = blockIdx.x, vcu = (G % 8 == 0) ? (bx % 8) * (G / 8) + bx / 8 : bx;
    const int NGW = G * NWAVES;
    const long NGT = (long)NGW * 64;
    gu32* ctl = (gu32*)(args.ws + WS_CTL);
    for (int u = tid; u < (LDS_BYTES - LDSCTL_OFF) / 4; u += NWAVES * 64) ((LAS unsigned*)(ldsl + LDSCTL_OFF))[u] = 0u;
    __syncthreads();
    const int lo = args.ph_lo, hi = args.ph_hi;
    XcdBarrier bar; bar.bar = (unsigned*)(ctl + CW_BAR); bar.x = 0; bar.st = nullptr;
    if (hi - lo > 1) bar = xcd_barrier_post((unsigned*)(ctl + CW_BAR), MISC + 8);

#pragma unroll 1
    for (int ph = lo; ph < hi; ++ph) {
        constexpr int PL = NSUB + ((DUP >= 0) ? 1 : 0);
        const int L = (ph - 1) / PL, idx_ = (ph - 1) % PL, sub = (ph == 0) ? -1 : ((DUP >= 0 && idx_ > DUP) ? idx_ - 1 : idx_);
        if (ph > lo && !(sub == 3 && DUP != 2 && DUP != 3)) { xcd_barrier(bar); for (int xb_ = 0; xb_ < EXTRA_BAR; ++xb_) xcd_barrier(bar); }
        if (ph == 0) {
#if (PHM & 1)
        int tidp_ = threadIdx.x; asm volatile("" : "+v"(tidp_));
        const int lane = tidp_ & 63, wave = __builtin_amdgcn_readfirstlane(tidp_ >> 6);
        const int gw = vcu * NWAVES + wave;
        const long gthr = (long)gw * 64 + lane;
        PHASE_PTRS();
            LAS float* scr = (LAS float*)(ldsl + RING_OFF + wave * 16384);
            constexpr int I_IN = (D / 64) * (NIN / 32), I_SQ = (D / 64) * (D / 32), I_LAYER = I_IN + 2 * I_SQ;
            for (int rp_ = 0; rp_ < ((DUPSUB & 32) ? 2 : 1); ++rp_)
            for (int it = gw; it < I_IN; it += NGW) p0_transpose_item(w_in, D, NIN, winT, scr, it, lane, true);
            (void)I_SQ; (void)I_LAYER;
            for (long i = gthr; i < (long)DEPTH * 64 * D; i += NGT) { const int L = (int)(i / (64 * D)), rr = (int)(i % (64 * D)), n = 5056 + rr / D, k = rr % D;
                const float v = (n < NIN) ? w_in[(size_t)L * D * NIN + (size_t)k * NIN + n] : 0.f; winT[(size_t)L * NINP * D + (size_t)n * D + k] = (bf16)f2bf(v); }
            for (long i = gthr; i < (long)DEPTH * 16 * 128 * 128 / 8; i += NGT) { const f32x4 a = *(const f32x4*)(peer_keys + 8 * i), b = *(const f32x4*)(peer_keys + 8 * i + 4);
                v4u o; o.x = pk2(a.x, a.y); o.y = pk2(a.z, a.w); o.z = pk2(b.x, b.y); o.w = pk2(b.z, b.w); *(GAS v4u*)(keysb + 8 * i) = o; }
            { constexpr long N8 = (long)T * D / 8;
              for (long i0 = gthr; i0 < N8; i0 += 4 * NGT) {
                  f32x4 a[4], b[4];
#pragma unroll
                  for (int u = 0; u < 4; ++u) { long g = i0 + u * NGT; g = g < N8 ? g : N8 - 1; a[u] = *(const f32x4*)(x_in + 8 * g); b[u] = *(const f32x4*)(x_in + 8 * g + 4); }
#pragma unroll
                  for (int u = 0; u < 4; ++u) { const long g = i0 + u * NGT; if (g < N8) { v4u o; o.x = pk2(a[u].x, a[u].y); o.y = pk2(a[u].z, a[u].w); o.z = pk2(b[u].x, b[u].y); o.w = pk2(b[u].z, b[u].w); *(GAS v4u*)(xb + 8 * g) = o; } }
              } }
            for (long i = gthr; i < (long)T * 32; i += NGT) { const int t = (int)(i >> 5), f = (int)(i & 31);
                const float inv = powf(10000.0f, -(float)f / 32.0f); const float ang = (float)t * inv; float sv, cv; sincosf(ang, &sv, &cv); cosT[i] = cv; sinT[i] = sv; }
#endif
            continue;
        }
        {
        PHASE_PTRS();
        if (sub == 0) {
#if (PHM & 2)
            PHASE_LANE();
            pg8::Gemm g{xb, winT + (size_t)L * NINP * D, T, NINP, D}; pg8::StaticOrder S; S.init(T, NINP, G, bx);
            pg8::EpiInProj E{proj, cw::PITCH, cosT, sinT};
            pg8::gemm_phase<pg8::EpiInProj, pg8::StaticOrder, true, true>(ldsl + RING_OFF, g, S, E);
            if (L == 0) {
                pg8::Unit u3_; const int nrounds = (S.nwg + G - 1) / G;
                if (nrounds > 1 && !S.next(nrounds - 1, u3_)) {
                    const int nbusy = S.nwg - (nrounds - 1) * G, nidle = G - nbusy;
                    int tid2_ = threadIdx.x; asm volatile("" : "+v"(tid2_));
                    const int lane2 = tid2_ & 63, wave2 = __builtin_amdgcn_readfirstlane(tid2_ >> 6);
                    constexpr int I_IN = (D / 64) * (NIN / 32), I_SQ = (D / 64) * (D / 32), I_LAYER = I_IN + 2 * I_SQ;
                    LAS float* scr = (LAS float*)(ldsl + RING_OFF + wave2 * 16384);
#pragma unroll 1
                    for (int it = I_IN + (bx - nbusy) * NWAVES + wave2; it < DEPTH * I_LAYER; it += nidle * NWAVES) {
                        const int Lw = it / I_LAYER; int r = it % I_LAYER;
                        if (r < I_IN) { p0_transpose_item(w_in + (size_t)Lw * D * NIN, D, NIN, winT + (size_t)Lw * NINP * D, scr, r, lane2, true); continue; } r -= I_IN;
                        if (r < I_SQ) { p0_transpose_item(w_out + (size_t)Lw * D * D, D, D, woutT + (size_t)Lw * D * D, scr, r, lane2, false); continue; } r -= I_SQ;
                        p0_transpose_item(peer_wq + (size_t)Lw * D * D, D, D, wqT + (size_t)Lw * D * D, scr, r, lane2, false);
                    }
                }
            }
#endif
        } else if (sub == 1) {
#if (PHM & 4)
            PHASE_LANE();
#if (SUBM & 1)
#pragma unroll 1
            for (int pi = vcu; pi < 256; pi += G) {
                const int vh = pi >> 4, s = pi & 15, h = vh >> 2, j = (vh >> 1) & 1, c = vh & 1;
                const attn_body::bf16* Qh = (const attn_body::bf16*)(proj + cw::BQ + h * 128 + j * 64);
                const attn_body::bf16* Kh = (const attn_body::bf16*)(proj + cw::BK_ + h * 128 + j * 64);
                const attn_body::bf16* Vh = (const attn_body::bf16*)(proj + cw::BV + h * 128 + c * 64);
                attn_body::bf16* Oh = (attn_body::bf16*)(ob + vh * 64);
#pragma unroll 1
                for (int ui = 0; ui < 2; ++ui) { attn_body::attn_unit<8>(ui == 0 ? 31 - s : s, Qh, Kh, Vh, Oh, (char*)lds + RING_OFF);
                    if (ui == 0 && pi == vcu) p0_tables_layer(peer_u, peer_v, ub8, vb8, L, (long)gw * 64 + lane, NGT); }
            }
#endif
#if (SUBM & 2)
            for (int rp_ = 0; rp_ < ((DUPSUB & 2) ? 2 : 1); ++rp_)
            for (int it = gw; it < 2048; it += NGW) cw::swa_item(proj, mixed, attn_sinks + L * 8, it & 7, it >> 3, lane, (LAS unsigned char*)(ldsl + RING_OFF + wave * 16384));
#endif
#if (SUBM & 4)
            for (int rp_ = 0; rp_ < ((DUPSUB & 4) ? 2 : 1); ++rp_)
            for (int it = gw; it < 2048; it += NGW) { const int rest = it >> 3; cw::dil_item(proj, mixed, it & 7, rest & 15, rest >> 4, lane, (LAS unsigned char*)(ldsl + RING_OFF + wave * 16384)); }
#endif
#if (SUBM & 8)
            for (int rp_ = 0; rp_ < ((DUPSUB & 8) ? 2 : 1); ++rp_)
            for (int it = gw; it < 8448; it += NGW) { int c = 0; while (c < 31 && it >= 512 * (c + 1) - 8 * (c + 1) * c) ++c; cw::idx_item(proj, scores, 16 * c + (it - (512 * c - 8 * c * (c - 1))), c, (gw * 5 + (gw >> 3)) & 1023, lane, (LAS unsigned char*)(ldsl + RING_OFF + wave * 16384), !((DUPSUB & 256) && rp_ == 1)); }
#endif
#endif
        } else if (sub == 2) {
#if (PHM & 8)
            PHASE_LANE();
            LAS unsigned char* wsl = ldsl + RING_OFF + wave * 16384;
#pragma unroll 1
            for (int i4 = 4 * gw; i4 < 8192; i4 += 4 * NGW) {
#pragma unroll 1
                for (int k = 0; k < 4; ++k) { const int i = i4 >> 2; const int t = (k == 0) ? 8191 - i : (k == 1) ? 4096 + i : (k == 2) ? 4095 - i : i; cw::dsa_select(scores, selb, t, wsl, lane); }
            }
            asm volatile("s_waitcnt vmcnt(0)" ::: "memory");
            const float* lp = diff_lambda + L * 256;
            const float lam_init = 0.8f - 0.6f * expf(-0.3f * (float)L);
            const float lam = expf(cw::wave_sum(lp[lane] * lp[64 + lane])) - expf(cw::wave_sum(lp[128 + lane] * lp[192 + lane])) + lam_init;
            for (int t = gw; t < T; t += NGW) cw::diff_combine_row(ob, mixed, diff_norm_g + L * 128, lam, lam_init, t, lane);
#endif
        } else if (sub == 3) {
#if (PHM & 8)
            PHASE_LANE();
            LAS unsigned char* wsl = ldsl + RING_OFF + wave * 16384; LAS bf16* idx16 = (LAS bf16*)(ldsl + MISC_OFF + 1024 + wave * 512);
#pragma unroll 1
            for (int i4 = 4 * gw; i4 < 8192; i4 += 4 * NGW) {
#pragma unroll 1
                for (int k = 0; k < 4; ++k) { const int i = i4 >> 2; const int t = (k == 0) ? 8191 - i : (k == 1) ? 4096 + i : (k == 2) ? 4095 - i : i; cw::dsa_attend(proj, selb, mixed, t, wsl, idx16, lane); }
            }
#endif
        } else if (sub == 4) {
#if (PHM & 16)
            PHASE_LANE();
            pg8::Gemm g{mixed, woutT + (size_t)L * D * D, T, D, D}; pg8::StaticOrder S; S.init(T, D, G, bx);
            pg8::EpiResid E{(bf16*)zbuf, (L == 0) ? x_in : (const float*)x2, D, ALPHA};
            pg8::gemm_phase<pg8::EpiResid, pg8::StaticOrder, true, true>(ldsl + RING_OFF, g, S, E);
#endif
        } else if (sub == 5) {
#if (PHM & 32)
            PHASE_LANE();
            for (int t = gw; t < T; t += NGW) cw::ln_row<true>((const bf16*)zbuf + (size_t)t * D, 1.0f, (const bf16*)nullptr, t, (float*)nullptr, x1b + (size_t)t * D, xs8, ln1_g + L * D, ln1_b + L * D, lane);
#endif
        } else if (sub == 6) {
#if (PHM & 64)
            PHASE_LANE();
            pg8::Gemm g{x1b, wqT + (size_t)L * D * D, T, D, D}; pg8::StaticOrder S; S.init(T, D, G, bx);
            pg8::EpiBf16<0> E{qpeer, D, nullptr, 0, 0, 1.f};
            pg8::gemm_phase<pg8::EpiBf16<0>, pg8::StaticOrder, true, true>(ldsl + RING_OFF, g, S, E);
#endif
        } else if (sub == 7) {
#if (PHM & 128)
            PHASE_LANE();
            LAS unsigned* cand = (LAS unsigned*)(ldsl + RING_OFF + wave * 12800);
#pragma unroll 1
            for (int it = gw; it < 2048; it += NGW) cw::peer_topk_item(qpeer, keysb + (size_t)L * 16 * 128 * 128, eidx, eidxT, gate, it >> 3, it & 7, cand, lane);
#endif
        } else if (sub == 8) {
#if (PHM & 256)
            PHASE_LANE();
            { const int xg = bx & 7, wig = (bx >> 3) * NWAVES + wave, wpg = (G >> 3) * NWAVES; const unsigned char* ubL = ub8 + (size_t)L * NEXP * D;
#pragma unroll 1
              for (int m = 0; m < 2; ++m) { const int s = xg + 8 * m;
#ifndef NO_DOT
                cw::peer_dot_slice(xs8, ubL, eidxT, pslab, wig, wpg, s, lane);
#endif
              } }
#endif
        } else if (sub == 9) {
#if (PHM & 256)
            PHASE_LANE();
            for (int t = gw; t < T; t += NGW) cw::peer_act_row(pslab, gate, aact, t, lane);
#endif
        } else if (sub == 10) {
#if (PHM & 256)
            PHASE_LANE();
            { const int xg = bx & 7, wig = (bx >> 3) * NWAVES + wave, wpg = (G >> 3) * NWAVES; const unsigned char* vbL = vb8 + (size_t)L * NEXP * D;
#pragma unroll 1
              for (int m = 0; m < 2; ++m) { const int s = xg + 8 * m;
#ifndef NO_AXPY
                cw::peer_axpy_slice(vbL, eidx, aact, zsl, wig, wpg, s, lane);
#endif
              } }
#endif
        } else {
#if (PHM & 256)
            PHASE_LANE();
            { const bool last = (L == DEPTH - 1); float* zout = last ? ap_->out : x2;
              for (int t = gw; t < T; t += NGW) cw::ln_row<true>(x1b + (size_t)t * D, ALPHA, zsl, t, zout + (size_t)t * D, last ? (bf16*)nullptr : xb + (size_t)t * D, (unsigned char*)nullptr, ln2_g + L * D, ln2_b + L * D, lane); }
#endif
        }
        }
    }
}

#undef wsp_
#undef x_in
#undef w_in
#undef attn_sinks
#undef diff_lambda
#undef diff_norm_g
#undef w_out
#undef ln1_g
#undef ln1_b
#undef peer_wq
#undef peer_keys
#undef peer_u
#undef peer_v
#undef ln2_g
#undef ln2_b
#undef cosT
#undef sinT
#undef keysb
#undef winT
#undef woutT
#undef wqT
#undef ub8
#undef vb8
#undef xb
#undef proj
#undef ob
#undef mixed
#undef x2
#undef scores
#undef zbuf
#undef x1b
#undef qpeer
#undef eidx
#undef gate
#undef aact
#undef xs8
#undef eidxT
#undef zsl
#undef pslab
#undef selb

extern "C" void kernel_launch(void* const* d_in, const int* in_sizes, int n_in, void* d_out, int out_size, void* d_ws, size_t ws_size, hipStream_t stream) {
    static int grid = 0;
    if (grid == 0) {
        if (n_in != 14 || out_size != T * D || ws_size < WS_END) { fprintf(stderr, "kernel_launch: unexpected shapes (n_in %d, out %d, ws %zu < %zu); nothing launched\n", n_in, out_size, ws_size, (size_t)WS_END); grid = -1; return; }
        int dev = 0, cus = 0;
        if (hipGetDevice(&dev) != hipSuccess || hipDeviceGetAttribute(&cus, hipDeviceAttributeMultiprocessorCount, dev) != hipSuccess) { grid = -1; return; }
        if (hipFuncSetAttribute((const void*)mega_fwd, hipFuncAttributeMaxDynamicSharedMemorySize, LDS_BYTES) != hipSuccess) { fprintf(stderr, "kernel_launch: hipFuncSetAttribute failed\n"); grid = -1; return; }
        (void)hipGetLastError();
        grid = cus;
    }
    if (grid < 0) return;
    if (hipMemsetAsync((char*)d_ws + WS_CTL, 0, CTL_ZERO_BYTES, stream) != hipSuccess) { fprintf(stderr, "kernel_launch: memset failed\n"); return; }
    Args a{};
    for (int i = 0; i < 14; ++i) a.in[i] = (const float*)d_in[i];
    a.out = (float*)d_out; a.ws = (unsigned char*)d_ws;
#if CHECK
    a.ph_lo = 0; a.ph_hi = 5;
    hipLaunchKernelGGL(mega_fwd, dim3(grid), dim3(NWAVES * 64), LDS_BYTES, stream, a);
    { unsigned char* w8 = (unsigned char*)d_ws; unsigned* res = (unsigned*)(w8 + WS_CTL + 512 * 1024);
      const cw::u16* projp = (const cw::u16*)(w8 + WS_PROJ); const cw::u16* mixp = (const cw::u16*)(w8 + WS_MIXED); const cw::u16* scp = (const cw::u16*)(w8 + WS_SCORES);
      if ((CHECK & 7) == 1) hipLaunchKernelGGL(chk::check_A, dim3(T * 8 / 4), dim3(256), 0, stream, projp, mixp, (const float*)d_in[2], res);
      if ((CHECK & 7) == 2) hipLaunchKernelGGL(chk::check_C, dim3(T * 8 / 4), dim3(256), 0, stream, projp, mixp, res);
      if ((CHECK & 7) == 3) hipLaunchKernelGGL(chk::check_D, dim3(T / 4), dim3(256), 0, stream, projp, scp, mixp, res);
      if ((CHECK & 7) == 4) hipLaunchKernelGGL(chk::check_S, dim3(T / 4), dim3(256), 0, stream, projp, scp, res);
      hipLaunchKernelGGL(chk::check_emit, dim3((out_size + 255) / 256), dim3(256), 0, stream, (const unsigned*)res, (float*)d_out, out_size, (CHECK >= 16) ? (CHECK >> 4) : ((CHECK & 7) - 1) + ((CHECK & 8) ? 8 : 0)); }
#elif MK_ONE_LAUNCH
    a.ph_lo = 0; a.ph_hi = NPH;
    hipLaunchKernelGGL(mega_fwd, dim3(grid), dim3(NWAVES * 64), LDS_BYTES, stream, a);
#else
    for (int ph = 0; ph < NPH; ++ph) { a.ph_lo = ph; a.ph_hi = ph + 1; hipLaunchKernelGGL(mega_fwd, dim3(grid), dim3(NWAVES * 64), LDS_BYTES, stream, a); }
#endif
}
```
